# Optimizing an MI355X kernel written in HIP

```python
import jax, jax.numpy as jnp
from jax import lax
import numpy as np

D_MODEL = 1024
BATCH = 2
SEQ = 8192
DEPTH = 4
DEC_BATCH = 128
DEC_SEQ = 1
PAST_LEN = 8192
PAGE_SIZE = 128

N_MIXERS = 3
N_LAYERS_A = (DEPTH + 2) // 3
N_LAYERS_B = (DEPTH + 1) // 3
N_LAYERS_C = DEPTH // 3
NORM_EPS = 1e-6
LN_EPS = 1e-5

A_EXPAND = 2
D_A = A_EXPAND * D_MODEL
CHUNK = 128
A_GROUPS = 4

HEAD_DIM = 64
N_HEADS = D_MODEL // HEAD_DIM
N_KV_HEADS = N_HEADS // 8
Q_PER_KV = N_HEADS // N_KV_HEADS
WINDOW = 128
ROPE_THETA = 10000.0

D_RNN = D_MODEL
C_BLOCKS = 4
C_BLOCK_W = D_RNN // C_BLOCKS
CONV_W = 4
LRU_C = 8.0

kernel_name = 'hybrid_gmlp_swa_rglru_decode_step'


def rms_norm(x, g):
    xf = x.astype(jnp.float32)
    y = xf * lax.rsqrt(jnp.mean(xf * xf, axis=-1, keepdims=True) + NORM_EPS)
    return (y * g.astype(jnp.float32)).astype(x.dtype)


def layer_norm(x, g, b):
    xf = x.astype(jnp.float32)
    mu = jnp.mean(xf, axis=-1, keepdims=True)
    var = jnp.mean(jnp.square(xf - mu), axis=-1, keepdims=True)
    y = (xf - mu) * lax.rsqrt(var + LN_EPS)
    return (y * g.astype(jnp.float32) + b.astype(jnp.float32)).astype(x.dtype)


def rope(x, pos):
    half = HEAD_DIM // 2
    inv_freq = ROPE_THETA ** (-jnp.arange(half, dtype=jnp.float32) / half)
    ang = pos.astype(jnp.float32)[:, None] * inv_freq[None, :]
    cos = jnp.cos(ang)[:, None, :]
    sin = jnp.sin(ang)[:, None, :]
    xf = x.astype(jnp.float32)
    x1, x2 = xf[..., :half], xf[..., half:]
    return jnp.concatenate([x1 * cos - x2 * sin, x2 * cos + x1 * sin], axis=-1).astype(x.dtype)


def sink_softmax(scores, mask, sinks):
    s = jnp.where(mask, scores.astype(jnp.float32), -jnp.inf)
    sink = sinks.astype(jnp.float32)[..., None, None]
    m = jnp.maximum(jnp.max(s, axis=-1, keepdims=True), sink)
    e = jnp.exp(s - m)
    return e / (jnp.sum(e, axis=-1, keepdims=True) + jnp.exp(sink - m))


def mixer_a(h, w_in, ln_g, ln_b, w_s, b_s, w_out):
    bsz, t_len, _ = h.shape
    u, v, g = jnp.split(h @ w_in, 3, axis=-1)
    u = jax.nn.gelu(u)
    v = layer_norm(jax.nn.gelu(v), ln_g, ln_b)
    n_chunks = -(-t_len // CHUNK)
    pad = n_chunks * CHUNK - t_len
    vc = jnp.pad(v, ((0, 0), (0, pad), (0, 0))).reshape(bsz, n_chunks, CHUNK, A_GROUPS, D_A // A_GROUPS)
    causal = jnp.tril(jnp.ones((CHUNK, CHUNK), dtype=bool))
    ws = jnp.where(causal[None], w_s, 0.0)
    mixed = jnp.einsum('gts,bnsgc->bntgc', ws, vc) + b_s.T[None, None, :, :, None]
    mixed = mixed.reshape(bsz, n_chunks * CHUNK, D_A)[:, :t_len]
    out = (u * mixed * jax.nn.silu(g)) @ w_out
    return out, v


def project_b(h, w_in):
    bsz, t_len, _ = h.shape
    qd, kd = N_HEADS * HEAD_DIM, N_KV_HEADS * HEAD_DIM
    z = h @ w_in
    q = z[..., :qd].reshape(bsz, t_len, N_HEADS, HEAD_DIM)
    k = z[..., qd:qd + kd].reshape(bsz, t_len, N_KV_HEADS, HEAD_DIM)
    v = z[..., qd + kd:qd + 2 * kd].reshape(bsz, t_len, N_KV_HEADS, HEAD_DIM)
    g = z[..., qd + 2 * kd:]
    return q, k, v, g


def mixer_b_prompt(h, w_in, sinks, w_out):
    bsz, t_len, _ = h.shape
    q, k, v, g = project_b(h, w_in)
    pos = jnp.arange(t_len, dtype=jnp.int32)
    q, k = rope(q, pos), rope(k, pos)
    nb = t_len // WINDOW
    qb = q.reshape(bsz, nb, WINDOW, N_KV_HEADS, Q_PER_KV, HEAD_DIM)
    kb = k.reshape(bsz, nb, WINDOW, N_KV_HEADS, HEAD_DIM)
    vb = v.reshape(bsz, nb, WINDOW, N_KV_HEADS, HEAD_DIM)
    prev = lambda a: jnp.pad(a, ((0, 0), (1, 0), (0, 0), (0, 0), (0, 0)))[:, :-1]
    kk = jnp.concatenate([prev(kb), kb], axis=2)
    vv = jnp.concatenate([prev(vb), vb], axis=2)
    scores = jnp.einsum('bnqkgd,bnskd->bnkgqs', qb, kk) * (HEAD_DIM ** -0.5)
    blk = jnp.arange(nb)[:, None, None]
    qpos = blk * WINDOW + jnp.arange(WINDOW)[None, :, None]
    kpos = (blk - 1) * WINDOW + jnp.arange(2 * WINDOW)[None, None, :]
    mask = (kpos <= qpos) & (qpos - kpos <= WINDOW) & (kpos >= 0)
    p = sink_softmax(scores, mask[None, :, None, None], sinks.reshape(N_KV_HEADS, Q_PER_KV))
    o = jnp.einsum('bnkgqs,bnskd->bnqkgd', p.astype(vv.dtype), vv).reshape(bsz, t_len, N_HEADS * HEAD_DIM)
    out = (o * jax.nn.silu(g)) @ w_out
    keep = min(WINDOW, t_len)
    return out, k[:, t_len - keep:], v[:, t_len - keep:]


def mixer_b_sample(h, buf_k, buf_v, w_in, sinks, w_out):
    bsz, t_len, _ = h.shape
    wb = buf_k.shape[1]
    q, k, v, g = project_b(h, w_in)
    qpos = PAST_LEN + jnp.arange(t_len, dtype=jnp.int32)
    q, k = rope(q, qpos), rope(k, qpos)
    kk = jnp.concatenate([buf_k.astype(k.dtype), k], axis=1)
    vv = jnp.concatenate([buf_v.astype(v.dtype), v], axis=1)
    kpos = jnp.concatenate([PAST_LEN - wb + jnp.arange(wb, dtype=jnp.int32), qpos])
    qg = q.reshape(bsz, t_len, N_KV_HEADS, Q_PER_KV, HEAD_DIM)
    scores = jnp.einsum('btkgd,bskd->bkgts', qg, kk) * (HEAD_DIM ** -0.5)
    mask = (kpos[None, :] <= qpos[:, None]) & (qpos[:, None] - kpos[None, :] <= WINDOW)
    p = sink_softmax(scores, mask, sinks.reshape(N_KV_HEADS, Q_PER_KV))
    o = jnp.einsum('bkgts,bskd->btkgd', p.astype(vv.dtype), vv).reshape(bsz, t_len, N_HEADS * HEAD_DIM)
    out = (o * jax.nn.silu(g)) @ w_out
    keep = min(WINDOW, wb + t_len)
    return out, kk[:, wb + t_len - keep:], vv[:, wb + t_len - keep:]


def mixer_c(h, conv_buf, h0, pos, w_in, conv_w, conv_b, w_a, b_a, w_x, b_x, lam, w_out):
    bsz, t_len, _ = h.shape
    xr, g = jnp.split(h @ w_in, 2, axis=-1)
    xpad = jnp.concatenate([conv_buf.astype(xr.dtype), xr], axis=1)
    xc = conv_b + xpad[:, 0:t_len] * conv_w[0]
    for tap in range(1, CONV_W):
        xc = xc + xpad[:, tap:tap + t_len] * conv_w[tap]
    new_conv = xpad[:, t_len:]
    xblk = xc.reshape(bsz, t_len, C_BLOCKS, C_BLOCK_W)
    r = jax.nn.sigmoid(jnp.einsum('btnc,ncd->btnd', xblk, w_a).reshape(bsz, t_len, D_RNN) + b_a)
    i_gate = jax.nn.sigmoid(jnp.einsum('btnc,ncd->btnd', xblk, w_x).reshape(bsz, t_len, D_RNN) + b_x)
    log_a = -LRU_C * r.astype(jnp.float32) * jax.nn.softplus(-lam.astype(jnp.float32))
    a = jnp.exp(log_a)
    mult = jnp.sqrt(-jnp.expm1(2.0 * log_a))
    mult = jnp.where((pos == 0)[None, :, None], 1.0, mult)
    bterm = mult * (i_gate * xc).astype(jnp.float32)
    bterm = bterm.at[:, 0].add(a[:, 0] * h0.astype(jnp.float32))

    def combine(left, right):
        a1, b1 = left
        a2, b2 = right
        return a1 * a2, a2 * b1 + b2

    _, hs = lax.associative_scan(combine, (a, bterm), axis=1)
    out = (hs.astype(h.dtype) * jax.nn.silu(g)) @ w_out
    return out, new_conv, hs[:, -1]


def setup_inputs(seed: int = 0) -> dict:
    key = jax.random.key(seed)
    ks = jax.random.split(key, 32)
    f32 = jnp.float32

    def nrm(k, shape, scale):
        return jax.random.normal(k, shape, f32) * scale

    w_buf = min(WINDOW, PAST_LEN)
    qkvg = 2 * N_HEADS * HEAD_DIM + 2 * N_KV_HEADS * HEAD_DIM
    u = jax.random.uniform(ks[29], (N_LAYERS_C, D_RNN), f32, 0.9, 0.999)
    base = u ** (1.0 / LRU_C)
    c_lam = jnp.log(base) - jnp.log1p(-base)
    return {
        'x_prompt': nrm(ks[0], (BATCH, SEQ, D_MODEL), 1.0),
        'x_sample': nrm(ks[1], (DEC_BATCH, DEC_SEQ, D_MODEL), 1.0),
        'cache_b_k': nrm(ks[2], (N_LAYERS_B, DEC_BATCH, w_buf, N_KV_HEADS, HEAD_DIM), 1.0),
        'cache_b_v': nrm(ks[3], (N_LAYERS_B, DEC_BATCH, w_buf, N_KV_HEADS, HEAD_DIM), 1.0),
        'state_c_conv': nrm(ks[4], (N_LAYERS_C, DEC_BATCH, CONV_W - 1, D_RNN), 1.0),
        'state_c_h': nrm(ks[5], (N_LAYERS_C, DEC_BATCH, D_RNN), 0.5),
        'norm_pre': 1.0 + nrm(ks[6], (DEPTH, D_MODEL), 0.02),
        'norm_post': 1.0 + nrm(ks[7], (DEPTH, D_MODEL), 0.02),
        'a_w_in': nrm(ks[8], (N_LAYERS_A, D_MODEL, 3 * D_A), D_MODEL ** -0.5),
        'a_ln_g': 1.0 + nrm(ks[9], (N_LAYERS_A, D_A), 0.02),
        'a_ln_b': nrm(ks[10], (N_LAYERS_A, D_A), 0.02),
        'a_w_s': nrm(ks[11], (N_LAYERS_A, A_GROUPS, CHUNK, CHUNK), CHUNK ** -0.5),
        'a_b_s': 1.0 + nrm(ks[12], (N_LAYERS_A, A_GROUPS, CHUNK), 0.02),
        'a_w_out': nrm(ks[13], (N_LAYERS_A, D_A, D_MODEL), D_A ** -0.5),
        'b_w_in': nrm(ks[14], (N_LAYERS_B, D_MODEL, qkvg), D_MODEL ** -0.5),
        'b_sinks': nrm(ks[15], (N_LAYERS_B, N_HEADS), 1.0),
        'b_w_out': nrm(ks[16], (N_LAYERS_B, N_HEADS * HEAD_DIM, D_MODEL), (N_HEADS * HEAD_DIM) ** -0.5),
        'c_w_in': nrm(ks[17], (N_LAYERS_C, D_MODEL, 2 * D_RNN), D_MODEL ** -0.5),
        'c_conv_w': nrm(ks[18], (N_LAYERS_C, CONV_W, D_RNN), CONV_W ** -0.5),
        'c_conv_b': nrm(ks[19], (N_LAYERS_C, D_RNN), 0.02),
        'c_w_a': nrm(ks[20], (N_LAYERS_C, C_BLOCKS, C_BLOCK_W, C_BLOCK_W), C_BLOCK_W ** -0.5),
        'c_b_a': nrm(ks[21], (N_LAYERS_C, D_RNN), 0.02),
        'c_w_x': nrm(ks[22], (N_LAYERS_C, C_BLOCKS, C_BLOCK_W, C_BLOCK_W), C_BLOCK_W ** -0.5),
        'c_b_x': nrm(ks[23], (N_LAYERS_C, D_RNN), 0.02),
        'c_lam': c_lam,
        'c_w_out': nrm(ks[24], (N_LAYERS_C, D_RNN, D_MODEL), D_RNN ** -0.5),
    }


def reference(x_prompt, x_sample, cache_b_k, cache_b_v, state_c_conv, state_c_h,
              norm_pre, norm_post,
              a_w_in, a_ln_g, a_ln_b, a_w_s, a_b_s, a_w_out,
              b_w_in, b_sinks, b_w_out,
              c_w_in, c_conv_w, c_conv_b, c_w_a, c_b_a, c_w_x, c_b_x, c_lam, c_w_out):
    xp, xs = x_prompt, x_sample
    pos_p = jnp.arange(xp.shape[1], dtype=jnp.int32)
    pos_s = PAST_LEN + jnp.arange(xs.shape[1], dtype=jnp.int32)
    a_v_s = []
    b_kp, b_vp, b_ks, b_vs = [], [], [], []
    c_cp, c_hp, c_cs, c_hs = [], [], [], []
    for i in range(DEPTH):
        kind, j = i % N_MIXERS, i // N_MIXERS
        hp = rms_norm(xp, norm_pre[i])
        hs = rms_norm(xs, norm_pre[i])
        if kind == 0:
            yp, _ = mixer_a(hp, a_w_in[j], a_ln_g[j], a_ln_b[j], a_w_s[j], a_b_s[j], a_w_out[j])
            ys, vs = mixer_a(hs, a_w_in[j], a_ln_g[j], a_ln_b[j], a_w_s[j], a_b_s[j], a_w_out[j])
            a_v_s.append(vs)
        elif kind == 1:
            yp, kp, vp = mixer_b_prompt(hp, b_w_in[j], b_sinks[j], b_w_out[j])
            ys, ks_, vs_ = mixer_b_sample(hs, cache_b_k[j], cache_b_v[j], b_w_in[j], b_sinks[j], b_w_out[j])
            b_kp.append(kp); b_vp.append(vp); b_ks.append(ks_); b_vs.append(vs_)
        else:
            yp, cp, hlp = mixer_c(hp, jnp.zeros((hp.shape[0], CONV_W - 1, D_RNN), hp.dtype),
                                  jnp.zeros((hp.shape[0], D_RNN), jnp.float32), pos_p,
                                  c_w_in[j], c_conv_w[j], c_conv_b[j], c_w_a[j], c_b_a[j],
                                  c_w_x[j], c_b_x[j], c_lam[j], c_w_out[j])
            ys, cs, hls = mixer_c(hs, state_c_conv[j], state_c_h[j], pos_s,
                                  c_w_in[j], c_conv_w[j], c_conv_b[j], c_w_a[j], c_b_a[j],
                                  c_w_x[j], c_b_x[j], c_lam[j], c_w_out[j])
            c_cp.append(cp); c_hp.append(hlp); c_cs.append(cs); c_hs.append(hls)
        xp = xp + rms_norm(yp, norm_post[i])
        xs = xs + rms_norm(ys, norm_post[i])
    new_a_v_sample = jnp.stack(a_v_s)
    new_b_k_prompt = jnp.stack(b_kp)
    new_b_v_prompt = jnp.stack(b_vp)
    new_b_k_sample = jnp.stack(b_ks)
    new_b_v_sample = jnp.stack(b_vs)
    new_c_conv_prompt = jnp.stack(c_cp)
    new_c_h_prompt = jnp.stack(c_hp)
    new_c_conv_sample = jnp.stack(c_cs)
    new_c_h_sample = jnp.stack(c_hs)
    return (xp, xs, new_a_v_sample, new_b_k_prompt, new_b_v_prompt, new_b_k_sample, new_b_v_sample,
            new_c_conv_prompt, new_c_h_prompt, new_c_conv_sample, new_c_h_sample)
```

```cpp
#include <hip/hip_runtime.h>
#include <hip/hip_cooperative_groups.h>
#include <stdint.h>
#include <stdio.h>
#include <math.h>
namespace cg = cooperative_groups;

#ifndef ONE_LAUNCH
#define ONE_LAUNCH 1
#endif

typedef unsigned short bf16_t;
typedef short bf16x8 __attribute__((ext_vector_type(8)));
typedef float f32x4 __attribute__((ext_vector_type(4)));
typedef unsigned u32x4 __attribute__((ext_vector_type(4)));
typedef unsigned u32x2 __attribute__((ext_vector_type(2)));

constexpr int M_P = 16384, M_S = 128, MT = 16512, D = 1024, SEQ = 8192;
constexpr int NTHREADS = 256;
constexpr int SMEM_BYTES = 65536;

constexpr size_t O_X = 0;
constexpr size_t O_AV = (size_t)MT * D;
constexpr size_t O_BKP = O_AV + 2 * 128 * 2048;
constexpr size_t O_BVP = O_BKP + 2 * 128 * 128;
constexpr size_t O_BKS = O_BVP + 2 * 128 * 128;
constexpr size_t O_BVS = O_BKS + 128 * 128 * 128;
constexpr size_t O_CCP = O_BVS + 128 * 128 * 128;
constexpr size_t O_CHP = O_CCP + 2 * 3 * 1024;
constexpr size_t O_CCS = O_CHP + 2 * 1024;
constexpr size_t O_CHS = O_CCS + 128 * 3 * 1024;
constexpr size_t O_END = O_CHS + 128 * 1024;

constexpr size_t W_A_IN = 0;
constexpr size_t W_A_OUT = W_A_IN + (size_t)2 * 6144 * 1024 * 2;
constexpr size_t W_B_IN = W_A_OUT + (size_t)2 * 1024 * 2048 * 2;
constexpr size_t W_B_OUT = W_B_IN + (size_t)2304 * 1024 * 2;
constexpr size_t W_C_IN = W_B_OUT + (size_t)1024 * 1024 * 2;
constexpr size_t W_C_G = W_C_IN + (size_t)2048 * 1024 * 2;
constexpr size_t W_C_OUT = W_C_G + (size_t)4 * 512 * 256 * 2;
constexpr size_t W_WS_A = W_C_OUT + (size_t)1024 * 1024 * 2;
constexpr size_t W_ROPE = W_WS_A + (size_t)2 * 4 * 128 * 128 * 2;
constexpr size_t W_H = W_ROPE + (size_t)8193 * 64 * 4;
constexpr size_t W_BUF1 = W_H + (size_t)MT * 1024 * 2;
constexpr size_t W_BUF2 = W_BUF1 + (size_t)MT * 2048 * 2;
constexpr size_t W_KB = W_BUF2 + (size_t)MT * 2048 * 2;
constexpr size_t W_STATS = W_KB;
constexpr size_t W_CARRY = W_KB + (size_t)MT * 256 * 2;
constexpr size_t W_YPART = W_CARRY + (size_t)128 * 1024 * 2 * 4;
constexpr size_t W_XB = W_YPART + (size_t)8 * 128 * 1024 * 4;
constexpr size_t W_END = W_XB + (size_t)MT * 1024 * 2;

struct Params {
    const float* in[26];
    float* out;
    unsigned char* ws;
    int ph_lo, ph_hi;
};

__device__ __forceinline__ unsigned cvt_pk(float lo, float hi) {
    unsigned r;
    asm("v_cvt_pk_bf16_f32 %0, %1, %2" : "=v"(r) : "v"(lo), "v"(hi));
    return r;
}
__device__ __forceinline__ float bf_lo(unsigned u) { return __uint_as_float(u << 16); }
__device__ __forceinline__ float bf_hi(unsigned u) { return __uint_as_float(u & 0xffff0000u); }
__device__ __forceinline__ float bf2f(bf16_t h) { return __uint_as_float(((unsigned)h) << 16); }
__device__ __forceinline__ float sigmoid_f(float x) { return __builtin_amdgcn_rcpf(1.f + __expf(-x)); }
__device__ __forceinline__ float silu_f(float x) { return x * sigmoid_f(x); }
__device__ __forceinline__ float gelu_f(float x) { return x * sigmoid_f(1.5957691216057308f * (x + 0.044715f * x * x * x)); }
__device__ __forceinline__ float gelu_silu(float u, float g) {
    const float eu = __expf(-1.5957691216057308f * (u + 0.044715f * u * u * u)), eg = __expf(-g);
    const float den = (1.f + eu) * (1.f + eg);
    return (u * g) * __builtin_amdgcn_rcpf(den);
}
template <int CTRL> __device__ __forceinline__ float dpp_add(float x) {
    return x + __builtin_bit_cast(float, __builtin_amdgcn_update_dpp(0, __builtin_bit_cast(int, x), CTRL, 0xF, 0xF, true));
}
__device__ __forceinline__ float row16_sum(float x) {
    x = dpp_add<0xB1>(x);
    x = dpp_add<0x4E>(x);
    x = dpp_add<0x141>(x);
    x = dpp_add<0x140>(x);
    return x;
}
__device__ __forceinline__ float wave_sum(float v) {
#pragma unroll
    for (int o = 1; o < 64; o <<= 1) v += __shfl_xor(v, o);
    return v;
}

__device__ __forceinline__ int perm32(int rho) { return 8 * ((rho & 15) >> 2) + 4 * (rho >> 4) + (rho & 3); }
__device__ __forceinline__ int permcol(int c) { return (c & ~31) + perm32(c & 31); }
__device__ __forceinline__ int swz(int row, int chunk) { return (chunk ^ (((row >> 3) & 1) << 1)) * 8; }

template <bool TRANS>
__device__ __forceinline__ void mma_stage(const bf16_t* As, const bf16_t* Bs, int apanel, int bpanel, f32x4 (&acc)[4][4], int wr, int wc, int lane) {
    const int fr = lane & 15, fq = lane >> 4;
    const int co = swz(fr, fq);
#pragma unroll
    for (int kk = 0; kk < 2; ++kk) {
        bf16x8 a[4], b[4];
#pragma unroll
        for (int i = 0; i < 4; ++i) {
            a[i] = *(const bf16x8*)(As + kk * apanel + (wr * 64 + i * 16 + fr) * 32 + co);
            b[i] = *(const bf16x8*)(Bs + kk * bpanel + (wc * 64 + i * 16 + fr) * 32 + co);
        }
#pragma unroll
        for (int i = 0; i < 4; ++i)
#pragma unroll
            for (int j = 0; j < 4; ++j)
                acc[i][j] = TRANS ? __builtin_amdgcn_mfma_f32_16x16x32_bf16(b[j], a[i], acc[i][j], 0, 0, 0)
                                  : __builtin_amdgcn_mfma_f32_16x16x32_bf16(a[i], b[j], acc[i][j], 0, 0, 0);
    }
}

__device__ __forceinline__ void g2r(const bf16_t* __restrict__ g, int ld, int row0, int k0, int tid, u32x4 (&r)[4]) {
    const int rl = 2 * (tid >> 4) + ((tid >> 2) & 1), kc = ((tid >> 3) & 1) * 4 + (tid & 3);
    const unsigned voff = (unsigned)(rl * ld + kc * 8) * 2u;
#pragma unroll
    for (int i = 0; i < 4; ++i) {
        const char* b = (const char*)(g + (size_t)(row0 + 32 * i) * ld + k0);
        r[i] = *(const u32x4*)(b + voff);
    }
}
__device__ __forceinline__ void r2s(bf16_t* s, int tid, const u32x4 (&r)[4]) {
    const int rl = 2 * (tid >> 4) + ((tid >> 2) & 1), kc = ((tid >> 3) & 1) * 4 + (tid & 3);
#pragma unroll
    for (int i = 0; i < 4; ++i) {
        const int row = rl + 32 * i;
        *(u32x4*)(s + (kc >> 2) * 4096 + row * 32 + swz(row, kc & 3)) = r[i];
    }
}

__device__ __forceinline__ void g2r32(const bf16_t* __restrict__ g, int ld, int row0, int k0, int tid, u32x4 (&r)[2]) {
    const unsigned voff = (unsigned)((tid >> 2) * ld + (tid & 3) * 8) * 2u;
#pragma unroll
    for (int i = 0; i < 2; ++i) {
        const char* b = (const char*)(g + (size_t)(row0 + 64 * i) * ld + k0);
        r[i] = *(const u32x4*)(b + voff);
    }
}
__device__ __forceinline__ void r2s32(bf16_t* s, int tid, const u32x4 (&r)[2]) {
#pragma unroll
    for (int i = 0; i < 2; ++i) {
        const int row = (tid >> 2) + 64 * i;
        *(u32x4*)(s + row * 32 + swz(row, tid & 3)) = r[i];
    }
}
__device__ __forceinline__ void ldfrag(const bf16_t* st, bf16x8 (&a)[4], bf16x8 (&b)[4], int wr, int wc, int fr, int co) {
#pragma unroll
    for (int i = 0; i < 4; ++i) {
        a[i] = *(const bf16x8*)(st + (wr * 64 + i * 16 + fr) * 32 + co);
        b[i] = *(const bf16x8*)(st + 4096 + (wc * 64 + i * 16 + fr) * 32 + co);
    }
}
template <bool TRANS>
__device__ __forceinline__ void mma16(const bf16x8 (&a)[4], const bf16x8 (&b)[4], f32x4 (&acc)[4][4]) {
    __builtin_amdgcn_s_setprio(1);
#pragma unroll
    for (int i = 0; i < 4; ++i)
#pragma unroll
        for (int j = 0; j < 4; ++j)
            acc[i][j] = TRANS ? __builtin_amdgcn_mfma_f32_16x16x32_bf16(b[j], a[i], acc[i][j], 0, 0, 0)
                              : __builtin_amdgcn_mfma_f32_16x16x32_bf16(a[i], b[j], acc[i][j], 0, 0, 0);
    __builtin_amdgcn_s_setprio(0);
}

struct Stage { u32x4 ra0[2], rb0[2], ra1[2], rb1[2]; };

template <bool TRANS, class Epi>
__device__ __forceinline__ void gemm_tile(const bf16_t* __restrict__ A, int lda, const bf16_t* __restrict__ Bt, int ldb, int K, int m0, int n0,
                                          bf16_t* smem, const Epi epi, Stage& st, bool pre, bool has_next, const bf16_t* __restrict__ An,
                                          const bf16_t* __restrict__ Bn, int m0n, int n0n) {
    const int tid = threadIdx.x, wid = tid >> 6, lane = tid & 63, wr = wid >> 1, wc = wid & 1, fr = lane & 15, fq = lane >> 4;
    const int co = swz(fr, fq);
    f32x4 acc[4][4];
#pragma unroll
    for (int i = 0; i < 4; ++i)
#pragma unroll
        for (int j = 0; j < 4; ++j) acc[i][j] = (f32x4){0.f, 0.f, 0.f, 0.f};
    const int nk = K >> 5;
    bf16x8 a0[4], b0[4], a1[4], b1[4];
    if (!pre) {
        g2r32(A, lda, m0, 0, tid, st.ra0);
        g2r32(Bt, ldb, n0, 0, tid, st.rb0);
        g2r32(A, lda, m0, 32, tid, st.ra1);
        g2r32(Bt, ldb, n0, 32, tid, st.rb1);
    }
    __syncthreads();
    r2s32(smem, tid, st.ra0);
    r2s32(smem + 4096, tid, st.rb0);
    r2s32(smem + 8192, tid, st.ra1);
    r2s32(smem + 8192 + 4096, tid, st.rb1);
    g2r32(A, lda, m0, 64, tid, st.ra0);
    g2r32(Bt, ldb, n0, 64, tid, st.rb0);
    g2r32(A, lda, m0, 96, tid, st.ra1);
    g2r32(Bt, ldb, n0, 96, tid, st.rb1);
    __syncthreads();
    ldfrag(smem, a0, b0, wr, wc, fr, co);
    for (int kt = 0; kt < nk; kt += 2) {
        {
            bf16_t* w = smem + ((kt + 2) & 3) * 8192;
            r2s32(w, tid, st.ra0);
            r2s32(w + 4096, tid, st.rb0);
            const int kn = (kt + 4 < nk ? kt + 4 : nk - 1) * 32;
            g2r32(A, lda, m0, kn, tid, st.ra0);
            g2r32(Bt, ldb, n0, kn, tid, st.rb0);
            ldfrag(smem + ((kt + 1) & 3) * 8192, a1, b1, wr, wc, fr, co);
            mma16<TRANS>(a0, b0, acc);
            __syncthreads();
        }
        {
            bf16_t* w = smem + ((kt + 3) & 3) * 8192;
            r2s32(w, tid, st.ra1);
            r2s32(w + 4096, tid, st.rb1);
            const int kn = (kt + 5 < nk ? kt + 5 : nk - 1) * 32;
            g2r32(A, lda, m0, kn, tid, st.ra1);
            g2r32(Bt, ldb, n0, kn, tid, st.rb1);
            ldfrag(smem + ((kt + 2) & 3) * 8192, a0, b0, wr, wc, fr, co);
            mma16<TRANS>(a1, b1, acc);
            __syncthreads();
        }
    }
    if (has_next) {
        g2r32(An, lda, m0n, 0, tid, st.ra0);
        g2r32(Bn, ldb, n0n, 0, tid, st.rb0);
        g2r32(An, lda, m0n, 32, tid, st.ra1);
        g2r32(Bn, ldb, n0n, 32, tid, st.rb1);
    }
    epi(acc, m0, n0, wr, wc, lane);
}

__device__ __forceinline__ void wt_tile(const float* colptr, int ldsrc, bf16_t* dst, int ldd, float* tile, int tid) {
    const int tx = tid & 63, ty = tid >> 6;
    float v[16];
#pragma unroll
    for (int q = 0; q < 16; ++q) v[q] = colptr[(size_t)(ty + 4 * q) * ldsrc];
#pragma unroll
    for (int q = 0; q < 16; ++q) tile[(ty + 4 * q) * 65 + tx] = v[q];
    __syncthreads();
    const int c2 = tid & 31, r0 = tid >> 5;
#pragma unroll
    for (int rr = r0; rr < 64; rr += 8)
        *(unsigned*)(dst + (size_t)rr * ldd + 2 * c2) = cvt_pk(tile[(2 * c2) * 65 + rr], tile[(2 * c2 + 1) * 65 + rr]);
    __syncthreads();
}

__device__ __forceinline__ void sincos_d(double x, double& s, double& c) {
    const double k = rint(x * 0.63661977236758134308);
    double r = fma(-k, 1.57079632673412561417e+00, x);
    r = fma(-k, 6.07710050650619224932e-11, r);
    const double z = r * r;
    const double sp = r + r * z * (-1.66666666666666324348e-01 + z * (8.33333333332248946124e-03 + z * (-1.98412698298579493134e-04 + z * (2.75573137070700676789e-06 + z * (-2.50507602534068634195e-08 + z * 1.58969099521155010221e-10)))));
    const double cp = 1.0 - 0.5 * z + z * z * (4.16666666666666019037e-02 + z * (-1.38888888888741095749e-03 + z * (2.48015872894767294178e-05 + z * (-2.75573143513906633035e-07 + z * (2.08757232129817482790e-09 + z * -1.13596475577881948265e-11)))));
    const int q = ((int)k) & 3;
    s = (q == 0) ? sp : (q == 1) ? cp : (q == 2) ? -sp : -cp;
    c = (q == 0) ? cp : (q == 1) ? -sp : (q == 2) ? -cp : sp;
}

__device__ __forceinline__ void norm_phase(const float* __restrict__ Y, const float* __restrict__ Ypart, int nsplit, const float* xin_p, const float* xin_s,
                                           bf16_t* Xb, bool storeXb, float* Xf, const float* gpost, const float* gpre, bf16_t* H) {
    const int lane = threadIdx.x & 63;
    const int gw = blockIdx.x * 4 + (threadIdx.x >> 6), nw = gridDim.x * 4;
    for (int row = gw; row < MT; row += nw) {
        f32x4 x[4];
        if (xin_p) {
            const float* xr = row < M_P ? xin_p + (size_t)row * D : xin_s + (size_t)(row - M_P) * D;
#pragma unroll
            for (int j = 0; j < 4; ++j) x[j] = *(const f32x4*)(xr + j * 256 + lane * 4);
        } else {
#pragma unroll
            for (int j = 0; j < 4; ++j) {
                const u32x2 w = *(const u32x2*)(Xb + (size_t)row * D + j * 256 + lane * 4);
                x[j] = (f32x4){bf_lo(w.x), bf_hi(w.x), bf_lo(w.y), bf_hi(w.y)};
            }
        }
        if (Y) {
            f32x4 y[4];
            float ss = 0.f;
            if (row < M_P) {
#pragma unroll
                for (int j = 0; j < 4; ++j) {
                    const u32x2 w = *(const u32x2*)((const bf16_t*)Y + (size_t)row * D + j * 256 + lane * 4);
                    y[j] = (f32x4){bf_lo(w.x), bf_hi(w.x), bf_lo(w.y), bf_hi(w.y)};
                }
            } else {
#pragma unroll
                for (int j = 0; j < 4; ++j) y[j] = (f32x4){0.f, 0.f, 0.f, 0.f};
                for (int s = 0; s < nsplit; ++s) {
#pragma unroll
                    for (int j = 0; j < 4; ++j) y[j] += *(const f32x4*)(Ypart + ((size_t)s * 128 + (row - M_P)) * D + j * 256 + lane * 4);
                }
            }
#pragma unroll
            for (int j = 0; j < 4; ++j) ss += y[j].x * y[j].x + y[j].y * y[j].y + y[j].z * y[j].z + y[j].w * y[j].w;
            ss = wave_sum(ss);
            const float rstd = rsqrtf(ss * (1.f / 1024.f) + 1e-6f);
#pragma unroll
            for (int j = 0; j < 4; ++j) {
                const f32x4 g = *(const f32x4*)(gpost + j * 256 + lane * 4);
                x[j] = x[j] + y[j] * rstd * g;
            }
        }
        if (storeXb) {
#pragma unroll
            for (int j = 0; j < 4; ++j) {
                u32x2 w;
                w.x = cvt_pk(x[j].x, x[j].y);
                w.y = cvt_pk(x[j].z, x[j].w);
                *(u32x2*)(Xb + (size_t)row * D + j * 256 + lane * 4) = w;
            }
        }
        if (Xf) {
#pragma unroll
            for (int j = 0; j < 4; ++j) *(f32x4*)(Xf + (size_t)row * D + j * 256 + lane * 4) = x[j];
        }
        if (gpre) {
            float ss = 0.f;
#pragma unroll
            for (int j = 0; j < 4; ++j) ss += x[j].x * x[j].x + x[j].y * x[j].y + x[j].z * x[j].z + x[j].w * x[j].w;
            ss = wave_sum(ss);
            const float rstd = rsqrtf(ss * (1.f / 1024.f) + 1e-6f);
#pragma unroll
            for (int j = 0; j < 4; ++j) {
                const f32x4 g = *(const f32x4*)(gpre + j * 256 + lane * 4);
                const f32x4 h = x[j] * rstd * g;
                u32x2 w;
                w.x = cvt_pk(h.x, h.y);
                w.y = cvt_pk(h.z, h.w);
                *(u32x2*)(H + (size_t)row * D + j * 256 + lane * 4) = w;
            }
        }
    }
}

constexpr int WT_FIRST = 96 * 16;
constexpr int WT_TOTAL = 2 * 96 * 16 + 2 * 16 * 32 + 36 * 16 + 256 + 32 * 16 + 128 + 256;
__device__ __forceinline__ void wt_jobs(const Params& p, unsigned char* smem, int lo, int hi, int w, int nw) {
    float* tile = (float*)smem;
    const int tid = threadIdx.x, tx = tid & 63;
    constexpr int T_AIN = 96 * 16, T_AOUT = 16 * 32, T_BIN = 36 * 16, T_BOUT = 256, T_CIN = 32 * 16, T_CG = 128, T_COUT = 256;
    for (int it = lo + w; it < hi; it += nw) {
        int r = it;
        if (r < 2 * T_AIN) {
            const int j = r / T_AIN; r -= j * T_AIN;
            const int nt = r >> 4, kt = r & 15, np = permcol(nt * 64 + tx);
            int col;
            const int T = np >> 7, w = np & 127;
            if (T < 32) {
                const int wc = w >> 6, jn = (w >> 4) & 3, i = w & 15;
                col = ((jn < 2) ? 0 : 4096) + 64 * T + 32 * wc + 16 * (jn & 1) + i;
            } else col = 2048 + (np - 4096);
            wt_tile(p.in[8] + (size_t)j * 1024 * 6144 + (size_t)(kt * 64) * 6144 + col, 6144,
                    (bf16_t*)(p.ws + W_A_IN) + (size_t)j * 6144 * 1024 + (size_t)(nt * 64) * 1024 + kt * 64, 1024, tile, tid);
            continue;
        }
        r -= 2 * T_AIN;
        if (r < 2 * T_AOUT) {
            const int j = r / T_AOUT; r -= j * T_AOUT;
            const int nt = r >> 5, kt = r & 31;
            wt_tile(p.in[13] + (size_t)j * 2048 * 1024 + (size_t)(kt * 64) * 1024 + permcol(nt * 64 + tx), 1024,
                    (bf16_t*)(p.ws + W_A_OUT) + (size_t)j * 1024 * 2048 + (size_t)(nt * 64) * 2048 + kt * 64, 2048, tile, tid);
            continue;
        }
        r -= 2 * T_AOUT;
        if (r < T_BIN) {
            const int nt = r >> 4, kt = r & 15;
            wt_tile(p.in[14] + (size_t)(kt * 64) * 2304 + permcol(nt * 64 + tx), 2304, (bf16_t*)(p.ws + W_B_IN) + (size_t)(nt * 64) * 1024 + kt * 64, 1024, tile, tid);
            continue;
        }
        r -= T_BIN;
        if (r < T_BOUT) {
            const int nt = r >> 4, kt = r & 15;
            wt_tile(p.in[16] + (size_t)(kt * 64) * 1024 + permcol(nt * 64 + tx), 1024, (bf16_t*)(p.ws + W_B_OUT) + (size_t)(nt * 64) * 1024 + kt * 64, 1024, tile, tid);
            continue;
        }
        r -= T_BOUT;
        if (r < T_CIN) {
            const int nt = r >> 4, kt = r & 15;
            wt_tile(p.in[17] + (size_t)(kt * 64) * 2048 + permcol(nt * 64 + tx), 2048, (bf16_t*)(p.ws + W_C_IN) + (size_t)(nt * 64) * 1024 + kt * 64, 1024, tile, tid);
            continue;
        }
        r -= T_CIN;
        if (r < T_CG) {
            const int blk = r >> 5, rr = r & 31, nt = rr >> 2, kt = rr & 3;
            const int np = permcol(nt * 64 + tx), j4 = np >> 7, w = np & 127, wc = w >> 6, jn = (w >> 4) & 3, i = w & 15;
            const int dl = 64 * j4 + 32 * wc + 16 * (jn & 1) + i;
            const float* src = ((jn < 2) ? p.in[20] : p.in[22]) + (size_t)blk * 65536;
            wt_tile(src + (size_t)(kt * 64) * 256 + dl, 256, (bf16_t*)(p.ws + W_C_G) + (size_t)blk * 512 * 256 + (size_t)(nt * 64) * 256 + kt * 64, 256, tile, tid);
            continue;
        }
        r -= T_CG;
        {
            const int nt = r >> 4, kt = r & 15;
            wt_tile(p.in[24 + 1] + (size_t)(kt * 64) * 1024 + permcol(nt * 64 + tx), 1024, (bf16_t*)(p.ws + W_C_OUT) + (size_t)(nt * 64) * 1024 + kt * 64, 1024, tile, tid);
        }
    }
}

__device__ __forceinline__ void prep_phase(const Params& p, unsigned char* smem) {
    const int tid = threadIdx.x;
    wt_jobs(p, smem, 0, WT_FIRST, blockIdx.x, gridDim.x);
    const int gt = blockIdx.x * NTHREADS + tid, gn = gridDim.x * NTHREADS;
    {
        bf16_t* wsa = (bf16_t*)(p.ws + W_WS_A);
        const float* src = p.in[11];
        for (int idx = gt; idx < 2 * 4 * 128 * 128 / 2; idx += gn) {
            const int e = idx * 2, t = (e >> 7) & 127, s = e & 127;
            const float a = (s <= t) ? src[e] : 0.f, b = (s + 1 <= t) ? src[e + 1] : 0.f;
            *(unsigned*)(wsa + e) = cvt_pk(a, b);
        }
    }
    {
        float* rt = (float*)(p.ws + W_ROPE);
        for (int idx = gt; idx < 8193 * 32; idx += gn) {
            const int pos = idx >> 5, i = idx & 31;
            const float ang = (float)pos * exp2f(-(float)i * (13.287712379549449f / 32.0f));
            double s, c;
            sincos_d((double)ang, s, c);
            rt[pos * 64 + i] = (float)c;
            rt[pos * 64 + 32 + i] = (float)s;
        }
    }
    norm_phase(nullptr, nullptr, 0, p.in[0], p.in[1], nullptr, false, nullptr, nullptr, p.in[6], (bf16_t*)(p.ws + W_H));
}

struct EpiUG {
    bf16_t* P;
    int T;
    __device__ __forceinline__ void operator()(f32x4 (&acc)[4][4], int m0, int n0, int wr, int wc, int lane) const {
        const int fr = lane & 15, fq = lane >> 4;
#pragma unroll
        for (int i = 0; i < 4; ++i) {
            const int m = m0 + wr * 64 + i * 16 + fr;
            const int ch = 64 * T + 32 * wc + 8 * fq;
            u32x4 w;
            {
                const f32x4 u = acc[i][0], g = acc[i][2];
                w.x = cvt_pk(gelu_silu(u.x, g.x), gelu_silu(u.y, g.y));
                w.y = cvt_pk(gelu_silu(u.z, g.z), gelu_silu(u.w, g.w));
            }
            {
                const f32x4 u = acc[i][1], g = acc[i][3];
                w.z = cvt_pk(gelu_silu(u.x, g.x), gelu_silu(u.y, g.y));
                w.w = cvt_pk(gelu_silu(u.z, g.z), gelu_silu(u.w, g.w));
            }
            *(u32x4*)(P + (size_t)m * 2048 + ch) = w;
        }
    }
};
struct EpiV {
    bf16_t* GVt;
    float* stats;
    int mt, tv;
    __device__ __forceinline__ void operator()(f32x4 (&acc)[4][4], int m0, int n0, int wr, int wc, int lane) const {
        const int fr = lane & 15, fq = lane >> 4;
#pragma unroll
        for (int i = 0; i < 4; ++i) {
            const int sl = wr * 64 + i * 16 + fq * 4;
            f32x4 sum = {0.f, 0.f, 0.f, 0.f}, sq = {0.f, 0.f, 0.f, 0.f};
#pragma unroll
            for (int jn = 0; jn < 4; ++jn) {
                const int ch = 128 * tv + wc * 64 + 32 * (jn >> 1) + perm32(16 * (jn & 1) + fr);
                f32x4 v = acc[i][jn];
                v.x = gelu_f(v.x); v.y = gelu_f(v.y); v.z = gelu_f(v.z); v.w = gelu_f(v.w);
                u32x2 w;
                w.x = cvt_pk(v.x, v.y);
                w.y = cvt_pk(v.z, v.w);
                *(u32x2*)(GVt + ((size_t)mt * 2048 + ch) * 128 + sl) = w;
                sum += v;
                sq += v * v;
            }
            sum.x = row16_sum(sum.x); sum.y = row16_sum(sum.y); sum.z = row16_sum(sum.z); sum.w = row16_sum(sum.w);
            sq.x = row16_sum(sq.x); sq.y = row16_sum(sq.y); sq.z = row16_sum(sq.z); sq.w = row16_sum(sq.w);
            if (fr == 0) {
                float* st = stats + (size_t)(m0 + sl) * 64 + (tv * 2 + wc) * 2;
                st[0] = sum.x; st[1] = sq.x;
                st[64] = sum.y; st[65] = sq.y;
                st[128] = sum.z; st[129] = sq.z;
                st[192] = sum.w; st[193] = sq.w;
            }
        }
    }
};

__device__ __forceinline__ void a_in_phase(const Params& p, int j, bf16_t* smem) {
    const bf16_t* H = (const bf16_t*)(p.ws + W_H);
    const bf16_t* Wt = (const bf16_t*)(p.ws + W_A_IN) + (size_t)j * 6144 * 1024;
    bf16_t* P = (bf16_t*)(p.ws + W_BUF1);
    bf16_t* GVt = (bf16_t*)(p.ws + W_BUF2);
    float* stats = (float*)(p.ws + W_STATS);
    Stage st;
    bool pre = false;
    for (int t = blockIdx.x; t < 129 * 48; t += gridDim.x) {
        const int mt = t / 48, nt = t % 48;
        const int tn = t + gridDim.x;
        const bool hn = tn < 129 * 48;
        const int m0n = (tn / 48) * 128, n0n = (tn % 48) * 128;
        if (nt < 32) {
            EpiUG e{P, nt};
            gemm_tile<true>(H, 1024, Wt, 1024, 1024, mt * 128, nt * 128, smem, e, st, pre, hn, H, Wt, m0n, n0n);
        } else {
            EpiV e{GVt, stats, mt, nt - 32};
            gemm_tile<false>(H, 1024, Wt, 1024, 1024, mt * 128, nt * 128, smem, e, st, pre, hn, H, Wt, m0n, n0n);
        }
        pre = hn;
    }
    if (j == 0) {
        const int busy = (129 * 48) % gridDim.x, idle = gridDim.x - busy;
        if (idle > 0 && (int)blockIdx.x >= busy) wt_jobs(p, (unsigned char*)smem, WT_FIRST, WT_TOTAL, blockIdx.x - busy, idle);
        else if (idle <= 0) wt_jobs(p, (unsigned char*)smem, WT_FIRST, WT_TOTAL, blockIdx.x, gridDim.x);
    }
}

__device__ __forceinline__ void a_mix_phase(const Params& p, int j, bf16_t* smem) {
    const int tid = threadIdx.x, wid = tid >> 6, lane = tid & 63, wr = wid >> 1, wc = wid & 1, fr = lane & 15, fq = lane >> 4;
    bf16_t* P = (bf16_t*)(p.ws + W_BUF1);
    const bf16_t* GVt = (const bf16_t*)(p.ws + W_BUF2);
    const float* stats = (const float*)(p.ws + W_STATS);
    const bf16_t* wsa = (const bf16_t*)(p.ws + W_WS_A) + (size_t)j * 4 * 128 * 128;
    const float* ln_g = p.in[9] + j * 2048;
    const float* ln_b = p.in[10] + j * 2048;
    const float* b_s = p.in[12] + j * 4 * 128;
    const float* w_s = p.in[11] + (size_t)j * 4 * 128 * 128;
    float* av_out = p.out + O_AV + (size_t)j * 128 * 2048;
    bf16_t* As = smem;
    bf16_t* Bs = smem + 16384;
    float* mu = (float*)(smem + 16384);
    float* rs = mu + 128;
    for (int it = blockIdx.x; it < 129 * 16; it += gridDim.x) {
        const int chunk = it >> 4, g = (it >> 2) & 3, slab = it & 3;
        const bool samp = (chunk == 128);
        __syncthreads();
        if (tid < 128) {
            const float* st = stats + (size_t)(chunk * 128 + tid) * 64;
            float s = 0.f, q = 0.f;
#pragma unroll
            for (int k = 0; k < 16; ++k) {
                const f32x4 v = *(const f32x4*)(st + k * 4);
                s += v.x + v.z;
                q += v.y + v.w;
            }
            const float mean = s * (1.f / 2048.f);
            const float var = fmaxf(q * (1.f / 2048.f) - mean * mean, 0.f);
            mu[tid] = mean;
            rs[tid] = rsqrtf(var + 1e-5f);
        }
        __syncthreads();
        float mur[8], rsr[8];
#pragma unroll
        for (int e = 0; e < 8; ++e) { mur[e] = mu[(tid & 15) * 8 + e]; rsr[e] = rs[(tid & 15) * 8 + e]; }
        __syncthreads();
        if (!samp) {
            const bf16_t* wg = wsa + g * 16384;
#pragma unroll
            for (int i = 0; i < 8; ++i) {
                const int c = tid + 256 * i, row = c >> 4, sc = c & 15;
                const u32x4 v = *(const u32x4*)(wg + row * 128 + sc * 8);
                *(u32x4*)(As + (sc >> 2) * 4096 + row * 32 + swz(row, sc & 3)) = v;
            }
        } else {
            const float w00 = w_s[g * 16384];
#pragma unroll
            for (int i = 0; i < 8; ++i) {
                const int c = tid + 256 * i, row = c >> 4, sc = c & 15;
                u32x4 v = {0u, 0u, 0u, 0u};
                if ((row >> 3) == sc) {
                    const unsigned lo = cvt_pk(w00, 0.f), hi = cvt_pk(0.f, w00);
                    const int e = row & 7;
                    const unsigned val = (e & 1) ? hi : lo;
                    if ((e >> 1) == 0) v.x = val; else if ((e >> 1) == 1) v.y = val; else if ((e >> 1) == 2) v.z = val; else v.w = val;
                }
                *(u32x4*)(As + (sc >> 2) * 4096 + row * 32 + swz(row, sc & 3)) = v;
            }
        }
        __syncthreads();
#pragma unroll 4
        for (int i = 0; i < 8; ++i) {
            const int c = tid + 256 * i, n = c >> 4, sc = c & 15;
            const int ch = g * 512 + slab * 128 + permcol(n);
            const u32x4 v = *(const u32x4*)(GVt + ((size_t)chunk * 2048 + ch) * 128 + sc * 8);
            const float lg = ln_g[ch], lb = ln_b[ch];
            float x[8];
            x[0] = bf_lo(v.x); x[1] = bf_hi(v.x); x[2] = bf_lo(v.y); x[3] = bf_hi(v.y);
            x[4] = bf_lo(v.z); x[5] = bf_hi(v.z); x[6] = bf_lo(v.w); x[7] = bf_hi(v.w);
#pragma unroll
            for (int e = 0; e < 8; ++e) x[e] = (x[e] - mur[e]) * rsr[e] * lg + lb;
            if (samp) {
#pragma unroll
                for (int e = 0; e < 8; ++e) av_out[(size_t)(sc * 8 + e) * 2048 + ch] = x[e];
            }
            u32x4 o;
            o.x = cvt_pk(x[0], x[1]); o.y = cvt_pk(x[2], x[3]); o.z = cvt_pk(x[4], x[5]); o.w = cvt_pk(x[6], x[7]);
            *(u32x4*)(Bs + (sc >> 2) * 4096 + n * 32 + swz(n, sc & 3)) = o;
        }
        __syncthreads();
        f32x4 acc[4][4];
#pragma unroll
        for (int i = 0; i < 4; ++i)
#pragma unroll
            for (int jn = 0; jn < 4; ++jn) acc[i][jn] = (f32x4){0.f, 0.f, 0.f, 0.f};
        u32x4 pvv[4][2];
#pragma unroll
        for (int i = 0; i < 4; ++i)
#pragma unroll
            for (int g2 = 0; g2 < 2; ++g2)
                pvv[i][g2] = *(const u32x4*)(P + (size_t)(chunk * 128 + wr * 64 + i * 16 + fr) * 2048 + g * 512 + slab * 128 + wc * 64 + 32 * g2 + 8 * fq);
        mma_stage<true>(As, Bs, 4096, 4096, acc, wr, wc, lane);
        mma_stage<true>(As + 8192, Bs + 8192, 4096, 4096, acc, wr, wc, lane);
#pragma unroll
        for (int i = 0; i < 4; ++i) {
            const int t = wr * 64 + i * 16 + fr;
            const float bs = b_s[g * 128 + (samp ? 0 : t)];
            const size_t rowoff = (size_t)(chunk * 128 + t) * 2048 + g * 512 + slab * 128;
#pragma unroll
            for (int g2 = 0; g2 < 2; ++g2) {
                bf16_t* pp = P + rowoff + wc * 64 + 32 * g2 + 8 * fq;
                const u32x4 pv = pvv[i][g2];
                const f32x4 a = acc[i][2 * g2], b = acc[i][2 * g2 + 1];
                u32x4 w;
                w.x = cvt_pk(bf_lo(pv.x) * (a.x + bs), bf_hi(pv.x) * (a.y + bs));
                w.y = cvt_pk(bf_lo(pv.y) * (a.z + bs), bf_hi(pv.y) * (a.w + bs));
                w.z = cvt_pk(bf_lo(pv.z) * (b.x + bs), bf_hi(pv.z) * (b.y + bs));
                w.w = cvt_pk(bf_lo(pv.w) * (b.z + bs), bf_hi(pv.w) * (b.w + bs));
                *(u32x4*)pp = w;
            }
        }
    }
}

struct EpiY {
    bf16_t* Yb;
    float* Yp;
    __device__ __forceinline__ void operator()(f32x4 (&acc)[4][4], int m0, int n0, int wr, int wc, int lane) const {
        const int fr = lane & 15, fq = lane >> 4;
        const bool part = (m0 == M_P);
#pragma unroll
        for (int i = 0; i < 4; ++i) {
            const int m = m0 + wr * 64 + i * 16 + fr;
#pragma unroll
            for (int g2 = 0; g2 < 2; ++g2) {
                const int n = n0 + wc * 64 + 32 * g2 + 8 * fq;
                const f32x4 a = acc[i][2 * g2], b = acc[i][2 * g2 + 1];
                if (part) {
                    float* o = Yp + (size_t)(m - M_P) * 1024 + n;
                    *(f32x4*)o = a;
                    *(f32x4*)(o + 4) = b;
                } else {
                    u32x4 w;
                    w.x = cvt_pk(a.x, a.y); w.y = cvt_pk(a.z, a.w); w.z = cvt_pk(b.x, b.y); w.w = cvt_pk(b.z, b.w);
                    *(u32x4*)(Yb + (size_t)m * 1024 + n) = w;
                }
            }
        }
    }
};
__device__ __forceinline__ void out_gemm_phase(const bf16_t* A, int K, const bf16_t* Wt, float* Y, float* Ypart, bf16_t* smem) {
    const int nsplit = K >> 8;
    const int ntile = 1024 + 8 * nsplit;
    Stage st;
    bool pre = false;
    for (int t = blockIdx.x; t < ntile; t += gridDim.x) {
        const bool full = t < 1024;
        const int u = t - 1024, ks = full ? 0 : (u >> 3);
        const int m0 = full ? (t >> 3) * 128 : M_P, n0 = (full ? (t & 7) : (u & 7)) * 128, Kt = full ? K : 256;
        const int tn = t + gridDim.x;
        const bool hn = tn < ntile, fulln = tn < 1024;
        const int un = tn - 1024, ksn = fulln ? 0 : (un >> 3);
        const int m0n = fulln ? (tn >> 3) * 128 : M_P, n0n = (fulln ? (tn & 7) : (un & 7)) * 128;
        EpiY e{(bf16_t*)Y, Ypart + (size_t)ks * 128 * 1024};
        gemm_tile<true>(A + ks * 256, K, Wt + ks * 256, K, Kt, m0, n0, smem, e, st, pre, hn, A + ksn * 256, Wt + ksn * 256, m0n, n0n);
        pre = hn;
    }
}

struct EpiSilu {
    bf16_t* O;
    int ldo, col0;
    __device__ __forceinline__ void operator()(f32x4 (&acc)[4][4], int m0, int n0, int wr, int wc, int lane) const {
        const int fr = lane & 15, fq = lane >> 4;
#pragma unroll
        for (int i = 0; i < 4; ++i) {
            const int m = m0 + wr * 64 + i * 16 + fr;
#pragma unroll
            for (int jn = 0; jn < 4; ++jn) {
                const f32x4 a = acc[i][jn];
                u32x2 w;
                w.x = cvt_pk(silu_f(a.x), silu_f(a.y));
                w.y = cvt_pk(silu_f(a.z), silu_f(a.w));
                *(u32x2*)(O + (size_t)m * ldo + col0 + wc * 64 + jn * 16 + fq * 4) = w;
            }
        }
    }
};
struct EpiCopy {
    bf16_t* O;
    int ldo, col0;
    __device__ __forceinline__ void operator()(f32x4 (&acc)[4][4], int m0, int n0, int wr, int wc, int lane) const {
        const int fr = lane & 15, fq = lane >> 4;
#pragma unroll
        for (int i = 0; i < 4; ++i) {
            const int m = m0 + wr * 64 + i * 16 + fr;
#pragma unroll
            for (int jn = 0; jn < 4; ++jn) {
                const f32x4 a = acc[i][jn];
                u32x2 w;
                w.x = cvt_pk(a.x, a.y);
                w.y = cvt_pk(a.z, a.w);
                *(u32x2*)(O + (size_t)m * ldo + col0 + wc * 64 + jn * 16 + fq * 4) = w;
            }
        }
    }
};
template <int isk> struct EpiRope {
    bf16_t* O;
    int ldo, col0;
    const float* rope;
    float* out;
    __device__ __forceinline__ void operator()(f32x4 (&acc)[4][4], int m0, int n0, int wr, int wc, int lane) const {
        const int fr = lane & 15, fq = lane >> 4;
#pragma unroll
        for (int i = 0; i < 4; ++i) {
            const int m = m0 + wr * 64 + i * 16 + fr;
            const int pos = (m < M_P) ? (m & (SEQ - 1)) : SEQ;
            const float* rt = rope + (size_t)pos * 64;
            const float scale = isk ? 1.0f : 0.125f;
#pragma unroll
            for (int jn = 0; jn < 2; ++jn) {
                const int d = jn * 16 + fq * 4;
                const f32x4 c = *(const f32x4*)(rt + d), s = *(const f32x4*)(rt + 32 + d);
                const f32x4 x1 = acc[i][jn], x2 = acc[i][jn + 2];
                const f32x4 o1 = (x1 * c - x2 * s) * scale, o2 = (x2 * c + x1 * s) * scale;
                u32x2 w1, w2;
                w1.x = cvt_pk(o1.x, o1.y); w1.y = cvt_pk(o1.z, o1.w);
                w2.x = cvt_pk(o2.x, o2.y); w2.y = cvt_pk(o2.z, o2.w);
                bf16_t* dst = O + (size_t)m * ldo + col0 + wc * 64 + d;
                *(u32x2*)dst = w1;
                *(u32x2*)(dst + 32) = w2;
                if (isk) {
                    if (m < M_P) {
                        const int t = m & (SEQ - 1), b = m >> 13;
                        if (t >= SEQ - 128) {
                            float* o = out + O_BKP + ((size_t)(b * 128 + t - (SEQ - 128)) * 2 + wc) * 64 + d;
                            *(f32x4*)o = o1;
                            *(f32x4*)(o + 32) = o2;
                        }
                    } else {
                        float* o = out + O_BKS + ((size_t)((m - M_P) * 128 + 127) * 2 + wc) * 64 + d;
                        *(f32x4*)o = o1;
                        *(f32x4*)(o + 32) = o2;
                    }
                }
            }
        }
    }
};
struct EpiVt {
    bf16_t* Vt;
    float* out;
    __device__ __forceinline__ void operator()(f32x4 (&acc)[4][4], int m0, int n0, int wr, int wc, int lane) const {
        const int fr = lane & 15, fq = lane >> 4;
#pragma unroll
        for (int i = 0; i < 4; ++i) {
            const int m = m0 + wr * 64 + i * 16 + fq * 4;
#pragma unroll
            for (int jn = 0; jn < 4; ++jn) {
                const int d = jn * 16 + fr;
                const f32x4 a = acc[i][jn];
                if (m < M_P) {
                    const int t = m & (SEQ - 1), b = m >> 13;
                    u32x2 w;
                    w.x = cvt_pk(a.x, a.y);
                    w.y = cvt_pk(a.z, a.w);
                    *(u32x2*)(Vt + ((size_t)(b * 2 + wc) * 64 + d) * SEQ + t) = w;
                    if (t >= SEQ - 128) {
                        float* o = out + O_BVP + ((size_t)(b * 128 + t - (SEQ - 128)) * 2 + wc) * 64 + d;
                        o[0] = a.x; o[128] = a.y; o[256] = a.z; o[384] = a.w;
                    }
                } else {
                    float* o = out + O_BVS + ((size_t)((m - M_P) * 128 + 127) * 2 + wc) * 64 + d;
                    o[0] = a.x; o[16384] = a.y; o[32768] = a.z; o[49152] = a.w;
                }
            }
        }
    }
};

struct EpiB {
    bf16_t *Q, *SG, *KV;
    const float* rope;
    float* out;
    int nt;
    __device__ __forceinline__ void operator()(f32x4 (&acc)[4][4], int m0, int n0, int wr, int wc, int lane) const {
        const int fr = lane & 15, fq = lane >> 4;
        if (nt < 9) {
            const bool isk = (nt == 8);
            const float scale = isk ? 1.0f : 0.125f;
#pragma unroll
            for (int i = 0; i < 4; ++i) {
                const int m = m0 + wr * 64 + i * 16 + fr;
                const int pos = (m < M_P) ? (m & (SEQ - 1)) : SEQ;
                const float* rt = rope + (size_t)pos * 64;
                const int d = 8 * fq;
                f32x4 o1[2], o2[2];
#pragma unroll
                for (int jl = 0; jl < 2; ++jl) {
                    const f32x4 c = *(const f32x4*)(rt + d + 4 * jl), s = *(const f32x4*)(rt + 32 + d + 4 * jl);
                    const f32x4 x1 = acc[i][jl], x2 = acc[i][jl + 2];
                    o1[jl] = (x1 * c - x2 * s) * scale;
                    o2[jl] = (x2 * c + x1 * s) * scale;
                }
                u32x4 w1, w2;
                w1.x = cvt_pk(o1[0].x, o1[0].y); w1.y = cvt_pk(o1[0].z, o1[0].w); w1.z = cvt_pk(o1[1].x, o1[1].y); w1.w = cvt_pk(o1[1].z, o1[1].w);
                w2.x = cvt_pk(o2[0].x, o2[0].y); w2.y = cvt_pk(o2[0].z, o2[0].w); w2.z = cvt_pk(o2[1].x, o2[1].y); w2.w = cvt_pk(o2[1].z, o2[1].w);
                bf16_t* dst = isk ? KV + (size_t)m * 256 + wc * 64 + d : Q + (size_t)m * 1024 + nt * 128 + wc * 64 + d;
                *(u32x4*)dst = w1;
                *(u32x4*)(dst + 32) = w2;
                if (isk) {
                    float* o = nullptr;
                    if (m < M_P) {
                        const int t = m & (SEQ - 1), b = m >> 13;
                        if (t >= SEQ - 128) o = out + O_BKP + ((size_t)(b * 128 + t - (SEQ - 128)) * 2 + wc) * 64 + d;
                    } else o = out + O_BKS + ((size_t)((m - M_P) * 128 + 127) * 2 + wc) * 64 + d;
                    if (o) { *(f32x4*)o = o1[0]; *(f32x4*)(o + 4) = o1[1]; *(f32x4*)(o + 32) = o2[0]; *(f32x4*)(o + 36) = o2[1]; }
                }
            }
        } else if (nt == 9) {
#pragma unroll
            for (int i = 0; i < 4; ++i) {
                const int m = m0 + wr * 64 + i * 16 + fr;
                float* o = nullptr;
                if (m < M_P) {
                    const int t = m & (SEQ - 1), b = m >> 13;
                    if (t >= SEQ - 128) o = out + O_BVP + ((size_t)(b * 128 + t - (SEQ - 128)) * 2 + wc) * 64;
                } else o = out + O_BVS + ((size_t)((m - M_P) * 128 + 127) * 2 + wc) * 64;
#pragma unroll
                for (int g2 = 0; g2 < 2; ++g2) {
                    const int d = 32 * g2 + 8 * fq;
                    const f32x4 a = acc[i][2 * g2], b = acc[i][2 * g2 + 1];
                    u32x4 w;
                    w.x = cvt_pk(a.x, a.y); w.y = cvt_pk(a.z, a.w); w.z = cvt_pk(b.x, b.y); w.w = cvt_pk(b.z, b.w);
                    *(u32x4*)(KV + (size_t)m * 256 + 128 + wc * 64 + d) = w;
                    if (o) { *(f32x4*)(o + d) = a; *(f32x4*)(o + d + 4) = b; }
                }
            }
        } else {
#pragma unroll
            for (int i = 0; i < 4; ++i) {
                const int m = m0 + wr * 64 + i * 16 + fr;
#pragma unroll
                for (int g2 = 0; g2 < 2; ++g2) {
                    const f32x4 a = acc[i][2 * g2], b = acc[i][2 * g2 + 1];
                    u32x4 w;
                    w.x = cvt_pk(silu_f(a.x), silu_f(a.y)); w.y = cvt_pk(silu_f(a.z), silu_f(a.w));
                    w.z = cvt_pk(silu_f(b.x), silu_f(b.y)); w.w = cvt_pk(silu_f(b.z), silu_f(b.w));
                    *(u32x4*)(SG + (size_t)m * 1024 + (nt - 10) * 128 + wc * 64 + 32 * g2 + 8 * fq) = w;
                }
            }
        }
    }
};

__device__ __forceinline__ void b_in_phase(const Params& p, bf16_t* smem) {
    const bf16_t* H = (const bf16_t*)(p.ws + W_H);
    const bf16_t* Wt = (const bf16_t*)(p.ws + W_B_IN);
    bf16_t* Q = (bf16_t*)(p.ws + W_BUF1);
    bf16_t* SG = Q + (size_t)MT * 1024;
    bf16_t* KV = (bf16_t*)(p.ws + W_KB);
    const float* rope = (const float*)(p.ws + W_ROPE);
    Stage st;
    bool pre = false;
    for (int t = blockIdx.x; t < 129 * 18; t += gridDim.x) {
        const int mt = t < 2064 ? (t >> 4) : ((t - 2064) >> 1), nt = t < 2064 ? (t & 15) : 16 + ((t - 2064) & 1);
        const int tn = t + gridDim.x;
        const bool hn = tn < 129 * 18;
        const int mtn = tn < 2064 ? (tn >> 4) : ((tn - 2064) >> 1), ntn = tn < 2064 ? (tn & 15) : 16 + ((tn - 2064) & 1);
        EpiB e{Q, SG, KV, rope, p.out, nt};
        gemm_tile<true>(H, 1024, Wt, 1024, 1024, mt * 128, nt * 128, smem, e, st, pre, hn, H, Wt, mtn * 128, ntn * 128);
        pre = hn;
    }
}

constexpr int VT_LD = 256;
__device__ __forceinline__ void attn_prompt_item(const Params& p, int item, bf16_t* smem) {
    const int tid = threadIdx.x, w = tid >> 6, lane = tid & 63, fr = lane & 15, fq = lane >> 4;
    const int half = item & 1, kvh = (item >> 1) & 1, nb = (item >> 2) & 63, b = item >> 8;
    const bf16_t* Q = (const bf16_t*)(p.ws + W_BUF1);
    const bf16_t* SG = Q + (size_t)MT * 1024;
    const bf16_t* KV = (const bf16_t*)(p.ws + W_KB);
    bf16_t* Z = (bf16_t*)(p.ws + W_H);
    bf16_t* Ks = smem;
    bf16_t* Vs = smem + 16384;
    const int row0 = b * SEQ + nb * 128;
    __syncthreads();
#pragma unroll
    for (int i = 0; i < 8; ++i) {
        const int c = tid + 256 * i, key = c >> 3, kc = c & 7;
        u32x4 v = {0u, 0u, 0u, 0u};
        if (nb > 0 || key >= 128) v = *(const u32x4*)(KV + (size_t)(row0 - 128 + key) * 256 + kvh * 64 + kc * 8);
        *(u32x4*)(Ks + (kc >> 2) * 8192 + key * 32 + swz(key, kc & 3)) = v;
    }
#pragma unroll
    for (int i = 0; i < 8; ++i) {
        const int c = tid + 256 * i, key = c >> 3, dc = c & 7;
        u32x4 v = {0u, 0u, 0u, 0u};
        if (nb > 0 || key >= 128) v = *(const u32x4*)(KV + (size_t)(row0 - 128 + key) * 256 + 128 + kvh * 64 + dc * 8);
        const unsigned wv[4] = {v.x, v.y, v.z, v.w};
#pragma unroll
        for (int e = 0; e < 8; ++e) {
            const int d = dc * 8 + e;
            const unsigned short hv = (e & 1) ? (unsigned short)(wv[e >> 1] >> 16) : (unsigned short)(wv[e >> 1] & 0xffff);
            Vs[d * VT_LD + (((key >> 3) ^ ((d & 15) << 1)) << 3) + (key & 7)] = hv;
        }
    }
    __syncthreads();
    const int co = swz(fr, fq);
    bf16x8 qf[2];
    {
        const int gq = half * 8, h = kvh * 8 + (gq >> 1), qi = 32 * w + 16 * (gq & 1) + fr;
#pragma unroll
        for (int kk = 0; kk < 2; ++kk) qf[kk] = *(const bf16x8*)(Q + (size_t)(row0 + qi) * 1024 + h * 64 + kk * 32 + fq * 8);
    }
#pragma unroll 1
    for (int gq = half * 8; gq < half * 8 + 8; ++gq) {
        const int g = gq >> 1, qt = gq & 1;
        const int h = kvh * 8 + g;
        const float sink = p.in[15][h];
        const int qi = 32 * w + 16 * qt + fr;
        f32x4 s[10];
#pragma unroll
        for (int kt = 0; kt < 10; ++kt) s[kt] = (f32x4){0.f, 0.f, 0.f, 0.f};
#pragma unroll
        for (int kt = 0; kt < 10; ++kt) {
#pragma unroll
            for (int kk = 0; kk < 2; ++kk) {
                const bf16x8 kf = *(const bf16x8*)(Ks + kk * 8192 + (16 * (2 * w + kt) + fr) * 32 + co);
                s[kt] = __builtin_amdgcn_mfma_f32_16x16x32_bf16(kf, qf[kk], s[kt], 0, 0, 0);
            }
            if (kt & 1) __builtin_amdgcn_sched_barrier(0);
        }
        {
            const int gn = (gq + 1 < half * 8 + 8) ? gq + 1 : gq, hn = kvh * 8 + (gn >> 1), qn = 32 * w + 16 * (gn & 1) + fr;
#pragma unroll
            for (int kk = 0; kk < 2; ++kk) qf[kk] = *(const bf16x8*)(Q + (size_t)(row0 + qn) * 1024 + hn * 64 + kk * 32 + fq * 8);
        }
        float mx = sink;
#pragma unroll
        for (int kt = 0; kt < 10; ++kt) {
            const int key0 = 16 * (2 * w + kt) + fq * 4;
#pragma unroll
            for (int r = 0; r < 4; ++r) {
                const int key = key0 + r;
                const bool valid = (key >= qi) && (key <= qi + 128) && (nb > 0 || key >= 128);
                const float v = valid ? s[kt][r] : -1e30f;
                s[kt][r] = v;
                mx = fmaxf(mx, v);
            }
        }
        mx = fmaxf(mx, __shfl_xor(mx, 16));
        mx = fmaxf(mx, __shfl_xor(mx, 32));
        float sum = 0.f;
#pragma unroll
        for (int kt = 0; kt < 10; ++kt)
#pragma unroll
            for (int r = 0; r < 4; ++r) {
                const float e = __expf(s[kt][r] - mx);
                s[kt][r] = e;
                sum += e;
            }
        sum += __shfl_xor(sum, 16);
        sum += __shfl_xor(sum, 32);
        const float inv = __builtin_amdgcn_rcpf(sum + __expf(sink - mx));
        f32x4 o[4];
#pragma unroll
        for (int dt = 0; dt < 4; ++dt) o[dt] = (f32x4){0.f, 0.f, 0.f, 0.f};
#pragma unroll
        for (int ks = 0; ks < 5; ++ks) {
            u32x4 pw;
            pw.x = cvt_pk(s[2 * ks][0], s[2 * ks][1]);
            pw.y = cvt_pk(s[2 * ks][2], s[2 * ks][3]);
            pw.z = cvt_pk(s[2 * ks + 1][0], s[2 * ks + 1][1]);
            pw.w = cvt_pk(s[2 * ks + 1][2], s[2 * ks + 1][3]);
            const bf16x8 pf = __builtin_bit_cast(bf16x8, pw);
            const int kc0 = (((2 * w + 2 * ks) ^ fr) << 4) + fq * 4, kc1 = (((2 * w + 2 * ks + 1) ^ fr) << 4) + fq * 4;
#pragma unroll
            for (int dt = 0; dt < 4; ++dt) {
                const bf16_t* vp = Vs + (16 * dt + fr) * VT_LD;
                u32x4 vw;
                const u32x2 v0 = *(const u32x2*)(vp + kc0), v1 = *(const u32x2*)(vp + kc1);
                vw.x = v0.x; vw.y = v0.y; vw.z = v1.x; vw.w = v1.y;
                const bf16x8 vf = __builtin_bit_cast(bf16x8, vw);
                o[dt] = __builtin_amdgcn_mfma_f32_16x16x32_bf16(vf, pf, o[dt], 0, 0, 0);
            }
            __builtin_amdgcn_sched_barrier(0);
        }
        const size_t ro = (size_t)(row0 + qi) * 1024 + h * 64;
#pragma unroll
        for (int dt = 0; dt < 4; ++dt) {
            const int d = 16 * dt + fq * 4;
            const u32x2 sg = *(const u32x2*)(SG + ro + d);
            const f32x4 ov = o[dt] * inv;
            u32x2 wv;
            wv.x = cvt_pk(ov.x * bf_lo(sg.x), ov.y * bf_hi(sg.x));
            wv.y = cvt_pk(ov.z * bf_lo(sg.y), ov.w * bf_hi(sg.y));
            *(u32x2*)(Z + ro + d) = wv;
        }
    }
}

__device__ __forceinline__ void attn_sample_item(const Params& p, int item, unsigned char* smem_raw) {
    const int tid = threadIdx.x, g = tid >> 5, l = tid & 31;
    const int kvh = item & 1, b = item >> 1;
    const bf16_t* Q = (const bf16_t*)(p.ws + W_BUF1);
    const bf16_t* SG = Q + (size_t)MT * 1024;
    bf16_t* Z = (bf16_t*)(p.ws + W_H);
    float* kv = (float*)smem_raw;
    float* qs = kv + 129 * 65;
    float* ps = qs + 512;
    const float* ck = p.in[2];
    const float* cv = p.in[3];
    float* oks = p.out + O_BKS;
    float* ovs = p.out + O_BVS;
    const int row = M_P + b;
    __syncthreads();
    for (int idx = tid; idx < 129 * 64; idx += NTHREADS) {
        const int key = idx >> 6, d = idx & 63;
        float v;
        if (key < 128) {
            v = ck[((size_t)(b * 128 + key) * 2 + kvh) * 64 + d];
            if (key >= 1) oks[((size_t)(b * 128 + key - 1) * 2 + kvh) * 64 + d] = v;
        } else v = oks[((size_t)(b * 128 + 127) * 2 + kvh) * 64 + d];
        kv[key * 65 + d] = v;
    }
    for (int idx = tid; idx < 512; idx += NTHREADS) qs[idx] = bf2f(Q[(size_t)row * 1024 + kvh * 512 + idx]);
    __syncthreads();
    const int h = kvh * 8 + g;
    const float sink = p.in[15][h];
    float sc[5];
    float mx = sink;
#pragma unroll
    for (int i = 0; i < 5; ++i) {
        const int key = l + 32 * i;
        float a = -1e30f;
        if (key < 129) {
            a = 0.f;
#pragma unroll 8
            for (int d = 0; d < 64; ++d) a += qs[g * 64 + d] * kv[key * 65 + d];
        }
        sc[i] = a;
        mx = fmaxf(mx, a);
    }
#pragma unroll
    for (int o = 1; o < 32; o <<= 1) mx = fmaxf(mx, __shfl_xor(mx, o));
    float sum = 0.f;
#pragma unroll
    for (int i = 0; i < 5; ++i) {
        const int key = l + 32 * i;
        const float e = (key < 129) ? __expf(sc[i] - mx) : 0.f;
        sc[i] = e;
        sum += e;
    }
#pragma unroll
    for (int o = 1; o < 32; o <<= 1) sum += __shfl_xor(sum, o);
    const float inv = __builtin_amdgcn_rcpf(sum + __expf(sink - mx));
#pragma unroll
    for (int i = 0; i < 5; ++i) {
        const int key = l + 32 * i;
        if (key < 129) ps[g * 132 + key] = sc[i] * inv;
    }
    __syncthreads();
    for (int idx = tid; idx < 129 * 64; idx += NTHREADS) {
        const int key = idx >> 6, d = idx & 63;
        float v;
        if (key < 128) {
            v = cv[((size_t)(b * 128 + key) * 2 + kvh) * 64 + d];
            if (key >= 1) ovs[((size_t)(b * 128 + key - 1) * 2 + kvh) * 64 + d] = v;
        } else v = ovs[((size_t)(b * 128 + 127) * 2 + kvh) * 64 + d];
        kv[key * 65 + d] = v;
    }
    __syncthreads();
    float o0 = 0.f, o1 = 0.f;
    for (int key = 0; key < 129; ++key) {
        const float pv = ps[g * 132 + key];
        o0 += pv * kv[key * 65 + l];
        o1 += pv * kv[key * 65 + l + 32];
    }
    const size_t ro = (size_t)row * 1024 + h * 64;
    Z[ro + l] = (bf16_t)(cvt_pk(o0 * bf2f(SG[ro + l]), 0.f) & 0xffff);
    Z[ro + l + 32] = (bf16_t)(cvt_pk(o1 * bf2f(SG[ro + l + 32]), 0.f) & 0xffff);
}

__device__ __forceinline__ void b_attn_phase(const Params& p, unsigned char* smem_raw) {
    for (int it = blockIdx.x; it < 768; it += gridDim.x) {
        if (it < 512) attn_prompt_item(p, it, (bf16_t*)smem_raw);
        else attn_sample_item(p, it - 512, smem_raw);
    }
}

struct EpiAct {
    bf16_t* XR;
    int ldo, col0, act;
    __device__ __forceinline__ void operator()(f32x4 (&acc)[4][4], int m0, int n0, int wr, int wc, int lane) const {
        const int fr = lane & 15, fq = lane >> 4;
        bf16_t* O = act ? XR + (size_t)MT * 1024 - 1024 : XR;
#pragma unroll
        for (int i = 0; i < 4; ++i) {
            const int m = m0 + wr * 64 + i * 16 + fr;
#pragma unroll
            for (int g2 = 0; g2 < 2; ++g2) {
                f32x4 a = acc[i][2 * g2], b = acc[i][2 * g2 + 1];
                if (act) {
                    a.x = silu_f(a.x); a.y = silu_f(a.y); a.z = silu_f(a.z); a.w = silu_f(a.w);
                    b.x = silu_f(b.x); b.y = silu_f(b.y); b.z = silu_f(b.z); b.w = silu_f(b.w);
                }
                u32x4 w;
                w.x = cvt_pk(a.x, a.y); w.y = cvt_pk(a.z, a.w); w.z = cvt_pk(b.x, b.y); w.w = cvt_pk(b.z, b.w);
                *(u32x4*)(O + (size_t)m * ldo + col0 + wc * 64 + 32 * g2 + 8 * fq) = w;
            }
        }
    }
};
__device__ __forceinline__ void c_in_phase(const Params& p, bf16_t* smem) {
    const bf16_t* H = (const bf16_t*)(p.ws + W_H);
    const bf16_t* Wt = (const bf16_t*)(p.ws + W_C_IN);
    bf16_t* XR = (bf16_t*)(p.ws + W_BUF1);
    bf16_t* SG = XR + (size_t)MT * 1024;
    Stage st;
    bool pre = false;
    for (int t = blockIdx.x; t < 129 * 16; t += gridDim.x) {
        const int mt = t >> 4, nt = t & 15;
        const int tn = t + gridDim.x;
        const bool hn = tn < 129 * 16;
        EpiAct e{XR, 1024, nt * 128, nt >= 8};
        gemm_tile<true>(H, 1024, Wt, 1024, 1024, mt * 128, nt * 128, smem, e, st, pre, hn, H, Wt, (tn >> 4) * 128, (tn & 15) * 128);
        pre = hn;
    }
}

__device__ __forceinline__ void unpack8(const u32x4 v, float (&x)[8]) {
    x[0] = bf_lo(v.x); x[1] = bf_hi(v.x); x[2] = bf_lo(v.y); x[3] = bf_hi(v.y);
    x[4] = bf_lo(v.z); x[5] = bf_hi(v.z); x[6] = bf_lo(v.w); x[7] = bf_hi(v.w);
}

__device__ __forceinline__ void c_conv_phase(const Params& p) {
    const bf16_t* XR = (const bf16_t*)(p.ws + W_BUF1);
    bf16_t* XC = (bf16_t*)(p.ws + W_H);
    const float* cw = p.in[18];
    const float* cb = p.in[19];
    const float* st = p.in[4];
    const int gt = blockIdx.x * NTHREADS + threadIdx.x, gn = gridDim.x * NTHREADS;
    const int c0 = (gt & 127) * 8;
    float w0[8], w1[8], w2[8], w3[8], bias[8];
#pragma unroll
    for (int e = 0; e < 8; ++e) {
        w0[e] = cw[c0 + e]; w1[e] = cw[1024 + c0 + e]; w2[e] = cw[2048 + c0 + e]; w3[e] = cw[3072 + c0 + e]; bias[e] = cb[c0 + e];
    }
    for (int run = gt >> 7; run < M_P / 8; run += gn >> 7) {
        const int r0 = run * 8, t0 = r0 & (SEQ - 1), b = r0 >> 13;
        u32x4 raw[11];
#pragma unroll
        for (int q = 0; q < 11; ++q) {
            raw[q] = (u32x4){0u, 0u, 0u, 0u};
            if (q >= 3 || t0 > 0) raw[q] = *(const u32x4*)(XR + (size_t)(r0 - 3 + q) * 1024 + c0);
        }
        float x0[8], x1[8], x2[8], x3[8];
        unpack8(raw[0], x0); unpack8(raw[1], x1); unpack8(raw[2], x2);
#pragma unroll
        for (int q = 0; q < 8; ++q) {
            unpack8(raw[q + 3], x3);
            float acc[8];
#pragma unroll
            for (int e = 0; e < 8; ++e) acc[e] = bias[e] + x0[e] * w0[e] + x1[e] * w1[e] + x2[e] * w2[e] + x3[e] * w3[e];
            u32x4 o;
            o.x = cvt_pk(acc[0], acc[1]); o.y = cvt_pk(acc[2], acc[3]); o.z = cvt_pk(acc[4], acc[5]); o.w = cvt_pk(acc[6], acc[7]);
            *(u32x4*)(XC + (size_t)(r0 + q) * 1024 + c0) = o;
            const int t = t0 + q;
            if (t >= SEQ - 3) {
                float* oo = p.out + O_CCP + ((size_t)b * 3 + (t - (SEQ - 3))) * 1024 + c0;
#pragma unroll
                for (int e = 0; e < 8; ++e) oo[e] = x3[e];
            }
#pragma unroll
            for (int e = 0; e < 8; ++e) { x0[e] = x1[e]; x1[e] = x2[e]; x2[e] = x3[e]; }
        }
    }
    for (int b = gt >> 7; b < M_S; b += gn >> 7) {
        const int row = M_P + b;
        float xv[8], acc[8];
        unpack8(*(const u32x4*)(XR + (size_t)row * 1024 + c0), xv);
#pragma unroll
        for (int e = 0; e < 8; ++e) {
            const float s0 = st[((size_t)b * 3 + 0) * 1024 + c0 + e], s1 = st[((size_t)b * 3 + 1) * 1024 + c0 + e], s2 = st[((size_t)b * 3 + 2) * 1024 + c0 + e];
            acc[e] = bias[e] + s0 * w0[e] + s1 * w1[e] + s2 * w2[e] + xv[e] * w3[e];
            p.out[O_CCS + ((size_t)b * 3 + 0) * 1024 + c0 + e] = s1;
            p.out[O_CCS + ((size_t)b * 3 + 1) * 1024 + c0 + e] = s2;
            p.out[O_CCS + ((size_t)b * 3 + 2) * 1024 + c0 + e] = xv[e];
        }
        u32x4 o;
        o.x = cvt_pk(acc[0], acc[1]); o.y = cvt_pk(acc[2], acc[3]); o.z = cvt_pk(acc[4], acc[5]); o.w = cvt_pk(acc[6], acc[7]);
        *(u32x4*)(XC + (size_t)row * 1024 + c0) = o;
    }
}

struct EpiGate {
    const bf16_t* XC;
    float* Aa;
    bf16_t* Bb;
    const float *b_a, *b_x, *lam;
    int blk, nt;
    float* lds;
    float* carry;
    __device__ __forceinline__ void operator()(f32x4 (&acc)[4][4], int m0, int n0, int wr, int wc, int lane) const {
        const int fr = lane & 15, fq = lane >> 4;
        const bool prompt = (m0 < M_P);
        __syncthreads();
#pragma unroll
        for (int jn = 0; jn < 2; ++jn) {
            const int cl = 32 * wc + 8 * fq + 4 * jn;
            const int d = blk * 256 + 64 * nt + cl;
            const f32x4 ba = *(const f32x4*)(b_a + d), bx = *(const f32x4*)(b_x + d), lm = *(const f32x4*)(lam + d);
            f32x4 sp;
            sp.x = log1pf(__expf(-lm.x)); sp.y = log1pf(__expf(-lm.y)); sp.z = log1pf(__expf(-lm.z)); sp.w = log1pf(__expf(-lm.w));
#pragma unroll
            for (int i = 0; i < 4; ++i) {
                const int rl = wr * 64 + i * 16 + fr, m = m0 + rl;
                const bool first = (m < M_P) && ((m & (SEQ - 1)) == 0);
                const u32x2 xw = *(const u32x2*)(XC + (size_t)m * 1024 + d);
                const f32x4 xc = {bf_lo(xw.x), bf_hi(xw.x), bf_lo(xw.y), bf_hi(xw.y)};
                const f32x4 ra = acc[i][jn] + ba, ia = acc[i][jn + 2] + bx;
                f32x4 av, bv;
#pragma unroll
                for (int r = 0; r < 4; ++r) {
                    const float rg = sigmoid_f(ra[r]), ig = sigmoid_f(ia[r]);
                    const float la = -8.0f * rg * sp[r];
                    const float a = __expf(la);
                    av[r] = a;
                    const float mult = first ? 1.0f : __builtin_amdgcn_sqrtf(fmaxf(1.0f - a * a, 0.f));
                    bv[r] = mult * (ig * xc[r]);
                }
                *(f32x4*)(Aa + (size_t)m * 1024 + d) = av;
                u32x2 w;
                w.x = cvt_pk(bv.x, bv.y);
                w.y = cvt_pk(bv.z, bv.w);
                *(u32x2*)(Bb + (size_t)m * 1024 + d) = w;
                if (prompt) {
                    *(f32x4*)(lds + rl * 64 + cl) = av;
                    *(f32x4*)(lds + 8192 + rl * 64 + cl) = (f32x4){bf_lo(w.x), bf_hi(w.x), bf_lo(w.y), bf_hi(w.y)};
                }
            }
        }
        __syncthreads();
        if (prompt && threadIdx.x < 64) {
            float A = 1.f, h = 0.f;
#pragma unroll 16
            for (int r = 0; r < 128; ++r) {
                const float a = lds[r * 64 + threadIdx.x], b = lds[8192 + r * 64 + threadIdx.x];
                A *= a;
                h = a * h + b;
            }
            const int chunk = m0 >> 7, d = blk * 256 + 64 * nt + threadIdx.x;
            carry[(size_t)chunk * 2048 + d] = A;
            carry[(size_t)chunk * 2048 + 1024 + d] = h;
        }
    }
};

__device__ __forceinline__ void c_gate_phase(const Params& p, bf16_t* smem) {
    const bf16_t* XC = (const bf16_t*)(p.ws + W_H);
    const bf16_t* Wg = (const bf16_t*)(p.ws + W_C_G);
    float* Aa = (float*)(p.ws + W_BUF2);
    bf16_t* Bb = (bf16_t*)(p.ws + W_BUF1);
    Stage st;
    bool pre = false;
    for (int t = blockIdx.x; t < 129 * 16; t += gridDim.x) {
        const int mt = t >> 4, blk = (t >> 2) & 3, nt = t & 3;
        const int tn = t + gridDim.x, blkn = (tn >> 2) & 3;
        const bool hn = tn < 129 * 16;
        EpiGate e{XC, Aa, Bb, p.in[21], p.in[23], p.in[24], blk, nt, (float*)smem, (float*)(p.ws + W_CARRY)};
        gemm_tile<true>(XC + blk * 256, 1024, Wg + (size_t)blk * 512 * 256, 256, 256, mt * 128, nt * 128, smem, e, st, pre, hn,
                        XC + blkn * 256, Wg + (size_t)blkn * 512 * 256, (tn >> 4) * 128, (tn & 3) * 128);
        pre = hn;
    }
}

__device__ __forceinline__ void c_scan1_phase(const Params& p) {
    const float* Aa = (const float*)(p.ws + W_BUF2);
    const bf16_t* Bb = (const bf16_t*)(p.ws + W_BUF1);
    float* carry = (float*)(p.ws + W_CARRY);
    for (int it = blockIdx.x; it < 512; it += gridDim.x) {
        const int chunk = it >> 2, d = (it & 3) * 256 + threadIdx.x;
        float A = 1.f, h = 0.f;
        const size_t base = (size_t)chunk * 128 * 1024 + d;
#pragma unroll 8
        for (int r = 0; r < 128; ++r) {
            const float a = Aa[base + (size_t)r * 1024], b = bf2f(Bb[base + (size_t)r * 1024]);
            A *= a;
            h = a * h + b;
        }
        carry[(size_t)chunk * 2048 + d] = A;
        carry[(size_t)chunk * 2048 + 1024 + d] = h;
    }
}

__device__ __forceinline__ void c_scan2_phase(const Params& p) {
    const float* Aa = (const float*)(p.ws + W_BUF2);
    const bf16_t* Bb = (const bf16_t*)(p.ws + W_BUF1);
    const bf16_t* SG = Bb + (size_t)MT * 1024;
    const float* carry = (const float*)(p.ws + W_CARRY);
    bf16_t* Z = (bf16_t*)(p.ws + W_H);
    for (int it = blockIdx.x; it < 512 + 512; it += gridDim.x) {
        if (it < 512) {
            const int chunk = it >> 2, d = (it & 3) * 256 + threadIdx.x;
            const int b = chunk >> 6, ci = chunk & 63;
            float h = 0.f;
            {
                const float* c0 = carry + (size_t)(b * 64) * 2048 + d;
                int jc = 0;
                for (; jc + 16 <= ci; jc += 16) {
                    float ca[16], ch[16];
#pragma unroll
                    for (int q = 0; q < 16; ++q) { ca[q] = c0[(size_t)(jc + q) * 2048]; ch[q] = c0[(size_t)(jc + q) * 2048 + 1024]; }
#pragma unroll
                    for (int q = 0; q < 16; ++q) h = ca[q] * h + ch[q];
                }
                for (; jc < ci; ++jc) h = c0[(size_t)jc * 2048] * h + c0[(size_t)jc * 2048 + 1024];
            }
            const size_t base = (size_t)chunk * 128 * 1024 + d;
for (int r0 = 0; r0 < 128; r0 += 32) {
                float av[32];
                bf16_t bv[32], sv[32];
#pragma unroll
                for (int q = 0; q < 32; ++q) {
                    const size_t o = base + (size_t)(r0 + q) * 1024;
                    av[q] = Aa[o]; bv[q] = Bb[o]; sv[q] = SG[o];
                }
#pragma unroll
                for (int q = 0; q < 32; ++q) {
                    h = av[q] * h + bf2f(bv[q]);
                    Z[base + (size_t)(r0 + q) * 1024] = (bf16_t)(cvt_pk(h * bf2f(sv[q]), 0.f) & 0xffff);
                }
            }
            if (ci == 63) p.out[O_CHP + (size_t)b * 1024 + d] = h;
        } else {
            const int s = it - 512, d = (s & 3) * 256 + threadIdx.x, b = s >> 2;
            const size_t o = (size_t)(M_P + b) * 1024 + d;
            const float h = Aa[o] * p.in[5][(size_t)b * 1024 + d] + bf2f(Bb[o]);
            Z[o] = (bf16_t)(cvt_pk(h * bf2f(SG[o]), 0.f) & 0xffff);
            p.out[O_CHS + (size_t)b * 1024 + d] = h;
        }
    }
}

constexpr int N_PHASES = 20;

__device__ __forceinline__ void run_phase(const Params& p, int ph, unsigned char* smem_raw) {
    bf16_t* smem = (bf16_t*)smem_raw;
    float* Y = (float*)(p.ws + W_BUF2);
    float* YP = (float*)(p.ws + W_YPART);
    float* X = p.out + O_X;
    bf16_t* XB = (bf16_t*)(p.ws + W_XB);
    bf16_t* H = (bf16_t*)(p.ws + W_H);
    switch (ph) {
        case 0: prep_phase(p, smem_raw); break;
        case 1: a_in_phase(p, 0, smem); break;
        case 2: a_mix_phase(p, 0, smem); break;
        case 3: out_gemm_phase((const bf16_t*)(p.ws + W_BUF1), 2048, (const bf16_t*)(p.ws + W_A_OUT), Y, YP, smem); break;
        case 4: norm_phase(Y, YP, 8, p.in[0], p.in[1], XB, true, nullptr, p.in[7] + 0 * 1024, p.in[6] + 1 * 1024, H); break;
        case 5: b_in_phase(p, smem); break;
        case 6: b_attn_phase(p, smem_raw); break;
        case 7: out_gemm_phase(H, 1024, (const bf16_t*)(p.ws + W_B_OUT), Y, YP, smem); break;
        case 8: norm_phase(Y, YP, 4, nullptr, nullptr, XB, true, nullptr, p.in[7] + 1 * 1024, p.in[6] + 2 * 1024, H); break;
        case 9: c_in_phase(p, smem); break;
        case 10: c_conv_phase(p); break;
        case 11: c_gate_phase(p, smem); break;
        case 12: c_scan1_phase(p); break;
        case 13: c_scan2_phase(p); break;
        case 14: out_gemm_phase(H, 1024, (const bf16_t*)(p.ws + W_C_OUT), Y, YP, smem); break;
        case 15: norm_phase(Y, YP, 4, nullptr, nullptr, XB, true, nullptr, p.in[7] + 2 * 1024, p.in[6] + 3 * 1024, H); break;
        case 16: a_in_phase(p, 1, smem); break;
        case 17: a_mix_phase(p, 1, smem); break;
        case 18: out_gemm_phase((const bf16_t*)(p.ws + W_BUF1), 2048, (const bf16_t*)(p.ws + W_A_OUT) + (size_t)1024 * 2048, Y, YP, smem); break;
        case 19: norm_phase(Y, YP, 8, nullptr, nullptr, XB, false, X, p.in[7] + 3 * 1024, nullptr, H); break;
        default: break;
    }
}


#define XB_TMO      128
#define XB_XCNT(j)  (256  + 64 * (j))
#define XB_XSUB(j)  (1280 + 64 * (j))
#define XB_XGEN(j)  (2304 + 64 * (j))
#define XB_TOP      3328
#define XB_TOPGEN   3392
#define XCD_BAR_WORDS 3456
#define XB_SPIN_CAP (1u << 20)
__device__ __forceinline__ unsigned xb_ld(unsigned* p) { return __hip_atomic_load(p, __ATOMIC_RELAXED, __HIP_MEMORY_SCOPE_AGENT); }
__device__ __forceinline__ unsigned xb_add(unsigned* p, unsigned v) { return __hip_atomic_fetch_add(p, v, __ATOMIC_RELAXED, __HIP_MEMORY_SCOPE_AGENT); }
__device__ __forceinline__ unsigned xb_xcc_id() { return (unsigned)__builtin_amdgcn_s_getreg((3 << 11) | 20) & 0xFu; }
#define XB_SPIN(cond, bar) do { unsigned _sp = 0; while (cond) { __builtin_amdgcn_s_sleep(1); \
    if ((++_sp & 255u) == 0u) { if (xb_ld(&(bar)[XB_TMO])) break; if (_sp > XB_SPIN_CAP) { atomicAdd(&(bar)[XB_TMO], 1u); break; } } } } while (0)
struct XcdBarrier { unsigned* bar; unsigned x, nloc, nx; };
__device__ __forceinline__ void xcd_barrier_complete(unsigned* bar, unsigned x, unsigned& nloc, unsigned& nx) {
    const unsigned G = gridDim.x;
    unsigned sum, cnt, mine, sp = 0u;
    for (;;) {
        sum = 0u; cnt = 0u; mine = 0u;
#pragma unroll
        for (unsigned j = 0; j < 16; ++j) { const unsigned c = xb_ld(&bar[XB_XCNT(j)]); sum += c; cnt += (c > 0u) ? 1u : 0u; mine = (j == x) ? c : mine; }
        if (sum == G) break;
        __builtin_amdgcn_s_sleep(1);
        if ((++sp & 255u) == 0u) { if (xb_ld(&bar[XB_TMO])) break; if (sp > XB_SPIN_CAP) { atomicAdd(&bar[XB_TMO], 1u); break; } }
    }
    nloc = mine > 0u ? mine : 1u; nx = cnt > 0u ? cnt : 1u;
}
__device__ __forceinline__ void xcd_barrier(XcdBarrier& b) {
    asm volatile("s_waitcnt vmcnt(0)" ::: "memory");
    __syncthreads();
    if (threadIdx.x == 0) {
        unsigned* bar = b.bar;
        __builtin_amdgcn_s_waitcnt(0);
        if (b.nloc == 0u) xcd_barrier_complete(bar, b.x, b.nloc, b.nx);
        const unsigned nloc = b.nloc, nx = b.nx;
        const unsigned old = xb_add(&bar[XB_XSUB(b.x)], 1u);
        const unsigned gen = old / nloc;
        if (old + 1u == (gen + 1u) * nloc) {
            __builtin_amdgcn_fence(__ATOMIC_RELEASE, "agent");
            asm volatile("s_waitcnt vmcnt(0)" ::: "memory");
            const unsigned og = xb_add(&bar[XB_TOP], 1u);
            const unsigned tg = og / nx;
            if (og + 1u == (tg + 1u) * nx) xb_add(&bar[XB_TOPGEN], 1u);
            else XB_SPIN(xb_ld(&bar[XB_TOPGEN]) == tg, bar);
            __builtin_amdgcn_fence(__ATOMIC_ACQUIRE, "agent");
            xb_add(&bar[XB_XGEN(b.x)], 1u);
            asm volatile("s_waitcnt vmcnt(0)" ::: "memory");
        } else {
            XB_SPIN(xb_ld(&bar[XB_XGEN(b.x)]) == gen, bar);
            __builtin_amdgcn_fence(__ATOMIC_ACQUIRE, "agent");
            asm volatile("s_waitcnt vmcnt(0)" ::: "memory");
        }
    }
    __syncthreads();
}

#ifndef PROBE_K
#define PROBE_K 20
#endif
__device__ __forceinline__ void dump_phase(const Params& p) {
    const unsigned* base = (const unsigned*)(p.ws);
    const size_t nwords = W_END / 4, n = (size_t)MT * D;
    const size_t gt = (size_t)blockIdx.x * NTHREADS + threadIdx.x, gn = (size_t)gridDim.x * NTHREADS;
    for (size_t i = gt; i < n; i += gn) {
        float a = 0.f;
        for (int k = 0; k < 4; ++k) {
            const size_t w = i + (size_t)k * n;
            if (w < nwords) { const unsigned u = base[w]; a += (float)((u * 2654435761u) >> 29); }
        }
        p.out[i] = a;
    }
}
constexpr size_t W_BAR = W_END;
#define PHASE(i) if (p.ph_lo <= (i) && (i) < p.ph_hi) { if ((i) > p.ph_lo) xcd_barrier(xb); run_phase(p, (i), smem_raw); }
__global__ void __launch_bounds__(NTHREADS, 2) mega_kernel(Params p) {
    __shared__ __attribute__((aligned(16))) unsigned char smem_raw[SMEM_BYTES];
    XcdBarrier xb;
    xb.bar = (unsigned*)(p.ws + W_BAR); xb.x = xb_xcc_id(); xb.nloc = 0u; xb.nx = 0u;
    if (threadIdx.x == 0) (void)xb_add(&xb.bar[XB_XCNT(xb.x)], 1u);
    if (p.ph_lo < 0) cg::this_grid().sync();
    PHASE(0) PHASE(1) PHASE(2) PHASE(3) PHASE(4) PHASE(5) PHASE(6) PHASE(7) PHASE(8) PHASE(9)
    PHASE(10) PHASE(11) PHASE(13) PHASE(14) PHASE(15) PHASE(16) PHASE(17) PHASE(18) PHASE(19)
    if (ONE_LAUNCH && p.ph_hi < N_PHASES && p.ph_lo == 0) { xcd_barrier(xb); dump_phase(p); }
    if (!ONE_LAUNCH && p.ph_lo == N_PHASES) dump_phase(p);
}

extern "C" void kernel_launch(void* const* d_in, const int* in_sizes, int n_in, void* d_out, int out_size, void* d_ws, size_t ws_size,
                              hipStream_t stream) {
    static int grid = 0;
    if (grid == 0) {
        if (n_in != 26 || (size_t)out_size != O_END || ws_size < W_END + XCD_BAR_WORDS * 4) {
            fprintf(stderr, "kernel_launch: unexpected shapes n_in=%d out=%d ws=%zu (need %zu)\n", n_in, out_size, ws_size, (size_t)W_END);
            grid = -1;
            return;
        }
        int dev = 0, cus = 0, per_cu = 0;
        (void)hipGetDevice(&dev);
        (void)hipDeviceGetAttribute(&cus, hipDeviceAttributeMultiprocessorCount, dev);
        (void)hipOccupancyMaxActiveBlocksPerMultiprocessor(&per_cu, (const void*)mega_kernel, NTHREADS, 0);
        if (per_cu < 1) per_cu = 1;
        if (per_cu > 2) per_cu = 2;
        grid = cus * per_cu;
    }
    if (grid < 0) return;
    Params p{};
    for (int i = 0; i < 26; ++i) p.in[i] = (const float*)d_in[i];
    p.out = (float*)d_out;
    p.ws = (unsigned char*)d_ws;
#if ONE_LAUNCH
    (void)hipMemsetAsync((unsigned char*)d_ws + W_BAR, 0, XCD_BAR_WORDS * 4, stream);
    p.ph_lo = 0;
    p.ph_hi = PROBE_K;
    void* args[] = {&p};
    hipError_t e = hipLaunchCooperativeKernel((const void*)mega_kernel, dim3(grid), dim3(NTHREADS), args, 0, stream);
    if (e != hipSuccess) fprintf(stderr, "cooperative launch failed: %s (grid %d)\n", hipGetErrorString(e), grid);
#else
    for (int ph = 0; ph < N_PHASES; ++ph) {
        p.ph_lo = ph;
        p.ph_hi = ph + 1;
        hipLaunchKernelGGL(mega_kernel, dim3(grid), dim3(NTHREADS), 0, stream, p);
    }
#endif
}
```

```cpp
#include <hip/hip_runtime.h>
#include <hip/hip_cooperative_groups.h>
#include <stdint.h>
#include <stdio.h>
#include <math.h>
namespace cg = cooperative_groups;

#ifndef ONE_LAUNCH
#define ONE_LAUNCH 1
#endif

typedef unsigned short bf16_t;
typedef short bf16x8 __attribute__((ext_vector_type(8)));
typedef float f32x4 __attribute__((ext_vector_type(4)));
typedef unsigned u32x4 __attribute__((ext_vector_type(4)));
typedef unsigned u32x2 __attribute__((ext_vector_type(2)));

constexpr int M_P = 16384, M_S = 128, MT = 16512, D = 1024, SEQ = 8192;
constexpr int NTHREADS = 256;
constexpr int SMEM_BYTES = 65536;

constexpr size_t O_X = 0;
constexpr size_t O_AV = (size_t)MT * D;
constexpr size_t O_BKP = O_AV + 2 * 128 * 2048;
constexpr size_t O_BVP = O_BKP + 2 * 128 * 128;
constexpr size_t O_BKS = O_BVP + 2 * 128 * 128;
constexpr size_t O_BVS = O_BKS + 128 * 128 * 128;
constexpr size_t O_CCP = O_BVS + 128 * 128 * 128;
constexpr size_t O_CHP = O_CCP + 2 * 3 * 1024;
constexpr size_t O_CCS = O_CHP + 2 * 1024;
constexpr size_t O_CHS = O_CCS + 128 * 3 * 1024;
constexpr size_t O_END = O_CHS + 128 * 1024;

constexpr size_t W_A_IN = 0;
constexpr size_t W_A_OUT = W_A_IN + (size_t)2 * 6144 * 1024 * 2;
constexpr size_t W_B_IN = W_A_OUT + (size_t)2 * 1024 * 2048 * 2;
constexpr size_t W_B_OUT = W_B_IN + (size_t)2304 * 1024 * 2;
constexpr size_t W_C_IN = W_B_OUT + (size_t)1024 * 1024 * 2;
constexpr size_t W_C_G = W_C_IN + (size_t)2048 * 1024 * 2;
constexpr size_t W_C_OUT = W_C_G + (size_t)4 * 512 * 256 * 2;
constexpr size_t W_WS_A = W_C_OUT + (size_t)1024 * 1024 * 2;
constexpr size_t W_ROPE = W_WS_A + (size_t)2 * 4 * 128 * 128 * 2;
constexpr size_t W_H = W_ROPE + (size_t)8193 * 64 * 4;
constexpr size_t W_BUF1 = W_H + (size_t)MT * 1024 * 2;
constexpr size_t W_BUF2 = W_BUF1 + (size_t)MT * 2048 * 2;
constexpr size_t W_KB = W_BUF2 + (size_t)MT * 2048 * 2;
constexpr size_t W_STATS = W_KB;
constexpr size_t W_CARRY = W_KB + (size_t)MT * 256 * 2;
constexpr size_t W_YPART = W_CARRY + (size_t)128 * 1024 * 2 * 4;
constexpr size_t W_XB = W_YPART + (size_t)8 * 128 * 1024 * 4;
constexpr size_t W_END = W_XB + (size_t)MT * 1024 * 2;

struct Params {
    const float* in[26];
    float* out;
    unsigned char* ws;
    int ph_lo, ph_hi;
};

__device__ __forceinline__ unsigned cvt_pk(float lo, float hi) {
    unsigned r;
    asm("v_cvt_pk_bf16_f32 %0, %1, %2" : "=v"(r) : "v"(lo), "v"(hi));
    return r;
}
__device__ __forceinline__ float bf_lo(unsigned u) { return __uint_as_float(u << 16); }
__device__ __forceinline__ float bf_hi(unsigned u) { return __uint_as_float(u & 0xffff0000u); }
__device__ __forceinline__ float bf2f(bf16_t h) { return __uint_as_float(((unsigned)h) << 16); }
__device__ __forceinline__ float sigmoid_f(float x) { return __builtin_amdgcn_rcpf(1.f + __expf(-x)); }
__device__ __forceinline__ float silu_f(float x) { return x * sigmoid_f(x); }
__device__ __forceinline__ float gelu_f(float x) { return x * sigmoid_f(1.5957691216057308f * (x + 0.044715f * x * x * x)); }
__device__ __forceinline__ float gelu_silu(float u, float g) {
    const float eu = __expf(-1.5957691216057308f * (u + 0.044715f * u * u * u)), eg = __expf(-g);
    const float den = (1.f + eu) * (1.f + eg);
    return (u * g) * __builtin_amdgcn_rcpf(den);
}
template <int CTRL> __device__ __forceinline__ float dpp_add(float x) {
    return x + __builtin_bit_cast(float, __builtin_amdgcn_update_dpp(0, __builtin_bit_cast(int, x), CTRL, 0xF, 0xF, true));
}
__device__ __forceinline__ float row16_sum(float x) {
    x = dpp_add<0xB1>(x);
    x = dpp_add<0x4E>(x);
    x = dpp_add<0x141>(x);
    x = dpp_add<0x140>(x);
    return x;
}
__device__ __forceinline__ float wave_sum(float v) {
#pragma unroll
    for (int o = 1; o < 64; o <<= 1) v += __shfl_xor(v, o);
    return v;
}

__device__ __forceinline__ int perm32(int rho) { return 8 * ((rho & 15) >> 2) + 4 * (rho >> 4) + (rho & 3); }
__device__ __forceinline__ int permcol(int c) { return (c & ~31) + perm32(c & 31); }
__device__ __forceinline__ int swz(int row, int chunk) { return (chunk ^ (((row >> 3) & 1) << 1)) * 8; }

template <bool TRANS>
__device__ __forceinline__ void mma_stage(const bf16_t* As, const bf16_t* Bs, int apanel, int bpanel, f32x4 (&acc)[4][4], int wr, int wc, int lane) {
    const int fr = lane & 15, fq = lane >> 4;
    const int co = swz(fr, fq);
#pragma unroll
    for (int kk = 0; kk < 2; ++kk) {
        bf16x8 a[4], b[4];
#pragma unroll
        for (int i = 0; i < 4; ++i) {
            a[i] = *(const bf16x8*)(As + kk * apanel + (wr * 64 + i * 16 + fr) * 32 + co);
            b[i] = *(const bf16x8*)(Bs + kk * bpanel + (wc * 64 + i * 16 + fr) * 32 + co);
        }
#pragma unroll
        for (int i = 0; i < 4; ++i)
#pragma unroll
            for (int j = 0; j < 4; ++j)
                acc[i][j] = TRANS ? __builtin_amdgcn_mfma_f32_16x16x32_bf16(b[j], a[i], acc[i][j], 0, 0, 0)
                                  : __builtin_amdgcn_mfma_f32_16x16x32_bf16(a[i], b[j], acc[i][j], 0, 0, 0);
    }
}

__device__ __forceinline__ void g2r(const bf16_t* __restrict__ g, int ld, int row0, int k0, int tid, u32x4 (&r)[4]) {
    const int rl = 2 * (tid >> 4) + ((tid >> 2) & 1), kc = ((tid >> 3) & 1) * 4 + (tid & 3);
    const unsigned voff = (unsigned)(rl * ld + kc * 8) * 2u;
#pragma unroll
    for (int i = 0; i < 4; ++i) {
        const char* b = (const char*)(g + (size_t)(row0 + 32 * i) * ld + k0);
        r[i] = *(const u32x4*)(b + voff);
    }
}
__device__ __forceinline__ void r2s(bf16_t* s, int tid, const u32x4 (&r)[4]) {
    const int rl = 2 * (tid >> 4) + ((tid >> 2) & 1), kc = ((tid >> 3) & 1) * 4 + (tid & 3);
#pragma unroll
    for (int i = 0; i < 4; ++i) {
        const int row = rl + 32 * i;
        *(u32x4*)(s + (kc >> 2) * 4096 + row * 32 + swz(row, kc & 3)) = r[i];
    }
}

__device__ __forceinline__ void g2r32(const bf16_t* __restrict__ g, int ld, int row0, int k0, int tid, u32x4 (&r)[2]) {
    const unsigned voff = (unsigned)((tid >> 2) * ld + (tid & 3) * 8) * 2u;
#pragma unroll
    for (int i = 0; i < 2; ++i) {
        const char* b = (const char*)(g + (size_t)(row0 + 64 * i) * ld + k0);
        r[i] = *(const u32x4*)(b + voff);
    }
}
__device__ __forceinline__ void r2s32(bf16_t* s, int tid, const u32x4 (&r)[2]) {
#pragma unroll
    for (int i = 0; i < 2; ++i) {
        const int row = (tid >> 2) + 64 * i;
        *(u32x4*)(s + row * 32 + swz(row, tid & 3)) = r[i];
    }
}
__device__ __forceinline__ void ldfrag(const bf16_t* st, bf16x8 (&a)[4], bf16x8 (&b)[4], int wr, int wc, int fr, int co) {
#pragma unroll
    for (int i = 0; i < 4; ++i) {
        a[i] = *(const bf16x8*)(st + (wr * 64 + i * 16 + fr) * 32 + co);
        b[i] = *(const bf16x8*)(st + 4096 + (wc * 64 + i * 16 + fr) * 32 + co);
    }
}
template <bool TRANS>
__device__ __forceinline__ void mma16(const bf16x8 (&a)[4], const bf16x8 (&b)[4], f32x4 (&acc)[4][4]) {
    __builtin_amdgcn_s_setprio(1);
#pragma unroll
    for (int i = 0; i < 4; ++i)
#pragma unroll
        for (int j = 0; j < 4; ++j)
            acc[i][j] = TRANS ? __builtin_amdgcn_mfma_f32_16x16x32_bf16(b[j], a[i], acc[i][j], 0, 0, 0)
                              : __builtin_amdgcn_mfma_f32_16x16x32_bf16(a[i], b[j], acc[i][j], 0, 0, 0);
    __builtin_amdgcn_s_setprio(0);
}

struct Stage { u32x4 ra0[2], rb0[2], ra1[2], rb1[2]; };

template <bool TRANS, class Epi>
__device__ __forceinline__ void gemm_tile(const bf16_t* __restrict__ A, int lda, const bf16_t* __restrict__ Bt, int ldb, int K, int m0, int n0,
                                          bf16_t* smem, const Epi epi, Stage& st, bool pre, bool has_next, const bf16_t* __restrict__ An,
                                          const bf16_t* __restrict__ Bn, int m0n, int n0n) {
    const int tid = threadIdx.x, wid = tid >> 6, lane = tid & 63, wr = wid >> 1, wc = wid & 1, fr = lane & 15, fq = lane >> 4;
    const int co = swz(fr, fq);
    f32x4 acc[4][4];
#pragma unroll
    for (int i = 0; i < 4; ++i)
#pragma unroll
        for (int j = 0; j < 4; ++j) acc[i][j] = (f32x4){0.f, 0.f, 0.f, 0.f};
    const int nk = K >> 5;
    bf16x8 a0[4], b0[4], a1[4], b1[4];
    if (!pre) {
        g2r32(A, lda, m0, 0, tid, st.ra0);
        g2r32(Bt, ldb, n0, 0, tid, st.rb0);
        g2r32(A, lda, m0, 32, tid, st.ra1);
        g2r32(Bt, ldb, n0, 32, tid, st.rb1);
    }
    __syncthreads();
    r2s32(smem, tid, st.ra0);
    r2s32(smem + 4096, tid, st.rb0);
    r2s32(smem + 8192, tid, st.ra1);
    r2s32(smem + 8192 + 4096, tid, st.rb1);
    g2r32(A, lda, m0, 64, tid, st.ra0);
    g2r32(Bt, ldb, n0, 64, tid, st.rb0);
    g2r32(A, lda, m0, 96, tid, st.ra1);
    g2r32(Bt, ldb, n0, 96, tid, st.rb1);
    __syncthreads();
    ldfrag(smem, a0, b0, wr, wc, fr, co);
    for (int kt = 0; kt < nk; kt += 2) {
        {
            bf16_t* w = smem + ((kt + 2) & 3) * 8192;
            r2s32(w, tid, st.ra0);
            r2s32(w + 4096, tid, st.rb0);
            const int kn = (kt + 4 < nk ? kt + 4 : nk - 1) * 32;
            g2r32(A, lda, m0, kn, tid, st.ra0);
            g2r32(Bt, ldb, n0, kn, tid, st.rb0);
            ldfrag(smem + ((kt + 1) & 3) * 8192, a1, b1, wr, wc, fr, co);
            mma16<TRANS>(a0, b0, acc);
            __syncthreads();
        }
        {
            bf16_t* w = smem + ((kt + 3) & 3) * 8192;
            r2s32(w, tid, st.ra1);
            r2s32(w + 4096, tid, st.rb1);
            const int kn = (kt + 5 < nk ? kt + 5 : nk - 1) * 32;
            g2r32(A, lda, m0, kn, tid, st.ra1);
            g2r32(Bt, ldb, n0, kn, tid, st.rb1);
            ldfrag(smem + ((kt + 2) & 3) * 8192, a0, b0, wr, wc, fr, co);
            mma16<TRANS>(a1, b1, acc);
            __syncthreads();
        }
    }
    if (has_next) {
        g2r32(An, lda, m0n, 0, tid, st.ra0);
        g2r32(Bn, ldb, n0n, 0, tid, st.rb0);
        g2r32(An, lda, m0n, 32, tid, st.ra1);
        g2r32(Bn, ldb, n0n, 32, tid, st.rb1);
    }
    epi(acc, m0, n0, wr, wc, lane);
}

__device__ __forceinline__ void wt_tile(const float* colptr, int ldsrc, bf16_t* dst, int ldd, float* tile, int tid) {
    const int tx = tid & 63, ty = tid >> 6;
    float v[16];
#pragma unroll
    for (int q = 0; q < 16; ++q) v[q] = colptr[(size_t)(ty + 4 * q) * ldsrc];
#pragma unroll
    for (int q = 0; q < 16; ++q) tile[(ty + 4 * q) * 65 + tx] = v[q];
    __syncthreads();
    const int c2 = tid & 31, r0 = tid >> 5;
#pragma unroll
    for (int rr = r0; rr < 64; rr += 8)
        *(unsigned*)(dst + (size_t)rr * ldd + 2 * c2) = cvt_pk(tile[(2 * c2) * 65 + rr], tile[(2 * c2 + 1) * 65 + rr]);
    __syncthreads();
}

__device__ __forceinline__ void sincos_d(double x, double& s, double& c) {
    const double k = rint(x * 0.63661977236758134308);
    double r = fma(-k, 1.57079632673412561417e+00, x);
    r = fma(-k, 6.07710050650619224932e-11, r);
    const double z = r * r;
    const double sp = r + r * z * (-1.66666666666666324348e-01 + z * (8.33333333332248946124e-03 + z * (-1.98412698298579493134e-04 + z * (2.75573137070700676789e-06 + z * (-2.50507602534068634195e-08 + z * 1.58969099521155010221e-10)))));
    const double cp = 1.0 - 0.5 * z + z * z * (4.16666666666666019037e-02 + z * (-1.38888888888741095749e-03 + z * (2.48015872894767294178e-05 + z * (-2.75573143513906633035e-07 + z * (2.08757232129817482790e-09 + z * -1.13596475577881948265e-11)))));
    const int q = ((int)k) & 3;
    s = (q == 0) ? sp : (q == 1) ? cp : (q == 2) ? -sp : -cp;
    c = (q == 0) ? cp : (q == 1) ? -sp : (q == 2) ? -cp : sp;
}

__device__ __forceinline__ void norm_phase(const float* __restrict__ Y, const float* __restrict__ Ypart, int nsplit, const float* xin_p, const float* xin_s,
                                           bf16_t* Xb, bool storeXb, float* Xf, const float* gpost, const float* gpre, bf16_t* H) {
    const int lane = threadIdx.x & 63;
    const int gw = blockIdx.x * 4 + (threadIdx.x >> 6), nw = gridDim.x * 4;
    for (int row = gw; row < MT; row += nw) {
        f32x4 x[4];
        if (xin_p) {
            const float* xr = row < M_P ? xin_p + (size_t)row * D : xin_s + (size_t)(row - M_P) * D;
#pragma unroll
            for (int j = 0; j < 4; ++j) x[j] = *(const f32x4*)(xr + j * 256 + lane * 4);
        } else {
#pragma unroll
            for (int j = 0; j < 4; ++j) {
                const u32x2 w = *(const u32x2*)(Xb + (size_t)row * D + j * 256 + lane * 4);
                x[j] = (f32x4){bf_lo(w.x), bf_hi(w.x), bf_lo(w.y), bf_hi(w.y)};
            }
        }
        if (Y) {
            f32x4 y[4];
            float ss = 0.f;
            if (row < M_P) {
#pragma unroll
                for (int j = 0; j < 4; ++j) {
                    const u32x2 w = *(const u32x2*)((const bf16_t*)Y + (size_t)row * D + j * 256 + lane * 4);
                    y[j] = (f32x4){bf_lo(w.x), bf_hi(w.x), bf_lo(w.y), bf_hi(w.y)};
                }
            } else {
#pragma unroll
                for (int j = 0; j < 4; ++j) y[j] = (f32x4){0.f, 0.f, 0.f, 0.f};
                for (int s = 0; s < nsplit; ++s) {
#pragma unroll
                    for (int j = 0; j < 4; ++j) y[j] += *(const f32x4*)(Ypart + ((size_t)s * 128 + (row - M_P)) * D + j * 256 + lane * 4);
                }
            }
#pragma unroll
            for (int j = 0; j < 4; ++j) ss += y[j].x * y[j].x + y[j].y * y[j].y + y[j].z * y[j].z + y[j].w * y[j].w;
            ss = wave_sum(ss);
            const float rstd = rsqrtf(ss * (1.f / 1024.f) + 1e-6f);
#pragma unroll
            for (int j = 0; j < 4; ++j) {
                const f32x4 g = *(const f32x4*)(gpost + j * 256 + lane * 4);
                x[j] = x[j] + y[j] * rstd * g;
            }
        }
        if (storeXb) {
#pragma unroll
            for (int j = 0; j < 4; ++j) {
                u32x2 w;
                w.x = cvt_pk(x[j].x, x[j].y);
                w.y = cvt_pk(x[j].z, x[j].w);
                *(u32x2*)(Xb + (size_t)row * D + j * 256 + lane * 4) = w;
            }
        }
        if (Xf) {
#pragma unroll
            for (int j = 0; j < 4; ++j) *(f32x4*)(Xf + (size_t)row * D + j * 256 + lane * 4) = x[j];
        }
        if (gpre) {
            float ss = 0.f;
#pragma unroll
            for (int j = 0; j < 4; ++j) ss += x[j].x * x[j].x + x[j].y * x[j].y + x[j].z * x[j].z + x[j].w * x[j].w;
            ss = wave_sum(ss);
            const float rstd = rsqrtf(ss * (1.f / 1024.f) + 1e-6f);
#pragma unroll
            for (int j = 0; j < 4; ++j) {
                const f32x4 g = *(const f32x4*)(gpre + j * 256 + lane * 4);
                const f32x4 h = x[j] * rstd * g;
                u32x2 w;
                w.x = cvt_pk(h.x, h.y);
                w.y = cvt_pk(h.z, h.w);
                *(u32x2*)(H + (size_t)row * D + j * 256 + lane * 4) = w;
            }
        }
    }
}

constexpr int WT_FIRST = 96 * 16;
constexpr int WT_TOTAL = 2 * 96 * 16 + 2 * 16 * 32 + 36 * 16 + 256 + 32 * 16 + 128 + 256;
__device__ __forceinline__ void wt_jobs(const Params& p, unsigned char* smem, int lo, int hi, int w, int nw) {
    float* tile = (float*)smem;
    const int tid = threadIdx.x, tx = tid & 63;
    constexpr int T_AIN = 96 * 16, T_AOUT = 16 * 32, T_BIN = 36 * 16, T_BOUT = 256, T_CIN = 32 * 16, T_CG = 128, T_COUT = 256;
    for (int it = lo + w; it < hi; it += nw) {
        int r = it;
        if (r < 2 * T_AIN) {
            const int j = r / T_AIN; r -= j * T_AIN;
            const int nt = r >> 4, kt = r & 15, np = permcol(nt * 64 + tx);
            int col;
            const int T = np >> 7, w = np & 127;
            if (T < 32) {
                const int wc = w >> 6, jn = (w >> 4) & 3, i = w & 15;
                col = ((jn < 2) ? 0 : 4096) + 64 * T + 32 * wc + 16 * (jn & 1) + i;
            } else col = 2048 + (np - 4096);
            wt_tile(p.in[8] + (size_t)j * 1024 * 6144 + (size_t)(kt * 64) * 6144 + col, 6144,
                    (bf16_t*)(p.ws + W_A_IN) + (size_t)j * 6144 * 1024 + (size_t)(nt * 64) * 1024 + kt * 64, 1024, tile, tid);
            continue;
        }
        r -= 2 * T_AIN;
        if (r < 2 * T_AOUT) {
            const int j = r / T_AOUT; r -= j * T_AOUT;
            const int nt = r >> 5, kt = r & 31;
            wt_tile(p.in[13] + (size_t)j * 2048 * 1024 + (size_t)(kt * 64) * 1024 + permcol(nt * 64 + tx), 1024,
                    (bf16_t*)(p.ws + W_A_OUT) + (size_t)j * 1024 * 2048 + (size_t)(nt * 64) * 2048 + kt * 64, 2048, tile, tid);
            continue;
        }
        r -= 2 * T_AOUT;
        if (r < T_BIN) {
            const int nt = r >> 4, kt = r & 15;
            wt_tile(p.in[14] + (size_t)(kt * 64) * 2304 + permcol(nt * 64 + tx), 2304, (bf16_t*)(p.ws + W_B_IN) + (size_t)(nt * 64) * 1024 + kt * 64, 1024, tile, tid);
            continue;
        }
        r -= T_BIN;
        if (r < T_BOUT) {
            const int nt = r >> 4, kt = r & 15;
            wt_tile(p.in[16] + (size_t)(kt * 64) * 1024 + permcol(nt * 64 + tx), 1024, (bf16_t*)(p.ws + W_B_OUT) + (size_t)(nt * 64) * 1024 + kt * 64, 1024, tile, tid);
            continue;
        }
        r -= T_BOUT;
        if (r < T_CIN) {
            const int nt = r >> 4, kt = r & 15;
            wt_tile(p.in[17] + (size_t)(kt * 64) * 2048 + permcol(nt * 64 + tx), 2048, (bf16_t*)(p.ws + W_C_IN) + (size_t)(nt * 64) * 1024 + kt * 64, 1024, tile, tid);
            continue;
        }
        r -= T_CIN;
        if (r < T_CG) {
            const int blk = r >> 5, rr = r & 31, nt = rr >> 2, kt = rr & 3;
            const int np = permcol(nt * 64 + tx), j4 = np >> 7, w = np & 127, wc = w >> 6, jn = (w >> 4) & 3, i = w & 15;
            const int dl = 64 * j4 + 32 * wc + 16 * (jn & 1) + i;
            const float* src = ((jn < 2) ? p.in[20] : p.in[22]) + (size_t)blk * 65536;
            wt_tile(src + (size_t)(kt * 64) * 256 + dl, 256, (bf16_t*)(p.ws + W_C_G) + (size_t)blk * 512 * 256 + (size_t)(nt * 64) * 256 + kt * 64, 256, tile, tid);
            continue;
        }
        r -= T_CG;
        {
            const int nt = r >> 4, kt = r & 15;
            wt_tile(p.in[24 + 1] + (size_t)(kt * 64) * 1024 + permcol(nt * 64 + tx), 1024, (bf16_t*)(p.ws + W_C_OUT) + (size_t)(nt * 64) * 1024 + kt * 64, 1024, tile, tid);
        }
    }
}

__device__ __forceinline__ void prep_phase(const Params& p, unsigned char* smem) {
    const int tid = threadIdx.x;
    wt_jobs(p, smem, 0, WT_FIRST, blockIdx.x, gridDim.x);
    const int gt = blockIdx.x * NTHREADS + tid, gn = gridDim.x * NTHREADS;
    {
        bf16_t* wsa = (bf16_t*)(p.ws + W_WS_A);
        const float* src = p.in[11];
        for (int idx = gt; idx < 2 * 4 * 128 * 128 / 2; idx += gn) {
            const int e = idx * 2, t = (e >> 7) & 127, s = e & 127;
            const float a = (s <= t) ? src[e] : 0.f, b = (s + 1 <= t) ? src[e + 1] : 0.f;
            *(unsigned*)(wsa + e) = cvt_pk(a, b);
        }
    }
    {
        float* rt = (float*)(p.ws + W_ROPE);
        for (int idx = gt; idx < 8193 * 32; idx += gn) {
            const int pos = idx >> 5, i = idx & 31;
            const float ang = (float)pos * exp2f(-(float)i * (13.287712379549449f / 32.0f));
            double s, c;
            sincos_d((double)ang, s, c);
            rt[pos * 64 + i] = (float)c;
            rt[pos * 64 + 32 + i] = (float)s;
        }
    }
    norm_phase(nullptr, nullptr, 0, p.in[0], p.in[1], nullptr, false, nullptr, nullptr, p.in[6], (bf16_t*)(p.ws + W_H));
}

struct EpiUG {
    bf16_t* P;
    int T;
    __device__ __forceinline__ void operator()(f32x4 (&acc)[4][4], int m0, int n0, int wr, int wc, int lane) const {
        const int fr = lane & 15, fq = lane >> 4;
#pragma unroll
        for (int i = 0; i < 4; ++i) {
            const int m = m0 + wr * 64 + i * 16 + fr;
            const int ch = 64 * T + 32 * wc + 8 * fq;
            u32x4 w;
            {
                const f32x4 u = acc[i][0], g = acc[i][2];
                w.x = cvt_pk(gelu_silu(u.x, g.x), gelu_silu(u.y, g.y));
                w.y = cvt_pk(gelu_silu(u.z, g.z), gelu_silu(u.w, g.w));
            }
            {
                const f32x4 u = acc[i][1], g = acc[i][3];
                w.z = cvt_pk(gelu_silu(u.x, g.x), gelu_silu(u.y, g.y));
                w.w = cvt_pk(gelu_silu(u.z, g.z), gelu_silu(u.w, g.w));
            }
            *(u32x4*)(P + (size_t)m * 2048 + ch) = w;
        }
    }
};
struct EpiV {
    bf16_t* GVt;
    float* stats;
    int mt, tv;
    __device__ __forceinline__ void operator()(f32x4 (&acc)[4][4], int m0, int n0, int wr, int wc, int lane) const {
        const int fr = lane & 15, fq = lane >> 4;
#pragma unroll
        for (int i = 0; i < 4; ++i) {
            const int sl = wr * 64 + i * 16 + fq * 4;
            f32x4 sum = {0.f, 0.f, 0.f, 0.f}, sq = {0.f, 0.f, 0.f, 0.f};
#pragma unroll
            for (int jn = 0; jn < 4; ++jn) {
                const int ch = 128 * tv + wc * 64 + 32 * (jn >> 1) + perm32(16 * (jn & 1) + fr);
                f32x4 v = acc[i][jn];
                v.x = gelu_f(v.x); v.y = gelu_f(v.y); v.z = gelu_f(v.z); v.w = gelu_f(v.w);
                u32x2 w;
                w.x = cvt_pk(v.x, v.y);
                w.y = cvt_pk(v.z, v.w);
                *(u32x2*)(GVt + ((size_t)mt * 2048 + ch) * 128 + sl) = w;
                sum += v;
                sq += v * v;
            }
            sum.x = row16_sum(sum.x); sum.y = row16_sum(sum.y); sum.z = row16_sum(sum.z); sum.w = row16_sum(sum.w);
            sq.x = row16_sum(sq.x); sq.y = row16_sum(sq.y); sq.z = row16_sum(sq.z); sq.w = row16_sum(sq.w);
            if (fr == 0) {
                float* st = stats + (size_t)(m0 + sl) * 64 + (tv * 2 + wc) * 2;
                st[0] = sum.x; st[1] = sq.x;
                st[64] = sum.y; st[65] = sq.y;
                st[128] = sum.z; st[129] = sq.z;
                st[192] = sum.w; st[193] = sq.w;
            }
        }
    }
};

__device__ __forceinline__ void a_in_phase(const Params& p, int j, bf16_t* smem) {
    const bf16_t* H = (const bf16_t*)(p.ws + W_H);
    const bf16_t* Wt = (const bf16_t*)(p.ws + W_A_IN) + (size_t)j * 6144 * 1024;
    bf16_t* P = (bf16_t*)(p.ws + W_BUF1);
    bf16_t* GVt = (bf16_t*)(p.ws + W_BUF2);
    float* stats = (float*)(p.ws + W_STATS);
    Stage st;
    bool pre = false;
    for (int t = blockIdx.x; t < 129 * 48; t += gridDim.x) {
        const int mt = t / 48, nt = t % 48;
        const int tn = t + gridDim.x;
        const bool hn = tn < 129 * 48;
        const int m0n = (tn / 48) * 128, n0n = (tn % 48) * 128;
        if (nt < 32) {
            EpiUG e{P, nt};
            gemm_tile<true>(H, 1024, Wt, 1024, 1024, mt * 128, nt * 128, smem, e, st, pre, hn, H, Wt, m0n, n0n);
        } else {
            EpiV e{GVt, stats, mt, nt - 32};
            gemm_tile<false>(H, 1024, Wt, 1024, 1024, mt * 128, nt * 128, smem, e, st, pre, hn, H, Wt, m0n, n0n);
        }
        pre = hn;
    }
    if (j == 0) {
        const int busy = (129 * 48) % gridDim.x, idle = gridDim.x - busy;
        if (idle > 0 && (int)blockIdx.x >= busy) wt_jobs(p, (unsigned char*)smem, WT_FIRST, WT_TOTAL, blockIdx.x - busy, idle);
        else if (idle <= 0) wt_jobs(p, (unsigned char*)smem, WT_FIRST, WT_TOTAL, blockIdx.x, gridDim.x);
    }
}

__device__ __forceinline__ void a_mix_phase(const Params& p, int j, bf16_t* smem) {
    const int tid = threadIdx.x, wid = tid >> 6, lane = tid & 63, wr = wid >> 1, wc = wid & 1, fr = lane & 15, fq = lane >> 4;
    bf16_t* P = (bf16_t*)(p.ws + W_BUF1);
    const bf16_t* GVt = (const bf16_t*)(p.ws + W_BUF2);
    const float* stats = (const float*)(p.ws + W_STATS);
    const bf16_t* wsa = (const bf16_t*)(p.ws + W_WS_A) + (size_t)j * 4 * 128 * 128;
    const float* ln_g = p.in[9] + j * 2048;
    const float* ln_b = p.in[10] + j * 2048;
    const float* b_s = p.in[12] + j * 4 * 128;
    const float* w_s = p.in[11] + (size_t)j * 4 * 128 * 128;
    float* av_out = p.out + O_AV + (size_t)j * 128 * 2048;
    bf16_t* As = smem;
    bf16_t* Bs = smem + 16384;
    float* mu = (float*)(smem + 16384);
    float* rs = mu + 128;
    for (int it = blockIdx.x; it < 129 * 16; it += gridDim.x) {
        const int chunk = it >> 4, g = (it >> 2) & 3, slab = it & 3;
        const bool samp = (chunk == 128);
        f32x4 sv[8];
        {
            const float* stp = stats + (size_t)(chunk * 128 + (tid >> 1)) * 64 + (tid & 1) * 32;
#pragma unroll
            for (int k = 0; k < 8; ++k) sv[k] = *(const f32x4*)(stp + k * 4);
        }
        u32x4 araw[8], braw[8];
        float lg[8], lb[8];
        const float w00 = w_s[g * 16384];
        {
            const bf16_t* wg = wsa + g * 16384;
#pragma unroll
            for (int i = 0; i < 8; ++i) {
                const int c = tid + 256 * i, row = c >> 4, sc = c & 15;
                araw[i] = (u32x4){0u, 0u, 0u, 0u};
                if (!samp) araw[i] = *(const u32x4*)(wg + row * 128 + sc * 8);
                const int ch = g * 512 + slab * 128 + permcol(row);
                braw[i] = *(const u32x4*)(GVt + ((size_t)chunk * 2048 + ch) * 128 + sc * 8);
                lg[i] = ln_g[ch];
                lb[i] = ln_b[ch];
            }
        }
        float s = 0.f, q = 0.f;
#pragma unroll
        for (int k = 0; k < 8; ++k) { s += sv[k].x + sv[k].z; q += sv[k].y + sv[k].w; }
        s += __shfl_xor(s, 1);
        q += __shfl_xor(q, 1);
        const float mean = s * (1.f / 2048.f);
        const float var = fmaxf(q * (1.f / 2048.f) - mean * mean, 0.f);
        __syncthreads();
        if ((tid & 1) == 0) { mu[tid >> 1] = mean; rs[tid >> 1] = rsqrtf(var + 1e-5f); }
        if (samp) {
#pragma unroll
            for (int i = 0; i < 8; ++i) {
                const int c = tid + 256 * i, row = c >> 4, sc = c & 15;
                if ((row >> 3) == sc) {
                    const unsigned lo = cvt_pk(w00, 0.f), hi = cvt_pk(0.f, w00);
                    const int e = row & 7;
                    const unsigned val = (e & 1) ? hi : lo;
                    if ((e >> 1) == 0) araw[i].x = val; else if ((e >> 1) == 1) araw[i].y = val; else if ((e >> 1) == 2) araw[i].z = val; else araw[i].w = val;
                }
            }
        }
#pragma unroll
        for (int i = 0; i < 8; ++i) {
            const int c = tid + 256 * i, row = c >> 4, sc = c & 15;
            *(u32x4*)(As + (sc >> 2) * 4096 + row * 32 + swz(row, sc & 3)) = araw[i];
        }
        __syncthreads();
        float mur[8], rsr[8];
#pragma unroll
        for (int e = 0; e < 8; ++e) { mur[e] = mu[(tid & 15) * 8 + e]; rsr[e] = rs[(tid & 15) * 8 + e]; }
        __syncthreads();
#pragma unroll
        for (int i = 0; i < 8; ++i) {
            const int c = tid + 256 * i, n = c >> 4, sc = c & 15;
            const int ch = g * 512 + slab * 128 + permcol(n);
            const u32x4 v = braw[i];
            float x[8];
            x[0] = bf_lo(v.x); x[1] = bf_hi(v.x); x[2] = bf_lo(v.y); x[3] = bf_hi(v.y);
            x[4] = bf_lo(v.z); x[5] = bf_hi(v.z); x[6] = bf_lo(v.w); x[7] = bf_hi(v.w);
#pragma unroll
            for (int e = 0; e < 8; ++e) x[e] = (x[e] - mur[e]) * rsr[e] * lg[i] + lb[i];
            if (samp) {
#pragma unroll
                for (int e = 0; e < 8; ++e) av_out[(size_t)(sc * 8 + e) * 2048 + ch] = x[e];
            }
            u32x4 o;
            o.x = cvt_pk(x[0], x[1]); o.y = cvt_pk(x[2], x[3]); o.z = cvt_pk(x[4], x[5]); o.w = cvt_pk(x[6], x[7]);
            *(u32x4*)(Bs + (sc >> 2) * 4096 + n * 32 + swz(n, sc & 3)) = o;
        }
        __syncthreads();
        f32x4 acc[4][4];
#pragma unroll
        for (int i = 0; i < 4; ++i)
#pragma unroll
            for (int jn = 0; jn < 4; ++jn) acc[i][jn] = (f32x4){0.f, 0.f, 0.f, 0.f};
        u32x4 pvv[4][2];
#pragma unroll
        for (int i = 0; i < 4; ++i)
#pragma unroll
            for (int g2 = 0; g2 < 2; ++g2)
                pvv[i][g2] = *(const u32x4*)(P + (size_t)(chunk * 128 + wr * 64 + i * 16 + fr) * 2048 + g * 512 + slab * 128 + wc * 64 + 32 * g2 + 8 * fq);
        mma_stage<true>(As, Bs, 4096, 4096, acc, wr, wc, lane);
        mma_stage<true>(As + 8192, Bs + 8192, 4096, 4096, acc, wr, wc, lane);
#pragma unroll
        for (int i = 0; i < 4; ++i) {
            const int t = wr * 64 + i * 16 + fr;
            const float bs = b_s[g * 128 + (samp ? 0 : t)];
            const size_t rowoff = (size_t)(chunk * 128 + t) * 2048 + g * 512 + slab * 128;
#pragma unroll
            for (int g2 = 0; g2 < 2; ++g2) {
                bf16_t* pp = P + rowoff + wc * 64 + 32 * g2 + 8 * fq;
                const u32x4 pv = pvv[i][g2];
                const f32x4 a = acc[i][2 * g2], b = acc[i][2 * g2 + 1];
                u32x4 w;
                w.x = cvt_pk(bf_lo(pv.x) * (a.x + bs), bf_hi(pv.x) * (a.y + bs));
                w.y = cvt_pk(bf_lo(pv.y) * (a.z + bs), bf_hi(pv.y) * (a.w + bs));
                w.z = cvt_pk(bf_lo(pv.z) * (b.x + bs), bf_hi(pv.z) * (b.y + bs));
                w.w = cvt_pk(bf_lo(pv.w) * (b.z + bs), bf_hi(pv.w) * (b.w + bs));
                *(u32x4*)pp = w;
            }
        }
    }
}

struct EpiY {
    bf16_t* Yb;
    float* Yp;
    __device__ __forceinline__ void operator()(f32x4 (&acc)[4][4], int m0, int n0, int wr, int wc, int lane) const {
        const int fr = lane & 15, fq = lane >> 4;
        const bool part = (m0 == M_P);
#pragma unroll
        for (int i = 0; i < 4; ++i) {
            const int m = m0 + wr * 64 + i * 16 + fr;
#pragma unroll
            for (int g2 = 0; g2 < 2; ++g2) {
                const int n = n0 + wc * 64 + 32 * g2 + 8 * fq;
                const f32x4 a = acc[i][2 * g2], b = acc[i][2 * g2 + 1];
                if (part) {
                    float* o = Yp + (size_t)(m - M_P) * 1024 + n;
                    *(f32x4*)o = a;
                    *(f32x4*)(o + 4) = b;
                } else {
                    u32x4 w;
                    w.x = cvt_pk(a.x, a.y); w.y = cvt_pk(a.z, a.w); w.z = cvt_pk(b.x, b.y); w.w = cvt_pk(b.z, b.w);
                    *(u32x4*)(Yb + (size_t)m * 1024 + n) = w;
                }
            }
        }
    }
};
__device__ __forceinline__ void out_gemm_phase(const bf16_t* A, int K, const bf16_t* Wt, float* Y, float* Ypart, bf16_t* smem) {
    const int nsplit = K >> 8;
    const int ntile = 1024 + 8 * nsplit;
    Stage st;
    bool pre = false;
    for (int t = blockIdx.x; t < ntile; t += gridDim.x) {
        const bool full = t < 1024;
        const int u = t - 1024, ks = full ? 0 : (u >> 3);
        const int m0 = full ? (t >> 3) * 128 : M_P, n0 = (full ? (t & 7) : (u & 7)) * 128, Kt = full ? K : 256;
        const int tn = t + gridDim.x;
        const bool hn = tn < ntile, fulln = tn < 1024;
        const int un = tn - 1024, ksn = fulln ? 0 : (un >> 3);
        const int m0n = fulln ? (tn >> 3) * 128 : M_P, n0n = (fulln ? (tn & 7) : (un & 7)) * 128;
        EpiY e{(bf16_t*)Y, Ypart + (size_t)ks * 128 * 1024};
        gemm_tile<true>(A + ks * 256, K, Wt + ks * 256, K, Kt, m0, n0, smem, e, st, pre, hn, A + ksn * 256, Wt + ksn * 256, m0n, n0n);
        pre = hn;
    }
}

struct EpiSilu {
    bf16_t* O;
    int ldo, col0;
    __device__ __forceinline__ void operator()(f32x4 (&acc)[4][4], int m0, int n0, int wr, int wc, int lane) const {
        const int fr = lane & 15, fq = lane >> 4;
#pragma unroll
        for (int i = 0; i < 4; ++i) {
            const int m = m0 + wr * 64 + i * 16 + fr;
#pragma unroll
            for (int jn = 0; jn < 4; ++jn) {
                const f32x4 a = acc[i][jn];
                u32x2 w;
                w.x = cvt_pk(silu_f(a.x), silu_f(a.y));
                w.y = cvt_pk(silu_f(a.z), silu_f(a.w));
                *(u32x2*)(O + (size_t)m * ldo + col0 + wc * 64 + jn * 16 + fq * 4) = w;
            }
        }
    }
};
struct EpiCopy {
    bf16_t* O;
    int ldo, col0;
    __device__ __forceinline__ void operator()(f32x4 (&acc)[4][4], int m0, int n0, int wr, int wc, int lane) const {
        const int fr = lane & 15, fq = lane >> 4;
#pragma unroll
        for (int i = 0; i < 4; ++i) {
            const int m = m0 + wr * 64 + i * 16 + fr;
#pragma unroll
            for (int jn = 0; jn < 4; ++jn) {
                const f32x4 a = acc[i][jn];
                u32x2 w;
                w.x = cvt_pk(a.x, a.y);
                w.y = cvt_pk(a.z, a.w);
                *(u32x2*)(O + (size_t)m * ldo + col0 + wc * 64 + jn * 16 + fq * 4) = w;
            }
        }
    }
};
template <int isk> struct EpiRope {
    bf16_t* O;
    int ldo, col0;
    const float* rope;
    float* out;
    __device__ __forceinline__ void operator()(f32x4 (&acc)[4][4], int m0, int n0, int wr, int wc, int lane) const {
        const int fr = lane & 15, fq = lane >> 4;
#pragma unroll
        for (int i = 0; i < 4; ++i) {
            const int m = m0 + wr * 64 + i * 16 + fr;
            const int pos = (m < M_P) ? (m & (SEQ - 1)) : SEQ;
            const float* rt = rope + (size_t)pos * 64;
            const float scale = isk ? 1.0f : 0.125f;
#pragma unroll
            for (int jn = 0; jn < 2; ++jn) {
                const int d = jn * 16 + fq * 4;
                const f32x4 c = *(const f32x4*)(rt + d), s = *(const f32x4*)(rt + 32 + d);
                const f32x4 x1 = acc[i][jn], x2 = acc[i][jn + 2];
                const f32x4 o1 = (x1 * c - x2 * s) * scale, o2 = (x2 * c + x1 * s) * scale;
                u32x2 w1, w2;
                w1.x = cvt_pk(o1.x, o1.y); w1.y = cvt_pk(o1.z, o1.w);
                w2.x = cvt_pk(o2.x, o2.y); w2.y = cvt_pk(o2.z, o2.w);
                bf16_t* dst = O + (size_t)m * ldo + col0 + wc * 64 + d;
                *(u32x2*)dst = w1;
                *(u32x2*)(dst + 32) = w2;
                if (isk) {
                    if (m < M_P) {
                        const int t = m & (SEQ - 1), b = m >> 13;
                        if (t >= SEQ - 128) {
                            float* o = out + O_BKP + ((size_t)(b * 128 + t - (SEQ - 128)) * 2 + wc) * 64 + d;
                            *(f32x4*)o = o1;
                            *(f32x4*)(o + 32) = o2;
                        }
                    } else {
                        float* o = out + O_BKS + ((size_t)((m - M_P) * 128 + 127) * 2 + wc) * 64 + d;
                        *(f32x4*)o = o1;
                        *(f32x4*)(o + 32) = o2;
                    }
                }
            }
        }
    }
};
struct EpiVt {
    bf16_t* Vt;
    float* out;
    __device__ __forceinline__ void operator()(f32x4 (&acc)[4][4], int m0, int n0, int wr, int wc, int lane) const {
        const int fr = lane & 15, fq = lane >> 4;
#pragma unroll
        for (int i = 0; i < 4; ++i) {
            const int m = m0 + wr * 64 + i * 16 + fq * 4;
#pragma unroll
            for (int jn = 0; jn < 4; ++jn) {
                const int d = jn * 16 + fr;
                const f32x4 a = acc[i][jn];
                if (m < M_P) {
                    const int t = m & (SEQ - 1), b = m >> 13;
                    u32x2 w;
                    w.x = cvt_pk(a.x, a.y);
                    w.y = cvt_pk(a.z, a.w);
                    *(u32x2*)(Vt + ((size_t)(b * 2 + wc) * 64 + d) * SEQ + t) = w;
                    if (t >= SEQ - 128) {
                        float* o = out + O_BVP + ((size_t)(b * 128 + t - (SEQ - 128)) * 2 + wc) * 64 + d;
                        o[0] = a.x; o[128] = a.y; o[256] = a.z; o[384] = a.w;
                    }
                } else {
                    float* o = out + O_BVS + ((size_t)((m - M_P) * 128 + 127) * 2 + wc) * 64 + d;
                    o[0] = a.x; o[16384] = a.y; o[32768] = a.z; o[49152] = a.w;
                }
            }
        }
    }
};

struct EpiB {
    bf16_t *Q, *SG, *KV;
    const float* rope;
    float* out;
    int nt;
    __device__ __forceinline__ void operator()(f32x4 (&acc)[4][4], int m0, int n0, int wr, int wc, int lane) const {
        const int fr = lane & 15, fq = lane >> 4;
        if (nt < 9) {
            const bool isk = (nt == 8);
            const float scale = isk ? 1.0f : 0.125f;
#pragma unroll
            for (int i = 0; i < 4; ++i) {
                const int m = m0 + wr * 64 + i * 16 + fr;
                const int pos = (m < M_P) ? (m & (SEQ - 1)) : SEQ;
                const float* rt = rope + (size_t)pos * 64;
                const int d = 8 * fq;
                f32x4 o1[2], o2[2];
#pragma unroll
                for (int jl = 0; jl < 2; ++jl) {
                    const f32x4 c = *(const f32x4*)(rt + d + 4 * jl), s = *(const f32x4*)(rt + 32 + d + 4 * jl);
                    const f32x4 x1 = acc[i][jl], x2 = acc[i][jl + 2];
                    o1[jl] = (x1 * c - x2 * s) * scale;
                    o2[jl] = (x2 * c + x1 * s) * scale;
                }
                u32x4 w1, w2;
                w1.x = cvt_pk(o1[0].x, o1[0].y); w1.y = cvt_pk(o1[0].z, o1[0].w); w1.z = cvt_pk(o1[1].x, o1[1].y); w1.w = cvt_pk(o1[1].z, o1[1].w);
                w2.x = cvt_pk(o2[0].x, o2[0].y); w2.y = cvt_pk(o2[0].z, o2[0].w); w2.z = cvt_pk(o2[1].x, o2[1].y); w2.w = cvt_pk(o2[1].z, o2[1].w);
                bf16_t* dst = isk ? KV + (size_t)m * 256 + wc * 64 + d : Q + (size_t)m * 1024 + nt * 128 + wc * 64 + d;
                *(u32x4*)dst = w1;
                *(u32x4*)(dst + 32) = w2;
                if (isk) {
                    float* o = nullptr;
                    if (m < M_P) {
                        const int t = m & (SEQ - 1), b = m >> 13;
                        if (t >= SEQ - 128) o = out + O_BKP + ((size_t)(b * 128 + t - (SEQ - 128)) * 2 + wc) * 64 + d;
                    } else o = out + O_BKS + ((size_t)((m - M_P) * 128 + 127) * 2 + wc) * 64 + d;
                    if (o) { *(f32x4*)o = o1[0]; *(f32x4*)(o + 4) = o1[1]; *(f32x4*)(o + 32) = o2[0]; *(f32x4*)(o + 36) = o2[1]; }
                }
            }
        } else if (nt == 9) {
#pragma unroll
            for (int i = 0; i < 4; ++i) {
                const int m = m0 + wr * 64 + i * 16 + fr;
                float* o = nullptr;
                if (m < M_P) {
                    const int t = m & (SEQ - 1), b = m >> 13;
                    if (t >= SEQ - 128) o = out + O_BVP + ((size_t)(b * 128 + t - (SEQ - 128)) * 2 + wc) * 64;
                } else o = out + O_BVS + ((size_t)((m - M_P) * 128 + 127) * 2 + wc) * 64;
#pragma unroll
                for (int g2 = 0; g2 < 2; ++g2) {
                    const int d = 32 * g2 + 8 * fq;
                    const f32x4 a = acc[i][2 * g2], b = acc[i][2 * g2 + 1];
                    u32x4 w;
                    w.x = cvt_pk(a.x, a.y); w.y = cvt_pk(a.z, a.w); w.z = cvt_pk(b.x, b.y); w.w = cvt_pk(b.z, b.w);
                    *(u32x4*)(KV + (size_t)m * 256 + 128 + wc * 64 + d) = w;
                    if (o) { *(f32x4*)(o + d) = a; *(f32x4*)(o + d + 4) = b; }
                }
            }
        } else {
#pragma unroll
            for (int i = 0; i < 4; ++i) {
                const int m = m0 + wr * 64 + i * 16 + fr;
#pragma unroll
                for (int g2 = 0; g2 < 2; ++g2) {
                    const f32x4 a = acc[i][2 * g2], b = acc[i][2 * g2 + 1];
                    u32x4 w;
                    w.x = cvt_pk(silu_f(a.x), silu_f(a.y)); w.y = cvt_pk(silu_f(a.z), silu_f(a.w));
                    w.z = cvt_pk(silu_f(b.x), silu_f(b.y)); w.w = cvt_pk(silu_f(b.z), silu_f(b.w));
                    *(u32x4*)(SG + (size_t)m * 1024 + (nt - 10) * 128 + wc * 64 + 32 * g2 + 8 * fq) = w;
                }
            }
        }
    }
};

__device__ __forceinline__ void b_in_phase(const Params& p, bf16_t* smem) {
    const bf16_t* H = (const bf16_t*)(p.ws + W_H);
    const bf16_t* Wt = (const bf16_t*)(p.ws + W_B_IN);
    bf16_t* Q = (bf16_t*)(p.ws + W_BUF1);
    bf16_t* SG = Q + (size_t)MT * 1024;
    bf16_t* KV = (bf16_t*)(p.ws + W_KB);
    const float* rope = (const float*)(p.ws + W_ROPE);
    Stage st;
    bool pre = false;
    for (int t = blockIdx.x; t < 129 * 18; t += gridDim.x) {
        const int mt = t < 2064 ? (t >> 4) : ((t - 2064) >> 1), nt = t < 2064 ? (t & 15) : 16 + ((t - 2064) & 1);
        const int tn = t + gridDim.x;
        const bool hn = tn < 129 * 18;
        const int mtn = tn < 2064 ? (tn >> 4) : ((tn - 2064) >> 1), ntn = tn < 2064 ? (tn & 15) : 16 + ((tn - 2064) & 1);
        EpiB e{Q, SG, KV, rope, p.out, nt};
        gemm_tile<true>(H, 1024, Wt, 1024, 1024, mt * 128, nt * 128, smem, e, st, pre, hn, H, Wt, mtn * 128, ntn * 128);
        pre = hn;
    }
}

constexpr int VT_LD = 256;
__device__ __forceinline__ void attn_prompt_item(const Params& p, int item, bf16_t* smem) {
    const int tid = threadIdx.x, w = tid >> 6, lane = tid & 63, fr = lane & 15, fq = lane >> 4;
    const int half = item & 1, kvh = (item >> 1) & 1, nb = (item >> 2) & 63, b = item >> 8;
    const bf16_t* Q = (const bf16_t*)(p.ws + W_BUF1);
    const bf16_t* SG = Q + (size_t)MT * 1024;
    const bf16_t* KV = (const bf16_t*)(p.ws + W_KB);
    bf16_t* Z = (bf16_t*)(p.ws + W_H);
    bf16_t* Ks = smem;
    bf16_t* Vs = smem + 16384;
    const int row0 = b * SEQ + nb * 128;
    __syncthreads();
#pragma unroll
    for (int i = 0; i < 8; ++i) {
        const int c = tid + 256 * i, key = c >> 3, kc = c & 7;
        u32x4 v = {0u, 0u, 0u, 0u};
        if (nb > 0 || key >= 128) v = *(const u32x4*)(KV + (size_t)(row0 - 128 + key) * 256 + kvh * 64 + kc * 8);
        *(u32x4*)(Ks + (kc >> 2) * 8192 + key * 32 + swz(key, kc & 3)) = v;
    }
#pragma unroll
    for (int i = 0; i < 8; ++i) {
        const int c = tid + 256 * i, key = c >> 3, dc = c & 7;
        u32x4 v = {0u, 0u, 0u, 0u};
        if (nb > 0 || key >= 128) v = *(const u32x4*)(KV + (size_t)(row0 - 128 + key) * 256 + 128 + kvh * 64 + dc * 8);
        const unsigned wv[4] = {v.x, v.y, v.z, v.w};
#pragma unroll
        for (int e = 0; e < 8; ++e) {
            const int d = dc * 8 + e;
            const unsigned short hv = (e & 1) ? (unsigned short)(wv[e >> 1] >> 16) : (unsigned short)(wv[e >> 1] & 0xffff);
            Vs[d * VT_LD + (((key >> 3) ^ ((d & 15) << 1)) << 3) + (key & 7)] = hv;
        }
    }
    __syncthreads();
    const int co = swz(fr, fq);
    bf16x8 qf[2];
    {
        const int gq = half * 8, h = kvh * 8 + (gq >> 1), qi = 32 * w + 16 * (gq & 1) + fr;
#pragma unroll
        for (int kk = 0; kk < 2; ++kk) qf[kk] = *(const bf16x8*)(Q + (size_t)(row0 + qi) * 1024 + h * 64 + kk * 32 + fq * 8);
    }
#pragma unroll 1
    for (int gq = half * 8; gq < half * 8 + 8; ++gq) {
        const int g = gq >> 1, qt = gq & 1;
        const int h = kvh * 8 + g;
        const float sink = p.in[15][h];
        const int qi = 32 * w + 16 * qt + fr;
        f32x4 s[10];
#pragma unroll
        for (int kt = 0; kt < 10; ++kt) s[kt] = (f32x4){0.f, 0.f, 0.f, 0.f};
#pragma unroll
        for (int kt = 0; kt < 10; ++kt) {
#pragma unroll
            for (int kk = 0; kk < 2; ++kk) {
                const bf16x8 kf = *(const bf16x8*)(Ks + kk * 8192 + (16 * (2 * w + kt) + fr) * 32 + co);
                s[kt] = __builtin_amdgcn_mfma_f32_16x16x32_bf16(kf, qf[kk], s[kt], 0, 0, 0);
            }
            if (kt & 1) __builtin_amdgcn_sched_barrier(0);
        }
        {
            const int gn = (gq + 1 < half * 8 + 8) ? gq + 1 : gq, hn = kvh * 8 + (gn >> 1), qn = 32 * w + 16 * (gn & 1) + fr;
#pragma unroll
            for (int kk = 0; kk < 2; ++kk) qf[kk] = *(const bf16x8*)(Q + (size_t)(row0 + qn) * 1024 + hn * 64 + kk * 32 + fq * 8);
        }
        float mx = sink;
#pragma unroll
        for (int kt = 0; kt < 10; ++kt) {
            const int key0 = 16 * (2 * w + kt) + fq * 4;
#pragma unroll
            for (int r = 0; r < 4; ++r) {
                const int key = key0 + r;
                const bool valid = (key >= qi) && (key <= qi + 128) && (nb > 0 || key >= 128);
                const float v = valid ? s[kt][r] : -1e30f;
                s[kt][r] = v;
                mx = fmaxf(mx, v);
            }
        }
        mx = fmaxf(mx, __shfl_xor(mx, 16));
        mx = fmaxf(mx, __shfl_xor(mx, 32));
        float sum = 0.f;
#pragma unroll
        for (int kt = 0; kt < 10; ++kt)
#pragma unroll
            for (int r = 0; r < 4; ++r) {
                const float e = __expf(s[kt][r] - mx);
                s[kt][r] = e;
                sum += e;
            }
        sum += __shfl_xor(sum, 16);
        sum += __shfl_xor(sum, 32);
        const float inv = __builtin_amdgcn_rcpf(sum + __expf(sink - mx));
        f32x4 o[4];
#pragma unroll
        for (int dt = 0; dt < 4; ++dt) o[dt] = (f32x4){0.f, 0.f, 0.f, 0.f};
#pragma unroll
        for (int ks = 0; ks < 5; ++ks) {
            u32x4 pw;
            pw.x = cvt_pk(s[2 * ks][0], s[2 * ks][1]);
            pw.y = cvt_pk(s[2 * ks][2], s[2 * ks][3]);
            pw.z = cvt_pk(s[2 * ks + 1][0], s[2 * ks + 1][1]);
            pw.w = cvt_pk(s[2 * ks + 1][2], s[2 * ks + 1][3]);
            const bf16x8 pf = __builtin_bit_cast(bf16x8, pw);
            const int kc0 = (((2 * w + 2 * ks) ^ fr) << 4) + fq * 4, kc1 = (((2 * w + 2 * ks + 1) ^ fr) << 4) + fq * 4;
#pragma unroll
            for (int dt = 0; dt < 4; ++dt) {
                const bf16_t* vp = Vs + (16 * dt + fr) * VT_LD;
                u32x4 vw;
                const u32x2 v0 = *(const u32x2*)(vp + kc0), v1 = *(const u32x2*)(vp + kc1);
                vw.x = v0.x; vw.y = v0.y; vw.z = v1.x; vw.w = v1.y;
                const bf16x8 vf = __builtin_bit_cast(bf16x8, vw);
                o[dt] = __builtin_amdgcn_mfma_f32_16x16x32_bf16(vf, pf, o[dt], 0, 0, 0);
            }
            __builtin_amdgcn_sched_barrier(0);
        }
        const size_t ro = (size_t)(row0 + qi) * 1024 + h * 64;
#pragma unroll
        for (int dt = 0; dt < 4; ++dt) {
            const int d = 16 * dt + fq * 4;
            const u32x2 sg = *(const u32x2*)(SG + ro + d);
            const f32x4 ov = o[dt] * inv;
            u32x2 wv;
            wv.x = cvt_pk(ov.x * bf_lo(sg.x), ov.y * bf_hi(sg.x));
            wv.y = cvt_pk(ov.z * bf_lo(sg.y), ov.w * bf_hi(sg.y));
            *(u32x2*)(Z + ro + d) = wv;
        }
    }
}

__device__ __forceinline__ void attn_sample_item(const Params& p, int item, unsigned char* smem_raw) {
    const int tid = threadIdx.x, g = tid >> 5, l = tid & 31;
    const int kvh = item & 1, b = item >> 1;
    const bf16_t* Q = (const bf16_t*)(p.ws + W_BUF1);
    const bf16_t* SG = Q + (size_t)MT * 1024;
    bf16_t* Z = (bf16_t*)(p.ws + W_H);
    float* kv = (float*)smem_raw;
    float* qs = kv + 129 * 65;
    float* ps = qs + 512;
    const float* ck = p.in[2];
    const float* cv = p.in[3];
    float* oks = p.out + O_BKS;
    float* ovs = p.out + O_BVS;
    const int row = M_P + b;
    __syncthreads();
    for (int idx = tid; idx < 129 * 64; idx += NTHREADS) {
        const int key = idx >> 6, d = idx & 63;
        float v;
        if (key < 128) {
            v = ck[((size_t)(b * 128 + key) * 2 + kvh) * 64 + d];
            if (key >= 1) oks[((size_t)(b * 128 + key - 1) * 2 + kvh) * 64 + d] = v;
        } else v = oks[((size_t)(b * 128 + 127) * 2 + kvh) * 64 + d];
        kv[key * 65 + d] = v;
    }
    for (int idx = tid; idx < 512; idx += NTHREADS) qs[idx] = bf2f(Q[(size_t)row * 1024 + kvh * 512 + idx]);
    __syncthreads();
    const int h = kvh * 8 + g;
    const float sink = p.in[15][h];
    float sc[5];
    float mx = sink;
#pragma unroll
    for (int i = 0; i < 5; ++i) {
        const int key = l + 32 * i;
        float a = -1e30f;
        if (key < 129) {
            a = 0.f;
#pragma unroll 8
            for (int d = 0; d < 64; ++d) a += qs[g * 64 + d] * kv[key * 65 + d];
        }
        sc[i] = a;
        mx = fmaxf(mx, a);
    }
#pragma unroll
    for (int o = 1; o < 32; o <<= 1) mx = fmaxf(mx, __shfl_xor(mx, o));
    float sum = 0.f;
#pragma unroll
    for (int i = 0; i < 5; ++i) {
        const int key = l + 32 * i;
        const float e = (key < 129) ? __expf(sc[i] - mx) : 0.f;
        sc[i] = e;
        sum += e;
    }
#pragma unroll
    for (int o = 1; o < 32; o <<= 1) sum += __shfl_xor(sum, o);
    const float inv = __builtin_amdgcn_rcpf(sum + __expf(sink - mx));
#pragma unroll
    for (int i = 0; i < 5; ++i) {
        const int key = l + 32 * i;
        if (key < 129) ps[g * 132 + key] = sc[i] * inv;
    }
    __syncthreads();
    for (int idx = tid; idx < 129 * 64; idx += NTHREADS) {
        const int key = idx >> 6, d = idx & 63;
        float v;
        if (key < 128) {
            v = cv[((size_t)(b * 128 + key) * 2 + kvh) * 64 + d];
            if (key >= 1) ovs[((size_t)(b * 128 + key - 1) * 2 + kvh) * 64 + d] = v;
        } else v = ovs[((size_t)(b * 128 + 127) * 2 + kvh) * 64 + d];
        kv[key * 65 + d] = v;
    }
    __syncthreads();
    float o0 = 0.f, o1 = 0.f;
    for (int key = 0; key < 129; ++key) {
        const float pv = ps[g * 132 + key];
        o0 += pv * kv[key * 65 + l];
        o1 += pv * kv[key * 65 + l + 32];
    }
    const size_t ro = (size_t)row * 1024 + h * 64;
    Z[ro + l] = (bf16_t)(cvt_pk(o0 * bf2f(SG[ro + l]), 0.f) & 0xffff);
    Z[ro + l + 32] = (bf16_t)(cvt_pk(o1 * bf2f(SG[ro + l + 32]), 0.f) & 0xffff);
}

__device__ __forceinline__ void b_attn_phase(const Params& p, unsigned char* smem_raw) {
    for (int it = blockIdx.x; it < 768; it += gridDim.x) {
        if (it < 512) attn_prompt_item(p, it, (bf16_t*)smem_raw);
        else attn_sample_item(p, it - 512, smem_raw);
    }
}

struct EpiAct {
    bf16_t* XR;
    int ldo, col0, act;
    __device__ __forceinline__ void operator()(f32x4 (&acc)[4][4], int m0, int n0, int wr, int wc, int lane) const {
        const int fr = lane & 15, fq = lane >> 4;
        bf16_t* O = act ? XR + (size_t)MT * 1024 - 1024 : XR;
#pragma unroll
        for (int i = 0; i < 4; ++i) {
            const int m = m0 + wr * 64 + i * 16 + fr;
#pragma unroll
            for (int g2 = 0; g2 < 2; ++g2) {
                f32x4 a = acc[i][2 * g2], b = acc[i][2 * g2 + 1];
                if (act) {
                    a.x = silu_f(a.x); a.y = silu_f(a.y); a.z = silu_f(a.z); a.w = silu_f(a.w);
                    b.x = silu_f(b.x); b.y = silu_f(b.y); b.z = silu_f(b.z); b.w = silu_f(b.w);
                }
                u32x4 w;
                w.x = cvt_pk(a.x, a.y); w.y = cvt_pk(a.z, a.w); w.z = cvt_pk(b.x, b.y); w.w = cvt_pk(b.z, b.w);
                *(u32x4*)(O + (size_t)m * ldo + col0 + wc * 64 + 32 * g2 + 8 * fq) = w;
            }
        }
    }
};
__device__ __forceinline__ void c_in_phase(const Params& p, bf16_t* smem) {
    const bf16_t* H = (const bf16_t*)(p.ws + W_H);
    const bf16_t* Wt = (const bf16_t*)(p.ws + W_C_IN);
    bf16_t* XR = (bf16_t*)(p.ws + W_BUF1);
    bf16_t* SG = XR + (size_t)MT * 1024;
    Stage st;
    bool pre = false;
    for (int t = blockIdx.x; t < 129 * 16; t += gridDim.x) {
        const int mt = t >> 4, nt = t & 15;
        const int tn = t + gridDim.x;
        const bool hn = tn < 129 * 16;
        EpiAct e{XR, 1024, nt * 128, nt >= 8};
        gemm_tile<true>(H, 1024, Wt, 1024, 1024, mt * 128, nt * 128, smem, e, st, pre, hn, H, Wt, (tn >> 4) * 128, (tn & 15) * 128);
        pre = hn;
    }
}

__device__ __forceinline__ void unpack8(const u32x4 v, float (&x)[8]) {
    x[0] = bf_lo(v.x); x[1] = bf_hi(v.x); x[2] = bf_lo(v.y); x[3] = bf_hi(v.y);
    x[4] = bf_lo(v.z); x[5] = bf_hi(v.z); x[6] = bf_lo(v.w); x[7] = bf_hi(v.w);
}

__device__ __forceinline__ void c_conv_phase(const Params& p) {
    const bf16_t* XR = (const bf16_t*)(p.ws + W_BUF1);
    bf16_t* XC = (bf16_t*)(p.ws + W_H);
    const float* cw = p.in[18];
    const float* cb = p.in[19];
    const float* st = p.in[4];
    const int gt = blockIdx.x * NTHREADS + threadIdx.x, gn = gridDim.x * NTHREADS;
    const int c0 = (gt & 127) * 8;
    float w0[8], w1[8], w2[8], w3[8], bias[8];
#pragma unroll
    for (int e = 0; e < 8; ++e) {
        w0[e] = cw[c0 + e]; w1[e] = cw[1024 + c0 + e]; w2[e] = cw[2048 + c0 + e]; w3[e] = cw[3072 + c0 + e]; bias[e] = cb[c0 + e];
    }
    for (int run = gt >> 7; run < M_P / 8; run += gn >> 7) {
        const int r0 = run * 8, t0 = r0 & (SEQ - 1), b = r0 >> 13;
        u32x4 raw[11];
#pragma unroll
        for (int q = 0; q < 11; ++q) {
            raw[q] = (u32x4){0u, 0u, 0u, 0u};
            if (q >= 3 || t0 > 0) raw[q] = *(const u32x4*)(XR + (size_t)(r0 - 3 + q) * 1024 + c0);
        }
        float x0[8], x1[8], x2[8], x3[8];
        unpack8(raw[0], x0); unpack8(raw[1], x1); unpack8(raw[2], x2);
#pragma unroll
        for (int q = 0; q < 8; ++q) {
            unpack8(raw[q + 3], x3);
            float acc[8];
#pragma unroll
            for (int e = 0; e < 8; ++e) acc[e] = bias[e] + x0[e] * w0[e] + x1[e] * w1[e] + x2[e] * w2[e] + x3[e] * w3[e];
            u32x4 o;
            o.x = cvt_pk(acc[0], acc[1]); o.y = cvt_pk(acc[2], acc[3]); o.z = cvt_pk(acc[4], acc[5]); o.w = cvt_pk(acc[6], acc[7]);
            *(u32x4*)(XC + (size_t)(r0 + q) * 1024 + c0) = o;
            const int t = t0 + q;
            if (t >= SEQ - 3) {
                float* oo = p.out + O_CCP + ((size_t)b * 3 + (t - (SEQ - 3))) * 1024 + c0;
#pragma unroll
                for (int e = 0; e < 8; ++e) oo[e] = x3[e];
            }
#pragma unroll
            for (int e = 0; e < 8; ++e) { x0[e] = x1[e]; x1[e] = x2[e]; x2[e] = x3[e]; }
        }
    }
    for (int b = gt >> 7; b < M_S; b += gn >> 7) {
        const int row = M_P + b;
        float xv[8], acc[8];
        unpack8(*(const u32x4*)(XR + (size_t)row * 1024 + c0), xv);
#pragma unroll
        for (int e = 0; e < 8; ++e) {
            const float s0 = st[((size_t)b * 3 + 0) * 1024 + c0 + e], s1 = st[((size_t)b * 3 + 1) * 1024 + c0 + e], s2 = st[((size_t)b * 3 + 2) * 1024 + c0 + e];
            acc[e] = bias[e] + s0 * w0[e] + s1 * w1[e] + s2 * w2[e] + xv[e] * w3[e];
            p.out[O_CCS + ((size_t)b * 3 + 0) * 1024 + c0 + e] = s1;
            p.out[O_CCS + ((size_t)b * 3 + 1) * 1024 + c0 + e] = s2;
            p.out[O_CCS + ((size_t)b * 3 + 2) * 1024 + c0 + e] = xv[e];
        }
        u32x4 o;
        o.x = cvt_pk(acc[0], acc[1]); o.y = cvt_pk(acc[2], acc[3]); o.z = cvt_pk(acc[4], acc[5]); o.w = cvt_pk(acc[6], acc[7]);
        *(u32x4*)(XC + (size_t)row * 1024 + c0) = o;
    }
}

struct EpiGate {
    const bf16_t* XC;
    float* Aa;
    bf16_t* Bb;
    const float *b_a, *b_x, *lam;
    int blk, nt;
    float* lds;
    float* carry;
    __device__ __forceinline__ void operator()(f32x4 (&acc)[4][4], int m0, int n0, int wr, int wc, int lane) const {
        const int fr = lane & 15, fq = lane >> 4;
        const bool prompt = (m0 < M_P);
        __syncthreads();
#pragma unroll
        for (int jn = 0; jn < 2; ++jn) {
            const int cl = 32 * wc + 8 * fq + 4 * jn;
            const int d = blk * 256 + 64 * nt + cl;
            const f32x4 ba = *(const f32x4*)(b_a + d), bx = *(const f32x4*)(b_x + d), lm = *(const f32x4*)(lam + d);
            f32x4 sp;
            sp.x = log1pf(__expf(-lm.x)); sp.y = log1pf(__expf(-lm.y)); sp.z = log1pf(__expf(-lm.z)); sp.w = log1pf(__expf(-lm.w));
#pragma unroll
            for (int i = 0; i < 4; ++i) {
                const int rl = wr * 64 + i * 16 + fr, m = m0 + rl;
                const bool first = (m < M_P) && ((m & (SEQ - 1)) == 0);
                const u32x2 xw = *(const u32x2*)(XC + (size_t)m * 1024 + d);
                const f32x4 xc = {bf_lo(xw.x), bf_hi(xw.x), bf_lo(xw.y), bf_hi(xw.y)};
                const f32x4 ra = acc[i][jn] + ba, ia = acc[i][jn + 2] + bx;
                f32x4 av, bv;
#pragma unroll
                for (int r = 0; r < 4; ++r) {
                    const float rg = sigmoid_f(ra[r]), ig = sigmoid_f(ia[r]);
                    const float la = -8.0f * rg * sp[r];
                    const float a = __expf(la);
                    av[r] = a;
                    const float mult = first ? 1.0f : __builtin_amdgcn_sqrtf(fmaxf(1.0f - a * a, 0.f));
                    bv[r] = mult * (ig * xc[r]);
                }
                *(f32x4*)(Aa + (size_t)m * 1024 + d) = av;
                u32x2 w;
                w.x = cvt_pk(bv.x, bv.y);
                w.y = cvt_pk(bv.z, bv.w);
                *(u32x2*)(Bb + (size_t)m * 1024 + d) = w;
                if (prompt) {
                    *(f32x4*)(lds + rl * 64 + cl) = av;
                    *(f32x4*)(lds + 8192 + rl * 64 + cl) = (f32x4){bf_lo(w.x), bf_hi(w.x), bf_lo(w.y), bf_hi(w.y)};
                }
            }
        }
        __syncthreads();
        if (prompt && threadIdx.x < 64) {
            float A = 1.f, h = 0.f;
#pragma unroll 16
            for (int r = 0; r < 128; ++r) {
                const float a = lds[r * 64 + threadIdx.x], b = lds[8192 + r * 64 + threadIdx.x];
                A *= a;
                h = a * h + b;
            }
            const int chunk = m0 >> 7, d = blk * 256 + 64 * nt + threadIdx.x;
            carry[(size_t)chunk * 2048 + d] = A;
            carry[(size_t)chunk * 2048 + 1024 + d] = h;
        }
    }
};

__device__ __forceinline__ void c_gate_phase(const Params& p, bf16_t* smem) {
    const bf16_t* XC = (const bf16_t*)(p.ws + W_H);
    const bf16_t* Wg = (const bf16_t*)(p.ws + W_C_G);
    float* Aa = (float*)(p.ws + W_BUF2);
    bf16_t* Bb = (bf16_t*)(p.ws + W_BUF1);
    Stage st;
    bool pre = false;
    for (int t = blockIdx.x; t < 129 * 16; t += gridDim.x) {
        const int mt = t >> 4, blk = (t >> 2) & 3, nt = t & 3;
        const int tn = t + gridDim.x, blkn = (tn >> 2) & 3;
        const bool hn = tn < 129 * 16;
        EpiGate e{XC, Aa, Bb, p.in[21], p.in[23], p.in[24], blk, nt, (float*)smem, (float*)(p.ws + W_CARRY)};
        gemm_tile<true>(XC + blk * 256, 1024, Wg + (size_t)blk * 512 * 256, 256, 256, mt * 128, nt * 128, smem, e, st, pre, hn,
                        XC + blkn * 256, Wg + (size_t)blkn * 512 * 256, (tn >> 4) * 128, (tn & 3) * 128);
        pre = hn;
    }
}

__device__ __forceinline__ void c_scan1_phase(const Params& p) {
    const float* Aa = (const float*)(p.ws + W_BUF2);
    const bf16_t* Bb = (const bf16_t*)(p.ws + W_BUF1);
    float* carry = (float*)(p.ws + W_CARRY);
    for (int it = blockIdx.x; it < 512; it += gridDim.x) {
        const int chunk = it >> 2, d = (it & 3) * 256 + threadIdx.x;
        float A = 1.f, h = 0.f;
        const size_t base = (size_t)chunk * 128 * 1024 + d;
#pragma unroll 8
        for (int r = 0; r < 128; ++r) {
            const float a = Aa[base + (size_t)r * 1024], b = bf2f(Bb[base + (size_t)r * 1024]);
            A *= a;
            h = a * h + b;
        }
        carry[(size_t)chunk * 2048 + d] = A;
        carry[(size_t)chunk * 2048 + 1024 + d] = h;
    }
}

__device__ __forceinline__ void c_scan2_phase(const Params& p) {
    const float* Aa = (const float*)(p.ws + W_BUF2);
    const bf16_t* Bb = (const bf16_t*)(p.ws + W_BUF1);
    const bf16_t* SG = Bb + (size_t)MT * 1024;
    const float* carry = (const float*)(p.ws + W_CARRY);
    bf16_t* Z = (bf16_t*)(p.ws + W_H);
    for (int it = blockIdx.x; it < 512 + 512; it += gridDim.x) {
        if (it < 512) {
            const int chunk = it >> 2, d = (it & 3) * 256 + threadIdx.x;
            const int b = chunk >> 6, ci = chunk & 63;
            float h = 0.f;
            {
                const float* c0 = carry + (size_t)(b * 64) * 2048 + d;
                int jc = 0;
                for (; jc + 16 <= ci; jc += 16) {
                    float ca[16], ch[16];
#pragma unroll
                    for (int q = 0; q < 16; ++q) { ca[q] = c0[(size_t)(jc + q) * 2048]; ch[q] = c0[(size_t)(jc + q) * 2048 + 1024]; }
#pragma unroll
                    for (int q = 0; q < 16; ++q) h = ca[q] * h + ch[q];
                }
                for (; jc < ci; ++jc) h = c0[(size_t)jc * 2048] * h + c0[(size_t)jc * 2048 + 1024];
            }
            const size_t base = (size_t)chunk * 128 * 1024 + d;
for (int r0 = 0; r0 < 128; r0 += 32) {
                float av[32];
                bf16_t bv[32], sv[32];
#pragma unroll
                for (int q = 0; q < 32; ++q) {
                    const size_t o = base + (size_t)(r0 + q) * 1024;
                    av[q] = Aa[o]; bv[q] = Bb[o]; sv[q] = SG[o];
                }
#pragma unroll
                for (int q = 0; q < 32; ++q) {
                    h = av[q] * h + bf2f(bv[q]);
                    Z[base + (size_t)(r0 + q) * 1024] = (bf16_t)(cvt_pk(h * bf2f(sv[q]), 0.f) & 0xffff);
                }
            }
            if (ci == 63) p.out[O_CHP + (size_t)b * 1024 + d] = h;
        } else {
            const int s = it - 512, d = (s & 3) * 256 + threadIdx.x, b = s >> 2;
            const size_t o = (size_t)(M_P + b) * 1024 + d;
            const float h = Aa[o] * p.in[5][(size_t)b * 1024 + d] + bf2f(Bb[o]);
            Z[o] = (bf16_t)(cvt_pk(h * bf2f(SG[o]), 0.f) & 0xffff);
            p.out[O_CHS + (size_t)b * 1024 + d] = h;
        }
    }
}

constexpr int N_PHASES = 20;

__device__ __forceinline__ void run_phase(const Params& p, int ph, unsigned char* smem_raw) {
    bf16_t* smem = (bf16_t*)smem_raw;
    float* Y = (float*)(p.ws + W_BUF2);
    float* YP = (float*)(p.ws + W_YPART);
    float* X = p.out + O_X;
    bf16_t* XB = (bf16_t*)(p.ws + W_XB);
    bf16_t* H = (bf16_t*)(p.ws + W_H);
    switch (ph) {
        case 0: prep_phase(p, smem_raw); break;
        case 1: a_in_phase(p, 0, smem); break;
        case 2: a_mix_phase(p, 0, smem); break;
        case 3: out_gemm_phase((const bf16_t*)(p.ws + W_BUF1), 2048, (const bf16_t*)(p.ws + W_A_OUT), Y, YP, smem); break;
        case 4: norm_phase(Y, YP, 8, p.in[0], p.in[1], XB, true, nullptr, p.in[7] + 0 * 1024, p.in[6] + 1 * 1024, H); break;
        case 5: b_in_phase(p, smem); break;
        case 6: b_attn_phase(p, smem_raw); break;
        case 7: out_gemm_phase(H, 1024, (const bf16_t*)(p.ws + W_B_OUT), Y, YP, smem); break;
        case 8: norm_phase(Y, YP, 4, nullptr, nullptr, XB, true, nullptr, p.in[7] + 1 * 1024, p.in[6] + 2 * 1024, H); break;
        case 9: c_in_phase(p, smem); break;
        case 10: c_conv_phase(p); break;
        case 11: c_gate_phase(p, smem); break;
        case 12: c_scan1_phase(p); break;
        case 13: c_scan2_phase(p); break;
        case 14: out_gemm_phase(H, 1024, (const bf16_t*)(p.ws + W_C_OUT), Y, YP, smem); break;
        case 15: norm_phase(Y, YP, 4, nullptr, nullptr, XB, true, nullptr, p.in[7] + 2 * 1024, p.in[6] + 3 * 1024, H); break;
        case 16: a_in_phase(p, 1, smem); break;
        case 17: a_mix_phase(p, 1, smem); break;
        case 18: out_gemm_phase((const bf16_t*)(p.ws + W_BUF1), 2048, (const bf16_t*)(p.ws + W_A_OUT) + (size_t)1024 * 2048, Y, YP, smem); break;
        case 19: norm_phase(Y, YP, 8, nullptr, nullptr, XB, false, X, p.in[7] + 3 * 1024, nullptr, H); break;
        default: break;
    }
}


#define XB_TMO      128
#define XB_XCNT(j)  (256  + 64 * (j))
#define XB_XSUB(j)  (1280 + 64 * (j))
#define XB_XGEN(j)  (2304 + 64 * (j))
#define XB_TOP      3328
#define XB_TOPGEN   3392
#define XCD_BAR_WORDS 3456
#define XB_SPIN_CAP (1u << 20)
__device__ __forceinline__ unsigned xb_ld(unsigned* p) { return __hip_atomic_load(p, __ATOMIC_RELAXED, __HIP_MEMORY_SCOPE_AGENT); }
__device__ __forceinline__ unsigned xb_add(unsigned* p, unsigned v) { return __hip_atomic_fetch_add(p, v, __ATOMIC_RELAXED, __HIP_MEMORY_SCOPE_AGENT); }
__device__ __forceinline__ unsigned xb_xcc_id() { return (unsigned)__builtin_amdgcn_s_getreg((3 << 11) | 20) & 0xFu; }
#define XB_SPIN(cond, bar) do { unsigned _sp = 0; while (cond) { __builtin_amdgcn_s_sleep(1); \
    if ((++_sp & 255u) == 0u) { if (xb_ld(&(bar)[XB_TMO])) break; if (_sp > XB_SPIN_CAP) { atomicAdd(&(bar)[XB_TMO], 1u); break; } } } } while (0)
struct XcdBarrier { unsigned* bar; unsigned x, nloc, nx; };
__device__ __forceinline__ void xcd_barrier_complete(unsigned* bar, unsigned x, unsigned& nloc, unsigned& nx) {
    const unsigned G = gridDim.x;
    unsigned sum, cnt, mine, sp = 0u;
    for (;;) {
        sum = 0u; cnt = 0u; mine = 0u;
#pragma unroll
        for (unsigned j = 0; j < 16; ++j) { const unsigned c = xb_ld(&bar[XB_XCNT(j)]); sum += c; cnt += (c > 0u) ? 1u : 0u; mine = (j == x) ? c : mine; }
        if (sum == G) break;
        __builtin_amdgcn_s_sleep(1);
        if ((++sp & 255u) == 0u) { if (xb_ld(&bar[XB_TMO])) break; if (sp > XB_SPIN_CAP) { atomicAdd(&bar[XB_TMO], 1u); break; } }
    }
    nloc = mine > 0u ? mine : 1u; nx = cnt > 0u ? cnt : 1u;
}
__device__ __forceinline__ void xcd_barrier(XcdBarrier& b) {
    asm volatile("s_waitcnt vmcnt(0)" ::: "memory");
    __syncthreads();
    if (threadIdx.x == 0) {
        unsigned* bar = b.bar;
        __builtin_amdgcn_s_waitcnt(0);
        if (b.nloc == 0u) xcd_barrier_complete(bar, b.x, b.nloc, b.nx);
        const unsigned nloc = b.nloc, nx = b.nx;
        const unsigned old = xb_add(&bar[XB_XSUB(b.x)], 1u);
        const unsigned gen = old / nloc;
        if (old + 1u == (gen + 1u) * nloc) {
            __builtin_amdgcn_fence(__ATOMIC_RELEASE, "agent");
            asm volatile("s_waitcnt vmcnt(0)" ::: "memory");
            const unsigned og = xb_add(&bar[XB_TOP], 1u);
            const unsigned tg = og / nx;
            if (og + 1u == (tg + 1u) * nx) xb_add(&bar[XB_TOPGEN], 1u);
            else XB_SPIN(xb_ld(&bar[XB_TOPGEN]) == tg, bar);
            __builtin_amdgcn_fence(__ATOMIC_ACQUIRE, "agent");
            xb_add(&bar[XB_XGEN(b.x)], 1u);
            asm volatile("s_waitcnt vmcnt(0)" ::: "memory");
        } else {
            XB_SPIN(xb_ld(&bar[XB_XGEN(b.x)]) == gen, bar);
            __builtin_amdgcn_fence(__ATOMIC_ACQUIRE, "agent");
            asm volatile("s_waitcnt vmcnt(0)" ::: "memory");
        }
    }
    __syncthreads();
}

#ifndef PROBE_K
#define PROBE_K 20
#endif
__device__ __forceinline__ void dump_phase(const Params& p) {
    const unsigned* base = (const unsigned*)(p.ws);
    const size_t nwords = W_END / 4, n = (size_t)MT * D;
    const size_t gt = (size_t)blockIdx.x * NTHREADS + threadIdx.x, gn = (size_t)gridDim.x * NTHREADS;
    for (size_t i = gt; i < n; i += gn) {
        float a = 0.f;
        for (int k = 0; k < 4; ++k) {
            const size_t w = i + (size_t)k * n;
            if (w < nwords) { const unsigned u = base[w]; a += (float)((u * 2654435761u) >> 29); }
        }
        p.out[i] = a;
    }
}
constexpr size_t W_BAR = W_END;
#define PHASE(i) if (p.ph_lo <= (i) && (i) < p.ph_hi) { if ((i) > p.ph_lo) xcd_barrier(xb); run_phase(p, (i), smem_raw); }
__global__ void __launch_bounds__(NTHREADS, 2) mega_kernel(Params p) {
    __shared__ __attribute__((aligned(16))) unsigned char smem_raw[SMEM_BYTES];
    XcdBarrier xb;
    xb.bar = (unsigned*)(p.ws + W_BAR); xb.x = xb_xcc_id(); xb.nloc = 0u; xb.nx = 0u;
    if (threadIdx.x == 0) (void)xb_add(&xb.bar[XB_XCNT(xb.x)], 1u);
    if (p.ph_lo < 0) cg::this_grid().sync();
    PHASE(0) PHASE(1) PHASE(2) PHASE(3) PHASE(4) PHASE(5) PHASE(6) PHASE(7) PHASE(8) PHASE(9)
    PHASE(10) PHASE(11) PHASE(13) PHASE(14) PHASE(15) PHASE(16) PHASE(17) PHASE(18) PHASE(19)
    if (ONE_LAUNCH && p.ph_hi < N_PHASES && p.ph_lo == 0) { xcd_barrier(xb); dump_phase(p); }
    if (!ONE_LAUNCH && p.ph_lo == N_PHASES) dump_phase(p);
}

extern "C" void kernel_launch(void* const* d_in, const int* in_sizes, int n_in, void* d_out, int out_size, void* d_ws, size_t ws_size,
                              hipStream_t stream) {
    static int grid = 0;
    if (grid == 0) {
        if (n_in != 26 || (size_t)out_size != O_END || ws_size < W_END + XCD_BAR_WORDS * 4) {
            fprintf(stderr, "kernel_launch: unexpected shapes n_in=%d out=%d ws=%zu (need %zu)\n", n_in, out_size, ws_size, (size_t)W_END);
            grid = -1;
            return;
        }
        int dev = 0, cus = 0, per_cu = 0;
        (void)hipGetDevice(&dev);
        (void)hipDeviceGetAttribute(&cus, hipDeviceAttributeMultiprocessorCount, dev);
        (void)hipOccupancyMaxActiveBlocksPerMultiprocessor(&per_cu, (const void*)mega_kernel, NTHREADS, 0);
        if (per_cu < 1) per_cu = 1;
        if (per_cu > 2) per_cu = 2;
        grid = cus * per_cu;
    }
    if (grid < 0) return;
    Params p{};
    for (int i = 0; i < 26; ++i) p.in[i] = (const float*)d_in[i];
    p.out = (float*)d_out;
    p.ws = (unsigned char*)d_ws;
#if ONE_LAUNCH
    (void)hipMemsetAsync((unsigned char*)d_ws + W_BAR, 0, XCD_BAR_WORDS * 4, stream);
    p.ph_lo = 0;
    p.ph_hi = PROBE_K;
    void* args[] = {&p};
    hipError_t e = hipLaunchCooperativeKernel((const void*)mega_kernel, dim3(grid), dim3(NTHREADS), args, 0, stream);
    if (e != hipSuccess) fprintf(stderr, "cooperative launch failed: %s (grid %d)\n", hipGetErrorString(e), grid);
#else
    for (int ph = 0; ph < N_PHASES; ++ph) {
        p.ph_lo = ph;
        p.ph_hi = ph + 1;
        hipLaunchKernelGGL(mega_kernel, dim3(grid), dim3(NTHREADS), 0, stream, p);
    }
#endif
}
```

```cpp
#include <hip/hip_runtime.h>
#include <hip/hip_cooperative_groups.h>
#include <stdint.h>
#include <stdio.h>
#include <math.h>
namespace cg = cooperative_groups;

#ifndef ONE_LAUNCH
#define ONE_LAUNCH 1
#endif

typedef unsigned short bf16_t;
typedef short bf16x8 __attribute__((ext_vector_type(8)));
typedef float f32x4 __attribute__((ext_vector_type(4)));
typedef unsigned u32x4 __attribute__((ext_vector_type(4)));
typedef unsigned u32x2 __attribute__((ext_vector_type(2)));

constexpr int M_P = 16384, M_S = 128, MT = 16512, D = 1024, SEQ = 8192;
constexpr int NTHREADS = 256;
constexpr int SMEM_BYTES = 65536;

constexpr size_t O_X = 0;
constexpr size_t O_AV = (size_t)MT * D;
constexpr size_t O_BKP = O_AV + 2 * 128 * 2048;
constexpr size_t O_BVP = O_BKP + 2 * 128 * 128;
constexpr size_t O_BKS = O_BVP + 2 * 128 * 128;
constexpr size_t O_BVS = O_BKS + 128 * 128 * 128;
constexpr size_t O_CCP = O_BVS + 128 * 128 * 128;
constexpr size_t O_CHP = O_CCP + 2 * 3 * 1024;
constexpr size_t O_CCS = O_CHP + 2 * 1024;
constexpr size_t O_CHS = O_CCS + 128 * 3 * 1024;
constexpr size_t O_END = O_CHS + 128 * 1024;

constexpr size_t W_A_IN = 0;
constexpr size_t W_A_OUT = W_A_IN + (size_t)2 * 6144 * 1024 * 2;
constexpr size_t W_B_IN = W_A_OUT + (size_t)2 * 1024 * 2048 * 2;
constexpr size_t W_B_OUT = W_B_IN + (size_t)2304 * 1024 * 2;
constexpr size_t W_C_IN = W_B_OUT + (size_t)1024 * 1024 * 2;
constexpr size_t W_C_G = W_C_IN + (size_t)2048 * 1024 * 2;
constexpr size_t W_C_OUT = W_C_G + (size_t)4 * 512 * 256 * 2;
constexpr size_t W_WS_A = W_C_OUT + (size_t)1024 * 1024 * 2;
constexpr size_t W_ROPE = W_WS_A + (size_t)2 * 4 * 128 * 128 * 2;
constexpr size_t W_H = W_ROPE + (size_t)8193 * 64 * 4;
constexpr size_t W_BUF1 = W_H + (size_t)MT * 1024 * 2;
constexpr size_t W_BUF2 = W_BUF1 + (size_t)MT * 2048 * 2;
constexpr size_t W_KB = W_BUF2 + (size_t)MT * 2048 * 2;
constexpr size_t W_STATS = W_KB;
constexpr size_t W_CARRY = W_KB + (size_t)MT * 256 * 2;
constexpr size_t W_YPART = W_CARRY + (size_t)128 * 1024 * 2 * 4;
constexpr size_t W_XB = W_YPART + (size_t)8 * 128 * 1024 * 4;
constexpr size_t W_END = W_XB + (size_t)MT * 1024 * 2;

struct Params {
    const float* in[26];
    float* out;
    unsigned char* ws;
    int ph_lo, ph_hi;
};

__device__ __forceinline__ unsigned cvt_pk(float lo, float hi) {
    unsigned r;
    asm("v_cvt_pk_bf16_f32 %0, %1, %2" : "=v"(r) : "v"(lo), "v"(hi));
    return r;
}
__device__ __forceinline__ float bf_lo(unsigned u) { return __uint_as_float(u << 16); }
__device__ __forceinline__ float bf_hi(unsigned u) { return __uint_as_float(u & 0xffff0000u); }
__device__ __forceinline__ float bf2f(bf16_t h) { return __uint_as_float(((unsigned)h) << 16); }
__device__ __forceinline__ float sigmoid_f(float x) { return __builtin_amdgcn_rcpf(1.f + __expf(-x)); }
__device__ __forceinline__ float silu_f(float x) { return x * sigmoid_f(x); }
__device__ __forceinline__ float gelu_f(float x) { return x * sigmoid_f(1.5957691216057308f * (x + 0.044715f * x * x * x)); }
__device__ __forceinline__ float gelu_silu(float u, float g) {
    const float eu = __expf(-1.5957691216057308f * (u + 0.044715f * u * u * u)), eg = __expf(-g);
    const float den = (1.f + eu) * (1.f + eg);
    return (u * g) * __builtin_amdgcn_rcpf(den);
}
template <int CTRL> __device__ __forceinline__ float dpp_add(float x) {
    return x + __builtin_bit_cast(float, __builtin_amdgcn_update_dpp(0, __builtin_bit_cast(int, x), CTRL, 0xF, 0xF, true));
}
__device__ __forceinline__ float row16_sum(float x) {
    x = dpp_add<0xB1>(x);
    x = dpp_add<0x4E>(x);
    x = dpp_add<0x141>(x);
    x = dpp_add<0x140>(x);
    return x;
}
__device__ __forceinline__ float wave_sum(float v) {
#pragma unroll
    for (int o = 1; o < 64; o <<= 1) v += __shfl_xor(v, o);
    return v;
}

__device__ __forceinline__ int perm32(int rho) { return 8 * ((rho & 15) >> 2) + 4 * (rho >> 4) + (rho & 3); }
__device__ __forceinline__ int permcol(int c) { return (c & ~31) + perm32(c & 31); }
__device__ __forceinline__ int swz(int row, int chunk) { return (chunk ^ (((row >> 3) & 1) << 1)) * 8; }

template <bool TRANS>
__device__ __forceinline__ void mma_stage(const bf16_t* As, const bf16_t* Bs, int apanel, int bpanel, f32x4 (&acc)[4][4], int wr, int wc, int lane) {
    const int fr = lane & 15, fq = lane >> 4;
    const int co = swz(fr, fq);
#pragma unroll
    for (int kk = 0; kk < 2; ++kk) {
        bf16x8 a[4], b[4];
#pragma unroll
        for (int i = 0; i < 4; ++i) {
            a[i] = *(const bf16x8*)(As + kk * apanel + (wr * 64 + i * 16 + fr) * 32 + co);
            b[i] = *(const bf16x8*)(Bs + kk * bpanel + (wc * 64 + i * 16 + fr) * 32 + co);
        }
#pragma unroll
        for (int i = 0; i < 4; ++i)
#pragma unroll
            for (int j = 0; j < 4; ++j)
                acc[i][j] = TRANS ? __builtin_amdgcn_mfma_f32_16x16x32_bf16(b[j], a[i], acc[i][j], 0, 0, 0)
                                  : __builtin_amdgcn_mfma_f32_16x16x32_bf16(a[i], b[j], acc[i][j], 0, 0, 0);
    }
}

__device__ __forceinline__ void g2r(const bf16_t* __restrict__ g, int ld, int row0, int k0, int tid, u32x4 (&r)[4]) {
    const int rl = 2 * (tid >> 4) + ((tid >> 2) & 1), kc = ((tid >> 3) & 1) * 4 + (tid & 3);
    const unsigned voff = (unsigned)(rl * ld + kc * 8) * 2u;
#pragma unroll
    for (int i = 0; i < 4; ++i) {
        const char* b = (const char*)(g + (size_t)(row0 + 32 * i) * ld + k0);
        r[i] = *(const u32x4*)(b + voff);
    }
}
__device__ __forceinline__ void r2s(bf16_t* s, int tid, const u32x4 (&r)[4]) {
    const int rl = 2 * (tid >> 4) + ((tid >> 2) & 1), kc = ((tid >> 3) & 1) * 4 + (tid & 3);
#pragma unroll
    for (int i = 0; i < 4; ++i) {
        const int row = rl + 32 * i;
        *(u32x4*)(s + (kc >> 2) * 4096 + row * 32 + swz(row, kc & 3)) = r[i];
    }
}

__device__ __forceinline__ void g2r32(const bf16_t* __restrict__ g, int ld, int row0, int k0, int tid, u32x4 (&r)[2]) {
    const unsigned voff = (unsigned)((tid >> 2) * ld + (tid & 3) * 8) * 2u;
#pragma unroll
    for (int i = 0; i < 2; ++i) {
        const char* b = (const char*)(g + (size_t)(row0 + 64 * i) * ld + k0);
        r[i] = *(const u32x4*)(b + voff);
    }
}
__device__ __forceinline__ void r2s32(bf16_t* s, int tid, const u32x4 (&r)[2]) {
#pragma unroll
    for (int i = 0; i < 2; ++i) {
        const int row = (tid >> 2) + 64 * i;
        *(u32x4*)(s + row * 32 + swz(row, tid & 3)) = r[i];
    }
}
__device__ __forceinline__ void ldfrag(const bf16_t* st, bf16x8 (&a)[4], bf16x8 (&b)[4], int wr, int wc, int fr, int co) {
#pragma unroll
    for (int i = 0; i < 4; ++i) {
        a[i] = *(const bf16x8*)(st + (wr * 64 + i * 16 + fr) * 32 + co);
        b[i] = *(const bf16x8*)(st + 4096 + (wc * 64 + i * 16 + fr) * 32 + co);
    }
}
template <bool TRANS>
__device__ __forceinline__ void mma16(const bf16x8 (&a)[4], const bf16x8 (&b)[4], f32x4 (&acc)[4][4]) {
    __builtin_amdgcn_s_setprio(1);
#pragma unroll
    for (int i = 0; i < 4; ++i)
#pragma unroll
        for (int j = 0; j < 4; ++j)
            acc[i][j] = TRANS ? __builtin_amdgcn_mfma_f32_16x16x32_bf16(b[j], a[i], acc[i][j], 0, 0, 0)
                              : __builtin_amdgcn_mfma_f32_16x16x32_bf16(a[i], b[j], acc[i][j], 0, 0, 0);
    __builtin_amdgcn_s_setprio(0);
}

struct Stage { u32x4 ra0[2], rb0[2], ra1[2], rb1[2]; };

template <bool TRANS, class Epi>
__device__ __forceinline__ void gemm_tile(const bf16_t* __restrict__ A, int lda, const bf16_t* __restrict__ Bt, int ldb, int K, int m0, int n0,
                                          bf16_t* smem, const Epi epi, Stage& st, bool pre, bool has_next, const bf16_t* __restrict__ An,
                                          const bf16_t* __restrict__ Bn, int m0n, int n0n) {
    const int tid = threadIdx.x, wid = tid >> 6, lane = tid & 63, wr = wid >> 1, wc = wid & 1, fr = lane & 15, fq = lane >> 4;
    const int co = swz(fr, fq);
    f32x4 acc[4][4];
#pragma unroll
    for (int i = 0; i < 4; ++i)
#pragma unroll
        for (int j = 0; j < 4; ++j) acc[i][j] = (f32x4){0.f, 0.f, 0.f, 0.f};
    const int nk = K >> 5;
    bf16x8 a0[4], b0[4], a1[4], b1[4];
    if (!pre) {
        g2r32(A, lda, m0, 0, tid, st.ra0);
        g2r32(Bt, ldb, n0, 0, tid, st.rb0);
        g2r32(A, lda, m0, 32, tid, st.ra1);
        g2r32(Bt, ldb, n0, 32, tid, st.rb1);
    }
    __syncthreads();
    r2s32(smem, tid, st.ra0);
    r2s32(smem + 4096, tid, st.rb0);
    r2s32(smem + 8192, tid, st.ra1);
    r2s32(smem + 8192 + 4096, tid, st.rb1);
    g2r32(A, lda, m0, 64, tid, st.ra0);
    g2r32(Bt, ldb, n0, 64, tid, st.rb0);
    g2r32(A, lda, m0, 96, tid, st.ra1);
    g2r32(Bt, ldb, n0, 96, tid, st.rb1);
    __syncthreads();
    ldfrag(smem, a0, b0, wr, wc, fr, co);
    for (int kt = 0; kt < nk; kt += 2) {
        {
            bf16_t* w = smem + ((kt + 2) & 3) * 8192;
            r2s32(w, tid, st.ra0);
            r2s32(w + 4096, tid, st.rb0);
            const int kn = (kt + 4 < nk ? kt + 4 : nk - 1) * 32;
            g2r32(A, lda, m0, kn, tid, st.ra0);
            g2r32(Bt, ldb, n0, kn, tid, st.rb0);
            ldfrag(smem + ((kt + 1) & 3) * 8192, a1, b1, wr, wc, fr, co);
            mma16<TRANS>(a0, b0, acc);
            __syncthreads();
        }
        {
            bf16_t* w = smem + ((kt + 3) & 3) * 8192;
            r2s32(w, tid, st.ra1);
            r2s32(w + 4096, tid, st.rb1);
            const int kn = (kt + 5 < nk ? kt + 5 : nk - 1) * 32;
            g2r32(A, lda, m0, kn, tid, st.ra1);
            g2r32(Bt, ldb, n0, kn, tid, st.rb1);
            ldfrag(smem + ((kt + 2) & 3) * 8192, a0, b0, wr, wc, fr, co);
            mma16<TRANS>(a1, b1, acc);
            __syncthreads();
        }
    }
    if (has_next) {
        g2r32(An, lda, m0n, 0, tid, st.ra0);
        g2r32(Bn, ldb, n0n, 0, tid, st.rb0);
        g2r32(An, lda, m0n, 32, tid, st.ra1);
        g2r32(Bn, ldb, n0n, 32, tid, st.rb1);
    }
    epi(acc, m0, n0, wr, wc, lane);
}

__device__ __forceinline__ void wt_tile(const float* colptr, int ldsrc, bf16_t* dst, int ldd, float* tile, int tid) {
    const int tx = tid & 63, ty = tid >> 6;
    float v[16];
#pragma unroll
    for (int q = 0; q < 16; ++q) v[q] = colptr[(size_t)(ty + 4 * q) * ldsrc];
#pragma unroll
    for (int q = 0; q < 16; ++q) tile[(ty + 4 * q) * 65 + tx] = v[q];
    __syncthreads();
    const int c2 = tid & 31, r0 = tid >> 5;
#pragma unroll
    for (int rr = r0; rr < 64; rr += 8)
        *(unsigned*)(dst + (size_t)rr * ldd + 2 * c2) = cvt_pk(tile[(2 * c2) * 65 + rr], tile[(2 * c2 + 1) * 65 + rr]);
    __syncthreads();
}

__device__ __forceinline__ void sincos_d(double x, double& s, double& c) {
    const double k = rint(x * 0.63661977236758134308);
    double r = fma(-k, 1.57079632673412561417e+00, x);
    r = fma(-k, 6.07710050650619224932e-11, r);
    const double z = r * r;
    const double sp = r + r * z * (-1.66666666666666324348e-01 + z * (8.33333333332248946124e-03 + z * (-1.98412698298579493134e-04 + z * (2.75573137070700676789e-06 + z * (-2.50507602534068634195e-08 + z * 1.58969099521155010221e-10)))));
    const double cp = 1.0 - 0.5 * z + z * z * (4.16666666666666019037e-02 + z * (-1.38888888888741095749e-03 + z * (2.48015872894767294178e-05 + z * (-2.75573143513906633035e-07 + z * (2.08757232129817482790e-09 + z * -1.13596475577881948265e-11)))));
    const int q = ((int)k) & 3;
    s = (q == 0) ? sp : (q == 1) ? cp : (q == 2) ? -sp : -cp;
    c = (q == 0) ? cp : (q == 1) ? -sp : (q == 2) ? -cp : sp;
}

__device__ __forceinline__ void norm_phase(const float* __restrict__ Y, const float* __restrict__ Ypart, int nsplit, const float* xin_p, const float* xin_s,
                                           bf16_t* Xb, bool storeXb, float* Xf, const float* gpost, const float* gpre, bf16_t* H) {
    const int lane = threadIdx.x & 63;
    const int gw = blockIdx.x * 4 + (threadIdx.x >> 6), nw = gridDim.x * 4;
    for (int row = gw; row < MT; row += nw) {
        f32x4 x[4];
        if (xin_p) {
            const float* xr = row < M_P ? xin_p + (size_t)row * D : xin_s + (size_t)(row - M_P) * D;
#pragma unroll
            for (int j = 0; j < 4; ++j) x[j] = *(const f32x4*)(xr + j * 256 + lane * 4);
        } else {
#pragma unroll
            for (int j = 0; j < 4; ++j) {
                const u32x2 w = *(const u32x2*)(Xb + (size_t)row * D + j * 256 + lane * 4);
                x[j] = (f32x4){bf_lo(w.x), bf_hi(w.x), bf_lo(w.y), bf_hi(w.y)};
            }
        }
        if (Y) {
            f32x4 y[4];
            float ss = 0.f;
            if (row < M_P) {
#pragma unroll
                for (int j = 0; j < 4; ++j) {
                    const u32x2 w = *(const u32x2*)((const bf16_t*)Y + (size_t)row * D + j * 256 + lane * 4);
                    y[j] = (f32x4){bf_lo(w.x), bf_hi(w.x), bf_lo(w.y), bf_hi(w.y)};
                }
            } else {
#pragma unroll
                for (int j = 0; j < 4; ++j) y[j] = (f32x4){0.f, 0.f, 0.f, 0.f};
                for (int s = 0; s < nsplit; ++s) {
#pragma unroll
                    for (int j = 0; j < 4; ++j) y[j] += *(const f32x4*)(Ypart + ((size_t)s * 128 + (row - M_P)) * D + j * 256 + lane * 4);
                }
            }
#pragma unroll
            for (int j = 0; j < 4; ++j) ss += y[j].x * y[j].x + y[j].y * y[j].y + y[j].z * y[j].z + y[j].w * y[j].w;
            ss = wave_sum(ss);
            const float rstd = rsqrtf(ss * (1.f / 1024.f) + 1e-6f);
#pragma unroll
            for (int j = 0; j < 4; ++j) {
                const f32x4 g = *(const f32x4*)(gpost + j * 256 + lane * 4);
                x[j] = x[j] + y[j] * rstd * g;
            }
        }
        if (storeXb) {
#pragma unroll
            for (int j = 0; j < 4; ++j) {
                u32x2 w;
                w.x = cvt_pk(x[j].x, x[j].y);
                w.y = cvt_pk(x[j].z, x[j].w);
                *(u32x2*)(Xb + (size_t)row * D + j * 256 + lane * 4) = w;
            }
        }
        if (Xf) {
#pragma unroll
            for (int j = 0; j < 4; ++j) *(f32x4*)(Xf + (size_t)row * D + j * 256 + lane * 4) = x[j];
        }
        if (gpre) {
            float ss = 0.f;
#pragma unroll
            for (int j = 0; j < 4; ++j) ss += x[j].x * x[j].x + x[j].y * x[j].y + x[j].z * x[j].z + x[j].w * x[j].w;
            ss = wave_sum(ss);
            const float rstd = rsqrtf(ss * (1.f / 1024.f) + 1e-6f);
#pragma unroll
            for (int j = 0; j < 4; ++j) {
                const f32x4 g = *(const f32x4*)(gpre + j * 256 + lane * 4);
                const f32x4 h = x[j] * rstd * g;
                u32x2 w;
                w.x = cvt_pk(h.x, h.y);
                w.y = cvt_pk(h.z, h.w);
                *(u32x2*)(H + (size_t)row * D + j * 256 + lane * 4) = w;
            }
        }
    }
}

constexpr int WT_FIRST = 96 * 16;
constexpr int WT_TOTAL = 2 * 96 * 16 + 2 * 16 * 32 + 36 * 16 + 256 + 32 * 16 + 128 + 256;
__device__ __forceinline__ void wt_jobs(const Params& p, unsigned char* smem, int lo, int hi, int w, int nw) {
    float* tile = (float*)smem;
    const int tid = threadIdx.x, tx = tid & 63;
    constexpr int T_AIN = 96 * 16, T_AOUT = 16 * 32, T_BIN = 36 * 16, T_BOUT = 256, T_CIN = 32 * 16, T_CG = 128, T_COUT = 256;
    for (int it = lo + w; it < hi; it += nw) {
        int r = it;
        if (r < 2 * T_AIN) {
            const int j = r / T_AIN; r -= j * T_AIN;
            const int nt = r >> 4, kt = r & 15, np = permcol(nt * 64 + tx);
            int col;
            const int T = np >> 7, w = np & 127;
            if (T < 32) {
                const int wc = w >> 6, jn = (w >> 4) & 3, i = w & 15;
                col = ((jn < 2) ? 0 : 4096) + 64 * T + 32 * wc + 16 * (jn & 1) + i;
            } else col = 2048 + (np - 4096);
            wt_tile(p.in[8] + (size_t)j * 1024 * 6144 + (size_t)(kt * 64) * 6144 + col, 6144,
                    (bf16_t*)(p.ws + W_A_IN) + (size_t)j * 6144 * 1024 + (size_t)(nt * 64) * 1024 + kt * 64, 1024, tile, tid);
            continue;
        }
        r -= 2 * T_AIN;
        if (r < 2 * T_AOUT) {
            const int j = r / T_AOUT; r -= j * T_AOUT;
            const int nt = r >> 5, kt = r & 31;
            wt_tile(p.in[13] + (size_t)j * 2048 * 1024 + (size_t)(kt * 64) * 1024 + permcol(nt * 64 + tx), 1024,
                    (bf16_t*)(p.ws + W_A_OUT) + (size_t)j * 1024 * 2048 + (size_t)(nt * 64) * 2048 + kt * 64, 2048, tile, tid);
            continue;
        }
        r -= 2 * T_AOUT;
        if (r < T_BIN) {
            const int nt = r >> 4, kt = r & 15;
            wt_tile(p.in[14] + (size_t)(kt * 64) * 2304 + permcol(nt * 64 + tx), 2304, (bf16_t*)(p.ws + W_B_IN) + (size_t)(nt * 64) * 1024 + kt * 64, 1024, tile, tid);
            continue;
        }
        r -= T_BIN;
        if (r < T_BOUT) {
            const int nt = r >> 4, kt = r & 15;
            wt_tile(p.in[16] + (size_t)(kt * 64) * 1024 + permcol(nt * 64 + tx), 1024, (bf16_t*)(p.ws + W_B_OUT) + (size_t)(nt * 64) * 1024 + kt * 64, 1024, tile, tid);
            continue;
        }
        r -= T_BOUT;
        if (r < T_CIN) {
            const int nt = r >> 4, kt = r & 15;
            wt_tile(p.in[17] + (size_t)(kt * 64) * 2048 + permcol(nt * 64 + tx), 2048, (bf16_t*)(p.ws + W_C_IN) + (size_t)(nt * 64) * 1024 + kt * 64, 1024, tile, tid);
            continue;
        }
        r -= T_CIN;
        if (r < T_CG) {
            const int blk = r >> 5, rr = r & 31, nt = rr >> 2, kt = rr & 3;
            const int np = permcol(nt * 64 + tx), j4 = np >> 7, w = np & 127, wc = w >> 6, jn = (w >> 4) & 3, i = w & 15;
            const int dl = 64 * j4 + 32 * wc + 16 * (jn & 1) + i;
            const float* src = ((jn < 2) ? p.in[20] : p.in[22]) + (size_t)blk * 65536;
            wt_tile(src + (size_t)(kt * 64) * 256 + dl, 256, (bf16_t*)(p.ws + W_C_G) + (size_t)blk * 512 * 256 + (size_t)(nt * 64) * 256 + kt * 64, 256, tile, tid);
            continue;
        }
        r -= T_CG;
        {
            const int nt = r >> 4, kt = r & 15;
            wt_tile(p.in[24 + 1] + (size_t)(kt * 64) * 1024 + permcol(nt * 64 + tx), 1024, (bf16_t*)(p.ws + W_C_OUT) + (size_t)(nt * 64) * 1024 + kt * 64, 1024, tile, tid);
        }
    }
}

__device__ __forceinline__ void prep_phase(const Params& p, unsigned char* smem) {
    const int tid = threadIdx.x;
    wt_jobs(p, smem, 0, WT_FIRST, blockIdx.x, gridDim.x);
    const int gt = blockIdx.x * NTHREADS + tid, gn = gridDim.x * NTHREADS;
    {
        bf16_t* wsa = (bf16_t*)(p.ws + W_WS_A);
        const float* src = p.in[11];
        for (int idx = gt; idx < 2 * 4 * 128 * 128 / 2; idx += gn) {
            const int e = idx * 2, t = (e >> 7) & 127, s = e & 127;
            const float a = (s <= t) ? src[e] : 0.f, b = (s + 1 <= t) ? src[e + 1] : 0.f;
            *(unsigned*)(wsa + e) = cvt_pk(a, b);
        }
    }
    {
        float* rt = (float*)(p.ws + W_ROPE);
        for (int idx = gt; idx < 8193 * 32; idx += gn) {
            const int pos = idx >> 5, i = idx & 31;
            const float ang = (float)pos * exp2f(-(float)i * (13.287712379549449f / 32.0f));
            double s, c;
            sincos_d((double)ang, s, c);
            rt[pos * 64 + i] = (float)c;
            rt[pos * 64 + 32 + i] = (float)s;
        }
    }
    norm_phase(nullptr, nullptr, 0, p.in[0], p.in[1], nullptr, false, nullptr, nullptr, p.in[6], (bf16_t*)(p.ws + W_H));
}

struct EpiUG {
    bf16_t* P;
    int T;
    __device__ __forceinline__ void operator()(f32x4 (&acc)[4][4], int m0, int n0, int wr, int wc, int lane) const {
        const int fr = lane & 15, fq = lane >> 4;
#pragma unroll
        for (int i = 0; i < 4; ++i) {
            const int m = m0 + wr * 64 + i * 16 + fr;
            const int ch = 64 * T + 32 * wc + 8 * fq;
            u32x4 w;
            {
                const f32x4 u = acc[i][0], g = acc[i][2];
                w.x = cvt_pk(gelu_silu(u.x, g.x), gelu_silu(u.y, g.y));
                w.y = cvt_pk(gelu_silu(u.z, g.z), gelu_silu(u.w, g.w));
            }
            {
                const f32x4 u = acc[i][1], g = acc[i][3];
                w.z = cvt_pk(gelu_silu(u.x, g.x), gelu_silu(u.y, g.y));
                w.w = cvt_pk(gelu_silu(u.z, g.z), gelu_silu(u.w, g.w));
            }
            *(u32x4*)(P + (size_t)m * 2048 + ch) = w;
        }
    }
};
struct EpiV {
    bf16_t* GVt;
    float* stats;
    int mt, tv;
    __device__ __forceinline__ void operator()(f32x4 (&acc)[4][4], int m0, int n0, int wr, int wc, int lane) const {
        const int fr = lane & 15, fq = lane >> 4;
#pragma unroll
        for (int i = 0; i < 4; ++i) {
            const int sl = wr * 64 + i * 16 + fq * 4;
            f32x4 sum = {0.f, 0.f, 0.f, 0.f}, sq = {0.f, 0.f, 0.f, 0.f};
#pragma unroll
            for (int jn = 0; jn < 4; ++jn) {
                const int ch = 128 * tv + wc * 64 + 32 * (jn >> 1) + perm32(16 * (jn & 1) + fr);
                f32x4 v = acc[i][jn];
                v.x = gelu_f(v.x); v.y = gelu_f(v.y); v.z = gelu_f(v.z); v.w = gelu_f(v.w);
                u32x2 w;
                w.x = cvt_pk(v.x, v.y);
                w.y = cvt_pk(v.z, v.w);
                *(u32x2*)(GVt + ((size_t)mt * 2048 + ch) * 128 + sl) = w;
                sum += v;
                sq += v * v;
            }
            sum.x = row16_sum(sum.x); sum.y = row16_sum(sum.y); sum.z = row16_sum(sum.z); sum.w = row16_sum(sum.w);
            sq.x = row16_sum(sq.x); sq.y = row16_sum(sq.y); sq.z = row16_sum(sq.z); sq.w = row16_sum(sq.w);
            if (fr == 0) {
                float* st = stats + (size_t)(m0 + sl) * 64 + (tv * 2 + wc) * 2;
                st[0] = sum.x; st[1] = sq.x;
                st[64] = sum.y; st[65] = sq.y;
                st[128] = sum.z; st[129] = sq.z;
                st[192] = sum.w; st[193] = sq.w;
            }
        }
    }
};

__device__ __forceinline__ void a_in_phase(const Params& p, int j, bf16_t* smem) {
    const bf16_t* H = (const bf16_t*)(p.ws + W_H);
    const bf16_t* Wt = (const bf16_t*)(p.ws + W_A_IN) + (size_t)j * 6144 * 1024;
    bf16_t* P = (bf16_t*)(p.ws + W_BUF1);
    bf16_t* GVt = (bf16_t*)(p.ws + W_BUF2);
    float* stats = (float*)(p.ws + W_STATS);
    Stage st;
    bool pre = false;
    for (int t = blockIdx.x; t < 129 * 48; t += gridDim.x) {
        const int mt = t / 48, nt = t % 48;
        const int tn = t + gridDim.x;
        const bool hn = tn < 129 * 48;
        const int m0n = (tn / 48) * 128, n0n = (tn % 48) * 128;
        if (nt < 32) {
            EpiUG e{P, nt};
            gemm_tile<true>(H, 1024, Wt, 1024, 1024, mt * 128, nt * 128, smem, e, st, pre, hn, H, Wt, m0n, n0n);
        } else {
            EpiV e{GVt, stats, mt, nt - 32};
            gemm_tile<false>(H, 1024, Wt, 1024, 1024, mt * 128, nt * 128, smem, e, st, pre, hn, H, Wt, m0n, n0n);
        }
        pre = hn;
    }
    if (j == 0) {
        const int busy = (129 * 48) % gridDim.x, idle = gridDim.x - busy;
        if (idle > 0 && (int)blockIdx.x >= busy) wt_jobs(p, (unsigned char*)smem, WT_FIRST, WT_TOTAL, blockIdx.x - busy, idle);
        else if (idle <= 0) wt_jobs(p, (unsigned char*)smem, WT_FIRST, WT_TOTAL, blockIdx.x, gridDim.x);
    }
}

__device__ __forceinline__ void a_mix_phase(const Params& p, int j, bf16_t* smem) {
    const int tid = threadIdx.x, wid = tid >> 6, lane = tid & 63, wr = wid >> 1, wc = wid & 1, fr = lane & 15, fq = lane >> 4;
    bf16_t* P = (bf16_t*)(p.ws + W_BUF1);
    const bf16_t* GVt = (const bf16_t*)(p.ws + W_BUF2);
    const float* stats = (const float*)(p.ws + W_STATS);
    const bf16_t* wsa = (const bf16_t*)(p.ws + W_WS_A) + (size_t)j * 4 * 128 * 128;
    const float* ln_g = p.in[9] + j * 2048;
    const float* ln_b = p.in[10] + j * 2048;
    const float* b_s = p.in[12] + j * 4 * 128;
    const float* w_s = p.in[11] + (size_t)j * 4 * 128 * 128;
    float* av_out = p.out + O_AV + (size_t)j * 128 * 2048;
    bf16_t* As = smem;
    bf16_t* Bs = smem + 16384;
    float* mu = (float*)(smem + 16384);
    float* rs = mu + 128;
    for (int it = blockIdx.x; it < 129 * 16; it += gridDim.x) {
        const int chunk = it >> 4, g = (it >> 2) & 3, slab = it & 3;
        const bool samp = (chunk == 128);
        f32x4 sv[8];
        {
            const float* stp = stats + (size_t)(chunk * 128 + (tid >> 1)) * 64 + (tid & 1) * 32;
#pragma unroll
            for (int k = 0; k < 8; ++k) sv[k] = *(const f32x4*)(stp + k * 4);
        }
        u32x4 araw[8], braw[8];
        float lg[8], lb[8];
        const float w00 = w_s[g * 16384];
        {
            const bf16_t* wg = wsa + g * 16384;
#pragma unroll
            for (int i = 0; i < 8; ++i) {
                const int c = tid + 256 * i, row = c >> 4, sc = c & 15;
                araw[i] = (u32x4){0u, 0u, 0u, 0u};
                if (!samp) araw[i] = *(const u32x4*)(wg + row * 128 + sc * 8);
                const int ch = g * 512 + slab * 128 + permcol(row);
                braw[i] = *(const u32x4*)(GVt + ((size_t)chunk * 2048 + ch) * 128 + sc * 8);
                lg[i] = ln_g[ch];
                lb[i] = ln_b[ch];
            }
        }
        float s = 0.f, q = 0.f;
#pragma unroll
        for (int k = 0; k < 8; ++k) { s += sv[k].x + sv[k].z; q += sv[k].y + sv[k].w; }
        s += __shfl_xor(s, 1);
        q += __shfl_xor(q, 1);
        const float mean = s * (1.f / 2048.f);
        const float var = fmaxf(q * (1.f / 2048.f) - mean * mean, 0.f);
        __syncthreads();
        if ((tid & 1) == 0) { mu[tid >> 1] = mean; rs[tid >> 1] = rsqrtf(var + 1e-5f); }
        if (samp) {
#pragma unroll
            for (int i = 0; i < 8; ++i) {
                const int c = tid + 256 * i, row = c >> 4, sc = c & 15;
                if ((row >> 3) == sc) {
                    const unsigned lo = cvt_pk(w00, 0.f), hi = cvt_pk(0.f, w00);
                    const int e = row & 7;
                    const unsigned val = (e & 1) ? hi : lo;
                    if ((e >> 1) == 0) araw[i].x = val; else if ((e >> 1) == 1) araw[i].y = val; else if ((e >> 1) == 2) araw[i].z = val; else araw[i].w = val;
                }
            }
        }
#pragma unroll
        for (int i = 0; i < 8; ++i) {
            const int c = tid + 256 * i, row = c >> 4, sc = c & 15;
            *(u32x4*)(As + (sc >> 2) * 4096 + row * 32 + swz(row, sc & 3)) = araw[i];
        }
        __syncthreads();
        float mur[8], rsr[8];
#pragma unroll
        for (int e = 0; e < 8; ++e) { mur[e] = mu[(tid & 15) * 8 + e]; rsr[e] = rs[(tid & 15) * 8 + e]; }
        __syncthreads();
#pragma unroll
        for (int i = 0; i < 8; ++i) {
            const int c = tid + 256 * i, n = c >> 4, sc = c & 15;
            const int ch = g * 512 + slab * 128 + permcol(n);
            const u32x4 v = braw[i];
            float x[8];
            x[0] = bf_lo(v.x); x[1] = bf_hi(v.x); x[2] = bf_lo(v.y); x[3] = bf_hi(v.y);
            x[4] = bf_lo(v.z); x[5] = bf_hi(v.z); x[6] = bf_lo(v.w); x[7] = bf_hi(v.w);
#pragma unroll
            for (int e = 0; e < 8; ++e) x[e] = (x[e] - mur[e]) * rsr[e] * lg[i] + lb[i];
            if (samp) {
#pragma unroll
                for (int e = 0; e < 8; ++e) av_out[(size_t)(sc * 8 + e) * 2048 + ch] = x[e];
            }
            u32x4 o;
            o.x = cvt_pk(x[0], x[1]); o.y = cvt_pk(x[2], x[3]); o.z = cvt_pk(x[4], x[5]); o.w = cvt_pk(x[6], x[7]);
            *(u32x4*)(Bs + (sc >> 2) * 4096 + n * 32 + swz(n, sc & 3)) = o;
        }
        __syncthreads();
        f32x4 acc[4][4];
#pragma unroll
        for (int i = 0; i < 4; ++i)
#pragma unroll
            for (int jn = 0; jn < 4; ++jn) acc[i][jn] = (f32x4){0.f, 0.f, 0.f, 0.f};
        u32x4 pvv[4][2];
#pragma unroll
        for (int i = 0; i < 4; ++i)
#pragma unroll
            for (int g2 = 0; g2 < 2; ++g2)
                pvv[i][g2] = *(const u32x4*)(P + (size_t)(chunk * 128 + wr * 64 + i * 16 + fr) * 2048 + g * 512 + slab * 128 + wc * 64 + 32 * g2 + 8 * fq);
        mma_stage<true>(As, Bs, 4096, 4096, acc, wr, wc, lane);
        mma_stage<true>(As + 8192, Bs + 8192, 4096, 4096, acc, wr, wc, lane);
#pragma unroll
        for (int i = 0; i < 4; ++i) {
            const int t = wr * 64 + i * 16 + fr;
            const float bs = b_s[g * 128 + (samp ? 0 : t)];
            const size_t rowoff = (size_t)(chunk * 128 + t) * 2048 + g * 512 + slab * 128;
#pragma unroll
            for (int g2 = 0; g2 < 2; ++g2) {
                bf16_t* pp = P + rowoff + wc * 64 + 32 * g2 + 8 * fq;
                const u32x4 pv = pvv[i][g2];
                const f32x4 a = acc[i][2 * g2], b = acc[i][2 * g2 + 1];
                u32x4 w;
                w.x = cvt_pk(bf_lo(pv.x) * (a.x + bs), bf_hi(pv.x) * (a.y + bs));
                w.y = cvt_pk(bf_lo(pv.y) * (a.z + bs), bf_hi(pv.y) * (a.w + bs));
                w.z = cvt_pk(bf_lo(pv.z) * (b.x + bs), bf_hi(pv.z) * (b.y + bs));
                w.w = cvt_pk(bf_lo(pv.w) * (b.z + bs), bf_hi(pv.w) * (b.w + bs));
                *(u32x4*)pp = w;
            }
        }
    }
}

struct EpiY {
    bf16_t* Yb;
    float* Yp;
    __device__ __forceinline__ void operator()(f32x4 (&acc)[4][4], int m0, int n0, int wr, int wc, int lane) const {
        const int fr = lane & 15, fq = lane >> 4;
        const bool part = (m0 == M_P);
#pragma unroll
        for (int i = 0; i < 4; ++i) {
            const int m = m0 + wr * 64 + i * 16 + fr;
#pragma unroll
            for (int g2 = 0; g2 < 2; ++g2) {
                const int n = n0 + wc * 64 + 32 * g2 + 8 * fq;
                const f32x4 a = acc[i][2 * g2], b = acc[i][2 * g2 + 1];
                if (part) {
                    float* o = Yp + (size_t)(m - M_P) * 1024 + n;
                    *(f32x4*)o = a;
                    *(f32x4*)(o + 4) = b;
                } else {
                    u32x4 w;
                    w.x = cvt_pk(a.x, a.y); w.y = cvt_pk(a.z, a.w); w.z = cvt_pk(b.x, b.y); w.w = cvt_pk(b.z, b.w);
                    *(u32x4*)(Yb + (size_t)m * 1024 + n) = w;
                }
            }
        }
    }
};
__device__ __forceinline__ void out_gemm_phase(const bf16_t* A, int K, const bf16_t* Wt, float* Y, float* Ypart, bf16_t* smem) {
    const int nsplit = K >> 8;
    const int ntile = 1024 + 8 * nsplit;
    Stage st;
    bool pre = false;
    for (int t = blockIdx.x; t < ntile; t += gridDim.x) {
        const bool full = t < 1024;
        const int u = t - 1024, ks = full ? 0 : (u >> 3);
        const int m0 = full ? (t >> 3) * 128 : M_P, n0 = (full ? (t & 7) : (u & 7)) * 128, Kt = full ? K : 256;
        const int tn = t + gridDim.x;
        const bool hn = tn < ntile, fulln = tn < 1024;
        const int un = tn - 1024, ksn = fulln ? 0 : (un >> 3);
        const int m0n = fulln ? (tn >> 3) * 128 : M_P, n0n = (fulln ? (tn & 7) : (un & 7)) * 128;
        EpiY e{(bf16_t*)Y, Ypart + (size_t)ks * 128 * 1024};
        gemm_tile<true>(A + ks * 256, K, Wt + ks * 256, K, Kt, m0, n0, smem, e, st, pre, hn, A + ksn * 256, Wt + ksn * 256, m0n, n0n);
        pre = hn;
    }
}

struct EpiSilu {
    bf16_t* O;
    int ldo, col0;
    __device__ __forceinline__ void operator()(f32x4 (&acc)[4][4], int m0, int n0, int wr, int wc, int lane) const {
        const int fr = lane & 15, fq = lane >> 4;
#pragma unroll
        for (int i = 0; i < 4; ++i) {
            const int m = m0 + wr * 64 + i * 16 + fr;
#pragma unroll
            for (int jn = 0; jn < 4; ++jn) {
                const f32x4 a = acc[i][jn];
                u32x2 w;
                w.x = cvt_pk(silu_f(a.x), silu_f(a.y));
                w.y = cvt_pk(silu_f(a.z), silu_f(a.w));
                *(u32x2*)(O + (size_t)m * ldo + col0 + wc * 64 + jn * 16 + fq * 4) = w;
            }
        }
    }
};
struct EpiCopy {
    bf16_t* O;
    int ldo, col0;
    __device__ __forceinline__ void operator()(f32x4 (&acc)[4][4], int m0, int n0, int wr, int wc, int lane) const {
        const int fr = lane & 15, fq = lane >> 4;
#pragma unroll
        for (int i = 0; i < 4; ++i) {
            const int m = m0 + wr * 64 + i * 16 + fr;
#pragma unroll
            for (int jn = 0; jn < 4; ++jn) {
                const f32x4 a = acc[i][jn];
                u32x2 w;
                w.x = cvt_pk(a.x, a.y);
                w.y = cvt_pk(a.z, a.w);
                *(u32x2*)(O + (size_t)m * ldo + col0 + wc * 64 + jn * 16 + fq * 4) = w;
            }
        }
    }
};
template <int isk> struct EpiRope {
    bf16_t* O;
    int ldo, col0;
    const float* rope;
    float* out;
    __device__ __forceinline__ void operator()(f32x4 (&acc)[4][4], int m0, int n0, int wr, int wc, int lane) const {
        const int fr = lane & 15, fq = lane >> 4;
#pragma unroll
        for (int i = 0; i < 4; ++i) {
            const int m = m0 + wr * 64 + i * 16 + fr;
            const int pos = (m < M_P) ? (m & (SEQ - 1)) : SEQ;
            const float* rt = rope + (size_t)pos * 64;
            const float scale = isk ? 1.0f : 0.125f;
#pragma unroll
            for (int jn = 0; jn < 2; ++jn) {
                const int d = jn * 16 + fq * 4;
                const f32x4 c = *(const f32x4*)(rt + d), s = *(const f32x4*)(rt + 32 + d);
                const f32x4 x1 = acc[i][jn], x2 = acc[i][jn + 2];
                const f32x4 o1 = (x1 * c - x2 * s) * scale, o2 = (x2 * c + x1 * s) * scale;
                u32x2 w1, w2;
                w1.x = cvt_pk(o1.x, o1.y); w1.y = cvt_pk(o1.z, o1.w);
                w2.x = cvt_pk(o2.x, o2.y); w2.y = cvt_pk(o2.z, o2.w);
                bf16_t* dst = O + (size_t)m * ldo + col0 + wc * 64 + d;
                *(u32x2*)dst = w1;
                *(u32x2*)(dst + 32) = w2;
                if (isk) {
                    if (m < M_P) {
                        const int t = m & (SEQ - 1), b = m >> 13;
                        if (t >= SEQ - 128) {
                            float* o = out + O_BKP + ((size_t)(b * 128 + t - (SEQ - 128)) * 2 + wc) * 64 + d;
                            *(f32x4*)o = o1;
                            *(f32x4*)(o + 32) = o2;
                        }
                    } else {
                        float* o = out + O_BKS + ((size_t)((m - M_P) * 128 + 127) * 2 + wc) * 64 + d;
                        *(f32x4*)o = o1;
                        *(f32x4*)(o + 32) = o2;
                    }
                }
            }
        }
    }
};
struct EpiVt {
    bf16_t* Vt;
    float* out;
    __device__ __forceinline__ void operator()(f32x4 (&acc)[4][4], int m0, int n0, int wr, int wc, int lane) const {
        const int fr = lane & 15, fq = lane >> 4;
#pragma unroll
        for (int i = 0; i < 4; ++i) {
            const int m = m0 + wr * 64 + i * 16 + fq * 4;
#pragma unroll
            for (int jn = 0; jn < 4; ++jn) {
                const int d = jn * 16 + fr;
                const f32x4 a = acc[i][jn];
                if (m < M_P) {
                    const int t = m & (SEQ - 1), b = m >> 13;
                    u32x2 w;
                    w.x = cvt_pk(a.x, a.y);
                    w.y = cvt_pk(a.z, a.w);
                    *(u32x2*)(Vt + ((size_t)(b * 2 + wc) * 64 + d) * SEQ + t) = w;
                    if (t >= SEQ - 128) {
                        float* o = out + O_BVP + ((size_t)(b * 128 + t - (SEQ - 128)) * 2 + wc) * 64 + d;
                        o[0] = a.x; o[128] = a.y; o[256] = a.z; o[384] = a.w;
                    }
                } else {
                    float* o = out + O_BVS + ((size_t)((m - M_P) * 128 + 127) * 2 + wc) * 64 + d;
                    o[0] = a.x; o[16384] = a.y; o[32768] = a.z; o[49152] = a.w;
                }
            }
        }
    }
};

struct EpiB {
    bf16_t *Q, *SG, *KV;
    const float* rope;
    float* out;
    int nt;
    __device__ __forceinline__ void operator()(f32x4 (&acc)[4][4], int m0, int n0, int wr, int wc, int lane) const {
        const int fr = lane & 15, fq = lane >> 4;
        if (nt < 9) {
            const bool isk = (nt == 8);
            const float scale = isk ? 1.0f : 0.125f;
#pragma unroll
            for (int i = 0; i < 4; ++i) {
                const int m = m0 + wr * 64 + i * 16 + fr;
                const int pos = (m < M_P) ? (m & (SEQ - 1)) : SEQ;
                const float* rt = rope + (size_t)pos * 64;
                const int d = 8 * fq;
                f32x4 o1[2], o2[2];
#pragma unroll
                for (int jl = 0; jl < 2; ++jl) {
                    const f32x4 c = *(const f32x4*)(rt + d + 4 * jl), s = *(const f32x4*)(rt + 32 + d + 4 * jl);
                    const f32x4 x1 = acc[i][jl], x2 = acc[i][jl + 2];
                    o1[jl] = (x1 * c - x2 * s) * scale;
                    o2[jl] = (x2 * c + x1 * s) * scale;
                }
                u32x4 w1, w2;
                w1.x = cvt_pk(o1[0].x, o1[0].y); w1.y = cvt_pk(o1[0].z, o1[0].w); w1.z = cvt_pk(o1[1].x, o1[1].y); w1.w = cvt_pk(o1[1].z, o1[1].w);
                w2.x = cvt_pk(o2[0].x, o2[0].y); w2.y = cvt_pk(o2[0].z, o2[0].w); w2.z = cvt_pk(o2[1].x, o2[1].y); w2.w = cvt_pk(o2[1].z, o2[1].w);
                bf16_t* dst = isk ? KV + (size_t)m * 256 + wc * 64 + d : Q + (size_t)m * 1024 + nt * 128 + wc * 64 + d;
                *(u32x4*)dst = w1;
                *(u32x4*)(dst + 32) = w2;
                if (isk) {
                    float* o = nullptr;
                    if (m < M_P) {
                        const int t = m & (SEQ - 1), b = m >> 13;
                        if (t >= SEQ - 128) o = out + O_BKP + ((size_t)(b * 128 + t - (SEQ - 128)) * 2 + wc) * 64 + d;
                    } else o = out + O_BKS + ((size_t)((m - M_P) * 128 + 127) * 2 + wc) * 64 + d;
                    if (o) { *(f32x4*)o = o1[0]; *(f32x4*)(o + 4) = o1[1]; *(f32x4*)(o + 32) = o2[0]; *(f32x4*)(o + 36) = o2[1]; }
                }
            }
        } else if (nt == 9) {
#pragma unroll
            for (int i = 0; i < 4; ++i) {
                const int m = m0 + wr * 64 + i * 16 + fr;
                float* o = nullptr;
                if (m < M_P) {
                    const int t = m & (SEQ - 1), b = m >> 13;
                    if (t >= SEQ - 128) o = out + O_BVP + ((size_t)(b * 128 + t - (SEQ - 128)) * 2 + wc) * 64;
                } else o = out + O_BVS + ((size_t)((m - M_P) * 128 + 127) * 2 + wc) * 64;
#pragma unroll
                for (int g2 = 0; g2 < 2; ++g2) {
                    const int d = 32 * g2 + 8 * fq;
                    const f32x4 a = acc[i][2 * g2], b = acc[i][2 * g2 + 1];
                    u32x4 w;
                    w.x = cvt_pk(a.x, a.y); w.y = cvt_pk(a.z, a.w); w.z = cvt_pk(b.x, b.y); w.w = cvt_pk(b.z, b.w);
                    *(u32x4*)(KV + (size_t)m * 256 + 128 + wc * 64 + d) = w;
                    if (o) { *(f32x4*)(o + d) = a; *(f32x4*)(o + d + 4) = b; }
                }
            }
        } else {
#pragma unroll
            for (int i = 0; i < 4; ++i) {
                const int m = m0 + wr * 64 + i * 16 + fr;
#pragma unroll
                for (int g2 = 0; g2 < 2; ++g2) {
                    const f32x4 a = acc[i][2 * g2], b = acc[i][2 * g2 + 1];
                    u32x4 w;
                    w.x = cvt_pk(silu_f(a.x), silu_f(a.y)); w.y = cvt_pk(silu_f(a.z), silu_f(a.w));
                    w.z = cvt_pk(silu_f(b.x), silu_f(b.y)); w.w = cvt_pk(silu_f(b.z), silu_f(b.w));
                    *(u32x4*)(SG + (size_t)m * 1024 + (nt - 10) * 128 + wc * 64 + 32 * g2 + 8 * fq) = w;
                }
            }
        }
    }
};

__device__ __forceinline__ void b_in_phase(const Params& p, bf16_t* smem) {
    const bf16_t* H = (const bf16_t*)(p.ws + W_H);
    const bf16_t* Wt = (const bf16_t*)(p.ws + W_B_IN);
    bf16_t* Q = (bf16_t*)(p.ws + W_BUF1);
    bf16_t* SG = Q + (size_t)MT * 1024;
    bf16_t* KV = (bf16_t*)(p.ws + W_KB);
    const float* rope = (const float*)(p.ws + W_ROPE);
    Stage st;
    bool pre = false;
    for (int t = blockIdx.x; t < 129 * 18; t += gridDim.x) {
        const int mt = t < 2064 ? (t >> 4) : ((t - 2064) >> 1), nt = t < 2064 ? (t & 15) : 16 + ((t - 2064) & 1);
        const int tn = t + gridDim.x;
        const bool hn = tn < 129 * 18;
        const int mtn = tn < 2064 ? (tn >> 4) : ((tn - 2064) >> 1), ntn = tn < 2064 ? (tn & 15) : 16 + ((tn - 2064) & 1);
        EpiB e{Q, SG, KV, rope, p.out, nt};
        gemm_tile<true>(H, 1024, Wt, 1024, 1024, mt * 128, nt * 128, smem, e, st, pre, hn, H, Wt, mtn * 128, ntn * 128);
        pre = hn;
    }
}

constexpr int VT_LD = 256;
__device__ __forceinline__ void attn_prompt_item(const Params& p, int item, bf16_t* smem) {
    const int tid = threadIdx.x, w = tid >> 6, lane = tid & 63, fr = lane & 15, fq = lane >> 4;
    const int half = item & 1, kvh = (item >> 1) & 1, nb = (item >> 2) & 63, b = item >> 8;
    const bf16_t* Q = (const bf16_t*)(p.ws + W_BUF1);
    const bf16_t* SG = Q + (size_t)MT * 1024;
    const bf16_t* KV = (const bf16_t*)(p.ws + W_KB);
    bf16_t* Z = (bf16_t*)(p.ws + W_H);
    bf16_t* Ks = smem;
    bf16_t* Vs = smem + 16384;
    const int row0 = b * SEQ + nb * 128;
    __syncthreads();
#pragma unroll
    for (int i = 0; i < 8; ++i) {
        const int c = tid + 256 * i, key = c >> 3, kc = c & 7;
        u32x4 v = {0u, 0u, 0u, 0u};
        if (nb > 0 || key >= 128) v = *(const u32x4*)(KV + (size_t)(row0 - 128 + key) * 256 + kvh * 64 + kc * 8);
        *(u32x4*)(Ks + (kc >> 2) * 8192 + key * 32 + swz(key, kc & 3)) = v;
    }
#pragma unroll
    for (int i = 0; i < 8; ++i) {
        const int c = tid + 256 * i, key = c >> 3, dc = c & 7;
        u32x4 v = {0u, 0u, 0u, 0u};
        if (nb > 0 || key >= 128) v = *(const u32x4*)(KV + (size_t)(row0 - 128 + key) * 256 + 128 + kvh * 64 + dc * 8);
        const unsigned wv[4] = {v.x, v.y, v.z, v.w};
#pragma unroll
        for (int e = 0; e < 8; ++e) {
            const int d = dc * 8 + e;
            const unsigned short hv = (e & 1) ? (unsigned short)(wv[e >> 1] >> 16) : (unsigned short)(wv[e >> 1] & 0xffff);
            Vs[d * VT_LD + (((key >> 3) ^ ((d & 15) << 1)) << 3) + (key & 7)] = hv;
        }
    }
    __syncthreads();
    const int co = swz(fr, fq);
#pragma unroll 1
    for (int gq = half * 8; gq < half * 8 + 8; ++gq) {
        const int g = gq >> 1, qt = gq & 1;
        const int h = kvh * 8 + g;
        const float sink = p.in[15][h];
        const int qi = 32 * w + 16 * qt + fr;
        bf16x8 qf[2];
#pragma unroll
        for (int kk = 0; kk < 2; ++kk)
            qf[kk] = *(const bf16x8*)(Q + (size_t)(row0 + qi) * 1024 + h * 64 + kk * 32 + fq * 8);
        f32x4 s[10];
#pragma unroll
        for (int kt = 0; kt < 10; ++kt) s[kt] = (f32x4){0.f, 0.f, 0.f, 0.f};
#pragma unroll
        for (int kt = 0; kt < 10; ++kt) {
#pragma unroll
            for (int kk = 0; kk < 2; ++kk) {
                const bf16x8 kf = *(const bf16x8*)(Ks + kk * 8192 + (16 * (2 * w + kt) + fr) * 32 + co);
                s[kt] = __builtin_amdgcn_mfma_f32_16x16x32_bf16(kf, qf[kk], s[kt], 0, 0, 0);
            }
            if (kt & 1) __builtin_amdgcn_sched_barrier(0);
        }
        float mx = sink;
#pragma unroll
        for (int kt = 0; kt < 10; ++kt) {
            const int key0 = 16 * (2 * w + kt) + fq * 4;
#pragma unroll
            for (int r = 0; r < 4; ++r) {
                const int key = key0 + r;
                const bool valid = (key >= qi) && (key <= qi + 128) && (nb > 0 || key >= 128);
                const float v = valid ? s[kt][r] : -1e30f;
                s[kt][r] = v;
                mx = fmaxf(mx, v);
            }
        }
        mx = fmaxf(mx, __shfl_xor(mx, 16));
        mx = fmaxf(mx, __shfl_xor(mx, 32));
        float sum = 0.f;
#pragma unroll
        for (int kt = 0; kt < 10; ++kt)
#pragma unroll
            for (int r = 0; r < 4; ++r) {
                const float e = __expf(s[kt][r] - mx);
                s[kt][r] = e;
                sum += e;
            }
        sum += __shfl_xor(sum, 16);
        sum += __shfl_xor(sum, 32);
        const float inv = __builtin_amdgcn_rcpf(sum + __expf(sink - mx));
        f32x4 o[4];
#pragma unroll
        for (int dt = 0; dt < 4; ++dt) o[dt] = (f32x4){0.f, 0.f, 0.f, 0.f};
#pragma unroll
        for (int ks = 0; ks < 5; ++ks) {
            u32x4 pw;
            pw.x = cvt_pk(s[2 * ks][0], s[2 * ks][1]);
            pw.y = cvt_pk(s[2 * ks][2], s[2 * ks][3]);
            pw.z = cvt_pk(s[2 * ks + 1][0], s[2 * ks + 1][1]);
            pw.w = cvt_pk(s[2 * ks + 1][2], s[2 * ks + 1][3]);
            const bf16x8 pf = __builtin_bit_cast(bf16x8, pw);
            const int kc0 = (((2 * w + 2 * ks) ^ fr) << 4) + fq * 4, kc1 = (((2 * w + 2 * ks + 1) ^ fr) << 4) + fq * 4;
#pragma unroll
            for (int dt = 0; dt < 4; ++dt) {
                const bf16_t* vp = Vs + (16 * dt + fr) * VT_LD;
                u32x4 vw;
                const u32x2 v0 = *(const u32x2*)(vp + kc0), v1 = *(const u32x2*)(vp + kc1);
                vw.x = v0.x; vw.y = v0.y; vw.z = v1.x; vw.w = v1.y;
                const bf16x8 vf = __builtin_bit_cast(bf16x8, vw);
                o[dt] = __builtin_amdgcn_mfma_f32_16x16x32_bf16(vf, pf, o[dt], 0, 0, 0);
            }
            __builtin_amdgcn_sched_barrier(0);
        }
        const size_t ro = (size_t)(row0 + qi) * 1024 + h * 64;
#pragma unroll
        for (int dt = 0; dt < 4; ++dt) {
            const int d = 16 * dt + fq * 4;
            const u32x2 sg = *(const u32x2*)(SG + ro + d);
            const f32x4 ov = o[dt] * inv;
            u32x2 wv;
            wv.x = cvt_pk(ov.x * bf_lo(sg.x), ov.y * bf_hi(sg.x));
            wv.y = cvt_pk(ov.z * bf_lo(sg.y), ov.w * bf_hi(sg.y));
            *(u32x2*)(Z + ro + d) = wv;
        }
    }
}

__device__ __forceinline__ void attn_sample_item(const Params& p, int item, unsigned char* smem_raw) {
    const int tid = threadIdx.x, g = tid >> 5, l = tid & 31;
    const int kvh = item & 1, b = item >> 1;
    const bf16_t* Q = (const bf16_t*)(p.ws + W_BUF1);
    const bf16_t* SG = Q + (size_t)MT * 1024;
    bf16_t* Z = (bf16_t*)(p.ws + W_H);
    float* kv = (float*)smem_raw;
    float* qs = kv + 129 * 65;
    float* ps = qs + 512;
    const float* ck = p.in[2];
    const float* cv = p.in[3];
    float* oks = p.out + O_BKS;
    float* ovs = p.out + O_BVS;
    const int row = M_P + b;
    f32x4 knew = {0.f, 0.f, 0.f, 0.f}, vnew = {0.f, 0.f, 0.f, 0.f};
    if (tid < 16) knew = *(const f32x4*)(oks + ((size_t)(b * 128 + 127) * 2 + kvh) * 64 + tid * 4);
    const float q0 = bf2f(Q[(size_t)row * 1024 + kvh * 512 + tid]), q1 = bf2f(Q[(size_t)row * 1024 + kvh * 512 + 256 + tid]);
    __syncthreads();
#pragma unroll 1
    for (int hb = 0; hb < 2; ++hb) {
        f32x4 kreg[4];
#pragma unroll
        for (int i = 0; i < 4; ++i) {
            const int c = tid + 256 * (hb * 4 + i), key = c >> 4, d4 = (c & 15) * 4;
            kreg[i] = *(const f32x4*)(ck + ((size_t)(b * 128 + key) * 2 + kvh) * 64 + d4);
        }
#pragma unroll
        for (int i = 0; i < 4; ++i) {
            const int c = tid + 256 * (hb * 4 + i), key = c >> 4, d4 = (c & 15) * 4;
            if (key >= 1) *(f32x4*)(oks + ((size_t)(b * 128 + key - 1) * 2 + kvh) * 64 + d4) = kreg[i];
            float* kp = kv + key * 65 + d4;
            kp[0] = kreg[i].x; kp[1] = kreg[i].y; kp[2] = kreg[i].z; kp[3] = kreg[i].w;
        }
    }
    if (tid < 16) { float* kp = kv + 128 * 65 + tid * 4; kp[0] = knew.x; kp[1] = knew.y; kp[2] = knew.z; kp[3] = knew.w; }
    qs[tid] = q0;
    qs[256 + tid] = q1;
    if (tid < 16) vnew = *(const f32x4*)(ovs + ((size_t)(b * 128 + 127) * 2 + kvh) * 64 + tid * 4);
    __syncthreads();
    const int h = kvh * 8 + g;
    const float sink = p.in[15][h];
    float sc[5];
    float mx = sink;
#pragma unroll
    for (int i = 0; i < 5; ++i) {
        const int key = l + 32 * i;
        float a = -1e30f;
        if (key < 129) {
            a = 0.f;
#pragma unroll 8
            for (int d = 0; d < 64; ++d) a += qs[g * 64 + d] * kv[key * 65 + d];
        }
        sc[i] = a;
        mx = fmaxf(mx, a);
    }
#pragma unroll
    for (int o = 1; o < 32; o <<= 1) mx = fmaxf(mx, __shfl_xor(mx, o));
    float sum = 0.f;
#pragma unroll
    for (int i = 0; i < 5; ++i) {
        const int key = l + 32 * i;
        const float e = (key < 129) ? __expf(sc[i] - mx) : 0.f;
        sc[i] = e;
        sum += e;
    }
#pragma unroll
    for (int o = 1; o < 32; o <<= 1) sum += __shfl_xor(sum, o);
    const float inv = __builtin_amdgcn_rcpf(sum + __expf(sink - mx));
#pragma unroll
    for (int i = 0; i < 5; ++i) {
        const int key = l + 32 * i;
        if (key < 129) ps[g * 132 + key] = sc[i] * inv;
    }
    __syncthreads();
#pragma unroll 1
    for (int hb = 0; hb < 2; ++hb) {
        f32x4 vreg[4];
#pragma unroll
        for (int i = 0; i < 4; ++i) {
            const int c = tid + 256 * (hb * 4 + i), key = c >> 4, d4 = (c & 15) * 4;
            vreg[i] = *(const f32x4*)(cv + ((size_t)(b * 128 + key) * 2 + kvh) * 64 + d4);
        }
#pragma unroll
        for (int i = 0; i < 4; ++i) {
            const int c = tid + 256 * (hb * 4 + i), key = c >> 4, d4 = (c & 15) * 4;
            if (key >= 1) *(f32x4*)(ovs + ((size_t)(b * 128 + key - 1) * 2 + kvh) * 64 + d4) = vreg[i];
            float* kp = kv + key * 65 + d4;
            kp[0] = vreg[i].x; kp[1] = vreg[i].y; kp[2] = vreg[i].z; kp[3] = vreg[i].w;
        }
    }
    if (tid < 16) { float* kp = kv + 128 * 65 + tid * 4; kp[0] = vnew.x; kp[1] = vnew.y; kp[2] = vnew.z; kp[3] = vnew.w; }
    __syncthreads();
    float o0 = 0.f, o1 = 0.f;
    for (int key = 0; key < 129; ++key) {
        const float pv = ps[g * 132 + key];
        o0 += pv * kv[key * 65 + l];
        o1 += pv * kv[key * 65 + l + 32];
    }
    const size_t ro = (size_t)row * 1024 + h * 64;
    Z[ro + l] = (bf16_t)(cvt_pk(o0 * bf2f(SG[ro + l]), 0.f) & 0xffff);
    Z[ro + l + 32] = (bf16_t)(cvt_pk(o1 * bf2f(SG[ro + l + 32]), 0.f) & 0xffff);
}

__device__ __forceinline__ void b_attn_phase(const Params& p, unsigned char* smem_raw) {
    for (int it = blockIdx.x; it < 768; it += gridDim.x) {
        if (it < 512) attn_prompt_item(p, it, (bf16_t*)smem_raw);
        else attn_sample_item(p, it - 512, smem_raw);
    }
}

struct EpiAct {
    bf16_t* XR;
    int ldo, col0, act;
    __device__ __forceinline__ void operator()(f32x4 (&acc)[4][4], int m0, int n0, int wr, int wc, int lane) const {
        const int fr = lane & 15, fq = lane >> 4;
        bf16_t* O = act ? XR + (size_t)MT * 1024 - 1024 : XR;
#pragma unroll
        for (int i = 0; i < 4; ++i) {
            const int m = m0 + wr * 64 + i * 16 + fr;
#pragma unroll
            for (int g2 = 0; g2 < 2; ++g2) {
                f32x4 a = acc[i][2 * g2], b = acc[i][2 * g2 + 1];
                if (act) {
                    a.x = silu_f(a.x); a.y = silu_f(a.y); a.z = silu_f(a.z); a.w = silu_f(a.w);
                    b.x = silu_f(b.x); b.y = silu_f(b.y); b.z = silu_f(b.z); b.w = silu_f(b.w);
                }
                u32x4 w;
                w.x = cvt_pk(a.x, a.y); w.y = cvt_pk(a.z, a.w); w.z = cvt_pk(b.x, b.y); w.w = cvt_pk(b.z, b.w);
                *(u32x4*)(O + (size_t)m * ldo + col0 + wc * 64 + 32 * g2 + 8 * fq) = w;
            }
        }
    }
};
__device__ __forceinline__ void c_in_phase(const Params& p, bf16_t* smem) {
    const bf16_t* H = (const bf16_t*)(p.ws + W_H);
    const bf16_t* Wt = (const bf16_t*)(p.ws + W_C_IN);
    bf16_t* XR = (bf16_t*)(p.ws + W_BUF1);
    bf16_t* SG = XR + (size_t)MT * 1024;
    Stage st;
    bool pre = false;
    for (int t = blockIdx.x; t < 129 * 16; t += gridDim.x) {
        const int mt = t >> 4, nt = t & 15;
        const int tn = t + gridDim.x;
        const bool hn = tn < 129 * 16;
        EpiAct e{XR, 1024, nt * 128, nt >= 8};
        gemm_tile<true>(H, 1024, Wt, 1024, 1024, mt * 128, nt * 128, smem, e, st, pre, hn, H, Wt, (tn >> 4) * 128, (tn & 15) * 128);
        pre = hn;
    }
}

__device__ __forceinline__ void unpack8(const u32x4 v, float (&x)[8]) {
    x[0] = bf_lo(v.x); x[1] = bf_hi(v.x); x[2] = bf_lo(v.y); x[3] = bf_hi(v.y);
    x[4] = bf_lo(v.z); x[5] = bf_hi(v.z); x[6] = bf_lo(v.w); x[7] = bf_hi(v.w);
}

__device__ __forceinline__ void c_conv_phase(const Params& p) {
    const bf16_t* XR = (const bf16_t*)(p.ws + W_BUF1);
    bf16_t* XC = (bf16_t*)(p.ws + W_H);
    const float* cw = p.in[18];
    const float* cb = p.in[19];
    const float* st = p.in[4];
    const int gt = blockIdx.x * NTHREADS + threadIdx.x, gn = gridDim.x * NTHREADS;
    const int c0 = (gt & 127) * 8;
    float w0[8], w1[8], w2[8], w3[8], bias[8];
#pragma unroll
    for (int e = 0; e < 8; ++e) {
        w0[e] = cw[c0 + e]; w1[e] = cw[1024 + c0 + e]; w2[e] = cw[2048 + c0 + e]; w3[e] = cw[3072 + c0 + e]; bias[e] = cb[c0 + e];
    }
    for (int run = gt >> 7; run < M_P / 8; run += gn >> 7) {
        const int r0 = run * 8, t0 = r0 & (SEQ - 1), b = r0 >> 13;
        u32x4 raw[11];
#pragma unroll
        for (int q = 0; q < 11; ++q) {
            raw[q] = (u32x4){0u, 0u, 0u, 0u};
            if (q >= 3 || t0 > 0) raw[q] = *(const u32x4*)(XR + (size_t)(r0 - 3 + q) * 1024 + c0);
        }
        float x0[8], x1[8], x2[8], x3[8];
        unpack8(raw[0], x0); unpack8(raw[1], x1); unpack8(raw[2], x2);
#pragma unroll
        for (int q = 0; q < 8; ++q) {
            unpack8(raw[q + 3], x3);
            float acc[8];
#pragma unroll
            for (int e = 0; e < 8; ++e) acc[e] = bias[e] + x0[e] * w0[e] + x1[e] * w1[e] + x2[e] * w2[e] + x3[e] * w3[e];
            u32x4 o;
            o.x = cvt_pk(acc[0], acc[1]); o.y = cvt_pk(acc[2], acc[3]); o.z = cvt_pk(acc[4], acc[5]); o.w = cvt_pk(acc[6], acc[7]);
            *(u32x4*)(XC + (size_t)(r0 + q) * 1024 + c0) = o;
            const int t = t0 + q;
            if (t >= SEQ - 3) {
                float* oo = p.out + O_CCP + ((size_t)b * 3 + (t - (SEQ - 3))) * 1024 + c0;
#pragma unroll
                for (int e = 0; e < 8; ++e) oo[e] = x3[e];
            }
#pragma unroll
            for (int e = 0; e < 8; ++e) { x0[e] = x1[e]; x1[e] = x2[e]; x2[e] = x3[e]; }
        }
    }
    for (int b = gt >> 7; b < M_S; b += gn >> 7) {
        const int row = M_P + b;
        float xv[8], acc[8];
        unpack8(*(const u32x4*)(XR + (size_t)row * 1024 + c0), xv);
#pragma unroll
        for (int e = 0; e < 8; ++e) {
            const float s0 = st[((size_t)b * 3 + 0) * 1024 + c0 + e], s1 = st[((size_t)b * 3 + 1) * 1024 + c0 + e], s2 = st[((size_t)b * 3 + 2) * 1024 + c0 + e];
            acc[e] = bias[e] + s0 * w0[e] + s1 * w1[e] + s2 * w2[e] + xv[e] * w3[e];
            p.out[O_CCS + ((size_t)b * 3 + 0) * 1024 + c0 + e] = s1;
            p.out[O_CCS + ((size_t)b * 3 + 1) * 1024 + c0 + e] = s2;
            p.out[O_CCS + ((size_t)b * 3 + 2) * 1024 + c0 + e] = xv[e];
        }
        u32x4 o;
        o.x = cvt_pk(acc[0], acc[1]); o.y = cvt_pk(acc[2], acc[3]); o.z = cvt_pk(acc[4], acc[5]); o.w = cvt_pk(acc[6], acc[7]);
        *(u32x4*)(XC + (size_t)row * 1024 + c0) = o;
    }
}

struct EpiGate {
    const bf16_t* XC;
    float* Aa;
    bf16_t* Bb;
    const float *b_a, *b_x, *lam;
    int blk, nt;
    float* lds;
    float* carry;
    __device__ __forceinline__ void operator()(f32x4 (&acc)[4][4], int m0, int n0, int wr, int wc, int lane) const {
        const int fr = lane & 15, fq = lane >> 4;
        const bool prompt = (m0 < M_P);
        __syncthreads();
#pragma unroll
        for (int jn = 0; jn < 2; ++jn) {
            const int cl = 32 * wc + 8 * fq + 4 * jn;
            const int d = blk * 256 + 64 * nt + cl;
            const f32x4 ba = *(const f32x4*)(b_a + d), bx = *(const f32x4*)(b_x + d), lm = *(const f32x4*)(lam + d);
            f32x4 sp;
            sp.x = log1pf(__expf(-lm.x)); sp.y = log1pf(__expf(-lm.y)); sp.z = log1pf(__expf(-lm.z)); sp.w = log1pf(__expf(-lm.w));
#pragma unroll
            for (int i = 0; i < 4; ++i) {
                const int rl = wr * 64 + i * 16 + fr, m = m0 + rl;
                const bool first = (m < M_P) && ((m & (SEQ - 1)) == 0);
                const u32x2 xw = *(const u32x2*)(XC + (size_t)m * 1024 + d);
                const f32x4 xc = {bf_lo(xw.x), bf_hi(xw.x), bf_lo(xw.y), bf_hi(xw.y)};
                const f32x4 ra = acc[i][jn] + ba, ia = acc[i][jn + 2] + bx;
                f32x4 av, bv;
#pragma unroll
                for (int r = 0; r < 4; ++r) {
                    const float rg = sigmoid_f(ra[r]), ig = sigmoid_f(ia[r]);
                    const float la = -8.0f * rg * sp[r];
                    const float a = __expf(la);
                    av[r] = a;
                    const float mult = first ? 1.0f : __builtin_amdgcn_sqrtf(fmaxf(1.0f - a * a, 0.f));
                    bv[r] = mult * (ig * xc[r]);
                }
                *(f32x4*)(Aa + (size_t)m * 1024 + d) = av;
                u32x2 w;
                w.x = cvt_pk(bv.x, bv.y);
                w.y = cvt_pk(bv.z, bv.w);
                *(u32x2*)(Bb + (size_t)m * 1024 + d) = w;
                if (prompt) {
                    *(f32x4*)(lds + rl * 64 + cl) = av;
                    *(f32x4*)(lds + 8192 + rl * 64 + cl) = (f32x4){bf_lo(w.x), bf_hi(w.x), bf_lo(w.y), bf_hi(w.y)};
                }
            }
        }
        __syncthreads();
        if (prompt && threadIdx.x < 64) {
            float A = 1.f, h = 0.f;
#pragma unroll 16
            for (int r = 0; r < 128; ++r) {
                const float a = lds[r * 64 + threadIdx.x], b = lds[8192 + r * 64 + threadIdx.x];
                A *= a;
                h = a * h + b;
            }
            const int chunk = m0 >> 7, d = blk * 256 + 64 * nt + threadIdx.x;
            carry[(size_t)chunk * 2048 + d] = A;
            carry[(size_t)chunk * 2048 + 1024 + d] = h;
        }
    }
};

__device__ __forceinline__ void c_gate_phase(const Params& p, bf16_t* smem) {
    const bf16_t* XC = (const bf16_t*)(p.ws + W_H);
    const bf16_t* Wg = (const bf16_t*)(p.ws + W_C_G);
    float* Aa = (float*)(p.ws + W_BUF2);
    bf16_t* Bb = (bf16_t*)(p.ws + W_BUF1);
    Stage st;
    bool pre = false;
    for (int t = blockIdx.x; t < 129 * 16; t += gridDim.x) {
        const int mt = t >> 4, blk = (t >> 2) & 3, nt = t & 3;
        const int tn = t + gridDim.x, blkn = (tn >> 2) & 3;
        const bool hn = tn < 129 * 16;
        EpiGate e{XC, Aa, Bb, p.in[21], p.in[23], p.in[24], blk, nt, (float*)smem, (float*)(p.ws + W_CARRY)};
        gemm_tile<true>(XC + blk * 256, 1024, Wg + (size_t)blk * 512 * 256, 256, 256, mt * 128, nt * 128, smem, e, st, pre, hn,
                        XC + blkn * 256, Wg + (size_t)blkn * 512 * 256, (tn >> 4) * 128, (tn & 3) * 128);
        pre = hn;
    }
}

__device__ __forceinline__ void c_scan1_phase(const Params& p) {
    const float* Aa = (const float*)(p.ws + W_BUF2);
    const bf16_t* Bb = (const bf16_t*)(p.ws + W_BUF1);
    float* carry = (float*)(p.ws + W_CARRY);
    for (int it = blockIdx.x; it < 512; it += gridDim.x) {
        const int chunk = it >> 2, d = (it & 3) * 256 + threadIdx.x;
        float A = 1.f, h = 0.f;
        const size_t base = (size_t)chunk * 128 * 1024 + d;
#pragma unroll 8
        for (int r = 0; r < 128; ++r) {
            const float a = Aa[base + (size_t)r * 1024], b = bf2f(Bb[base + (size_t)r * 1024]);
            A *= a;
            h = a * h + b;
        }
        carry[(size_t)chunk * 2048 + d] = A;
        carry[(size_t)chunk * 2048 + 1024 + d] = h;
    }
}

__device__ __forceinline__ void c_scan2_phase(const Params& p) {
    const float* Aa = (const float*)(p.ws + W_BUF2);
    const bf16_t* Bb = (const bf16_t*)(p.ws + W_BUF1);
    const bf16_t* SG = Bb + (size_t)MT * 1024;
    const float* carry = (const float*)(p.ws + W_CARRY);
    bf16_t* Z = (bf16_t*)(p.ws + W_H);
    for (int it = blockIdx.x; it < 512 + 512; it += gridDim.x) {
        if (it < 512) {
            const int chunk = it >> 2, d = (it & 3) * 256 + threadIdx.x;
            const int b = chunk >> 6, ci = chunk & 63;
            float h = 0.f;
            {
                const float* c0 = carry + (size_t)(b * 64) * 2048 + d;
                int jc = 0;
                for (; jc + 16 <= ci; jc += 16) {
                    float ca[16], ch[16];
#pragma unroll
                    for (int q = 0; q < 16; ++q) { ca[q] = c0[(size_t)(jc + q) * 2048]; ch[q] = c0[(size_t)(jc + q) * 2048 + 1024]; }
#pragma unroll
                    for (int q = 0; q < 16; ++q) h = ca[q] * h + ch[q];
                }
                for (; jc < ci; ++jc) h = c0[(size_t)jc * 2048] * h + c0[(size_t)jc * 2048 + 1024];
            }
            const size_t base = (size_t)chunk * 128 * 1024 + d;
for (int r0 = 0; r0 < 128; r0 += 32) {
                float av[32];
                bf16_t bv[32], sv[32];
#pragma unroll
                for (int q = 0; q < 32; ++q) {
                    const size_t o = base + (size_t)(r0 + q) * 1024;
                    av[q] = Aa[o]; bv[q] = Bb[o]; sv[q] = SG[o];
                }
#pragma unroll
                for (int q = 0; q < 32; ++q) {
                    h = av[q] * h + bf2f(bv[q]);
                    Z[base + (size_t)(r0 + q) * 1024] = (bf16_t)(cvt_pk(h * bf2f(sv[q]), 0.f) & 0xffff);
                }
            }
            if (ci == 63) p.out[O_CHP + (size_t)b * 1024 + d] = h;
        } else {
            const int s = it - 512, d = (s & 3) * 256 + threadIdx.x, b = s >> 2;
            const size_t o = (size_t)(M_P + b) * 1024 + d;
            const float h = Aa[o] * p.in[5][(size_t)b * 1024 + d] + bf2f(Bb[o]);
            Z[o] = (bf16_t)(cvt_pk(h * bf2f(SG[o]), 0.f) & 0xffff);
            p.out[O_CHS + (size_t)b * 1024 + d] = h;
        }
    }
}

constexpr int N_PHASES = 20;

__device__ __forceinline__ void run_phase(const Params& p, int ph, unsigned char* smem_raw) {
    bf16_t* smem = (bf16_t*)smem_raw;
    float* Y = (float*)(p.ws + W_BUF2);
    float* YP = (float*)(p.ws + W_YPART);
    float* X = p.out + O_X;
    bf16_t* XB = (bf16_t*)(p.ws + W_XB);
    bf16_t* H = (bf16_t*)(p.ws + W_H);
    switch (ph) {
        case 0: prep_phase(p, smem_raw); break;
        case 1: a_in_phase(p, 0, smem); break;
        case 2: a_mix_phase(p, 0, smem); break;
        case 3: out_gemm_phase((const bf16_t*)(p.ws + W_BUF1), 2048, (const bf16_t*)(p.ws + W_A_OUT), Y, YP, smem); break;
        case 4: norm_phase(Y, YP, 8, p.in[0], p.in[1], XB, true, nullptr, p.in[7] + 0 * 1024, p.in[6] + 1 * 1024, H); break;
        case 5: b_in_phase(p, smem); break;
        case 6: b_attn_phase(p, smem_raw); break;
        case 7: out_gemm_phase(H, 1024, (const bf16_t*)(p.ws + W_B_OUT), Y, YP, smem); break;
        case 8: norm_phase(Y, YP, 4, nullptr, nullptr, XB, true, nullptr, p.in[7] + 1 * 1024, p.in[6] + 2 * 1024, H); break;
        case 9: c_in_phase(p, smem); break;
        case 10: c_conv_phase(p); break;
        case 11: c_gate_phase(p, smem); break;
        case 12: c_scan1_phase(p); break;
        case 13: c_scan2_phase(p); break;
        case 14: out_gemm_phase(H, 1024, (const bf16_t*)(p.ws + W_C_OUT), Y, YP, smem); break;
        case 15: norm_phase(Y, YP, 4, nullptr, nullptr, XB, true, nullptr, p.in[7] + 2 * 1024, p.in[6] + 3 * 1024, H); break;
        case 16: a_in_phase(p, 1, smem); break;
        case 17: a_mix_phase(p, 1, smem); break;
        case 18: out_gemm_phase((const bf16_t*)(p.ws + W_BUF1), 2048, (const bf16_t*)(p.ws + W_A_OUT) + (size_t)1024 * 2048, Y, YP, smem); break;
        case 19: norm_phase(Y, YP, 8, nullptr, nullptr, XB, false, X, p.in[7] + 3 * 1024, nullptr, H); break;
        default: break;
    }
}


#define XB_TMO      128
#define XB_XCNT(j)  (256  + 64 * (j))
#define XB_XSUB(j)  (1280 + 64 * (j))
#define XB_XGEN(j)  (2304 + 64 * (j))
#define XB_TOP      3328
#define XB_TOPGEN   3392
#define XCD_BAR_WORDS 3456
#define XB_SPIN_CAP (1u << 20)
__device__ __forceinline__ unsigned xb_ld(unsigned* p) { return __hip_atomic_load(p, __ATOMIC_RELAXED, __HIP_MEMORY_SCOPE_AGENT); }
__device__ __forceinline__ unsigned xb_add(unsigned* p, unsigned v) { return __hip_atomic_fetch_add(p, v, __ATOMIC_RELAXED, __HIP_MEMORY_SCOPE_AGENT); }
__device__ __forceinline__ unsigned xb_xcc_id() { return (unsigned)__builtin_amdgcn_s_getreg((3 << 11) | 20) & 0xFu; }
#define XB_SPIN(cond, bar) do { unsigned _sp = 0; while (cond) { __builtin_amdgcn_s_sleep(1); \
    if ((++_sp & 255u) == 0u) { if (xb_ld(&(bar)[XB_TMO])) break; if (_sp > XB_SPIN_CAP) { atomicAdd(&(bar)[XB_TMO], 1u); break; } } } } while (0)
struct XcdBarrier { unsigned* bar; unsigned x, nloc, nx; };
__device__ __forceinline__ void xcd_barrier_complete(unsigned* bar, unsigned x, unsigned& nloc, unsigned& nx) {
    const unsigned G = gridDim.x;
    unsigned sum, cnt, mine, sp = 0u;
    for (;;) {
        sum = 0u; cnt = 0u; mine = 0u;
#pragma unroll
        for (unsigned j = 0; j < 16; ++j) { const unsigned c = xb_ld(&bar[XB_XCNT(j)]); sum += c; cnt += (c > 0u) ? 1u : 0u; mine = (j == x) ? c : mine; }
        if (sum == G) break;
        __builtin_amdgcn_s_sleep(1);
        if ((++sp & 255u) == 0u) { if (xb_ld(&bar[XB_TMO])) break; if (sp > XB_SPIN_CAP) { atomicAdd(&bar[XB_TMO], 1u); break; } }
    }
    nloc = mine > 0u ? mine : 1u; nx = cnt > 0u ? cnt : 1u;
}
__device__ __forceinline__ void xcd_barrier(XcdBarrier& b) {
    asm volatile("s_waitcnt vmcnt(0)" ::: "memory");
    __syncthreads();
    if (threadIdx.x == 0) {
        unsigned* bar = b.bar;
        __builtin_amdgcn_s_waitcnt(0);
        if (b.nloc == 0u) xcd_barrier_complete(bar, b.x, b.nloc, b.nx);
        const unsigned nloc = b.nloc, nx = b.nx;
        const unsigned old = xb_add(&bar[XB_XSUB(b.x)], 1u);
        const unsigned gen = old / nloc;
        if (old + 1u == (gen + 1u) * nloc) {
            __builtin_amdgcn_fence(__ATOMIC_RELEASE, "agent");
            asm volatile("s_waitcnt vmcnt(0)" ::: "memory");
            const unsigned og = xb_add(&bar[XB_TOP], 1u);
            const unsigned tg = og / nx;
            if (og + 1u == (tg + 1u) * nx) xb_add(&bar[XB_TOPGEN], 1u);
            else XB_SPIN(xb_ld(&bar[XB_TOPGEN]) == tg, bar);
            __builtin_amdgcn_fence(__ATOMIC_ACQUIRE, "agent");
            xb_add(&bar[XB_XGEN(b.x)], 1u);
            asm volatile("s_waitcnt vmcnt(0)" ::: "memory");
        } else {
            XB_SPIN(xb_ld(&bar[XB_XGEN(b.x)]) == gen, bar);
            __builtin_amdgcn_fence(__ATOMIC_ACQUIRE, "agent");
            asm volatile("s_waitcnt vmcnt(0)" ::: "memory");
        }
    }
    __syncthreads();
}

#ifndef PROBE_K
#define PROBE_K 20
#endif
__device__ __forceinline__ void dump_phase(const Params& p) {
    const unsigned* base = (const unsigned*)(p.ws);
    const size_t nwords = W_END / 4, n = (size_t)MT * D;
    const size_t gt = (size_t)blockIdx.x * NTHREADS + threadIdx.x, gn = (size_t)gridDim.x * NTHREADS;
    for (size_t i = gt; i < n; i += gn) {
        float a = 0.f;
        for (int k = 0; k < 4; ++k) {
            const size_t w = i + (size_t)k * n;
            if (w < nwords) { const unsigned u = base[w]; a += (float)((u * 2654435761u) >> 29); }
        }
        p.out[i] = a;
    }
}
constexpr size_t W_BAR = W_END;
#define PHASE(i) if (p.ph_lo <= (i) && (i) < p.ph_hi) { if ((i) > p.ph_lo) xcd_barrier(xb); run_phase(p, (i), smem_raw); }
__global__ void __launch_bounds__(NTHREADS, 2) mega_kernel(Params p) {
    __shared__ __attribute__((aligned(16))) unsigned char smem_raw[SMEM_BYTES];
    XcdBarrier xb;
    xb.bar = (unsigned*)(p.ws + W_BAR); xb.x = xb_xcc_id(); xb.nloc = 0u; xb.nx = 0u;
    if (threadIdx.x == 0) (void)xb_add(&xb.bar[XB_XCNT(xb.x)], 1u);
    if (p.ph_lo < 0) cg::this_grid().sync();
    PHASE(0) PHASE(1) PHASE(2) PHASE(3) PHASE(4) PHASE(5) PHASE(6) PHASE(7) PHASE(8) PHASE(9)
    PHASE(10) PHASE(11) PHASE(13) PHASE(14) PHASE(15) PHASE(16) PHASE(17) PHASE(18) PHASE(19)
    if (ONE_LAUNCH && p.ph_hi < N_PHASES && p.ph_lo == 0) { xcd_barrier(xb); dump_phase(p); }
    if (!ONE_LAUNCH && p.ph_lo == N_PHASES) dump_phase(p);
}

extern "C" void kernel_launch(void* const* d_in, const int* in_sizes, int n_in, void* d_out, int out_size, void* d_ws, size_t ws_size,
                              hipStream_t stream) {
    static int grid = 0;
    if (grid == 0) {
        if (n_in != 26 || (size_t)out_size != O_END || ws_size < W_END + XCD_BAR_WORDS * 4) {
            fprintf(stderr, "kernel_launch: unexpected shapes n_in=%d out=%d ws=%zu (need %zu)\n", n_in, out_size, ws_size, (size_t)W_END);
            grid = -1;
            return;
        }
        int dev = 0, cus = 0, per_cu = 0;
        (void)hipGetDevice(&dev);
        (void)hipDeviceGetAttribute(&cus, hipDeviceAttributeMultiprocessorCount, dev);
        (void)hipOccupancyMaxActiveBlocksPerMultiprocessor(&per_cu, (const void*)mega_kernel, NTHREADS, 0);
        if (per_cu < 1) per_cu = 1;
        if (per_cu > 2) per_cu = 2;
        grid = cus * per_cu;
    }
    if (grid < 0) return;
    Params p{};
    for (int i = 0; i < 26; ++i) p.in[i] = (const float*)d_in[i];
    p.out = (float*)d_out;
    p.ws = (unsigned char*)d_ws;
#if ONE_LAUNCH
    (void)hipMemsetAsync((unsigned char*)d_ws + W_BAR, 0, XCD_BAR_WORDS * 4, stream);
    p.ph_lo = 0;
    p.ph_hi = PROBE_K;
    void* args[] = {&p};
    hipError_t e = hipLaunchCooperativeKernel((const void*)mega_kernel, dim3(grid), dim3(NTHREADS), args, 0, stream);
    if (e != hipSuccess) fprintf(stderr, "cooperative launch failed: %s (grid %d)\n", hipGetErrorString(e), grid);
#else
    for (int ph = 0; ph < N_PHASES; ++ph) {
        p.ph_lo = ph;
        p.ph_hi = ph + 1;
        hipLaunchKernelGGL(mega_kernel, dim3(grid), dim3(NTHREADS), 0, stream, p);
    }
#endif
}
```

```cpp
#include <hip/hip_runtime.h>
#include <hip/hip_cooperative_groups.h>
#include <stdint.h>
#include <stdio.h>
#include <math.h>
namespace cg = cooperative_groups;

#ifndef ONE_LAUNCH
#define ONE_LAUNCH 1
#endif

typedef unsigned short bf16_t;
typedef short bf16x8 __attribute__((ext_vector_type(8)));
typedef float f32x4 __attribute__((ext_vector_type(4)));
typedef unsigned u32x4 __attribute__((ext_vector_type(4)));
typedef unsigned u32x2 __attribute__((ext_vector_type(2)));

constexpr int M_P = 16384, M_S = 128, MT = 16512, D = 1024, SEQ = 8192;
constexpr int NTHREADS = 256;
constexpr int SMEM_BYTES = 65536;

constexpr size_t O_X = 0;
constexpr size_t O_AV = (size_t)MT * D;
constexpr size_t O_BKP = O_AV + 2 * 128 * 2048;
constexpr size_t O_BVP = O_BKP + 2 * 128 * 128;
constexpr size_t O_BKS = O_BVP + 2 * 128 * 128;
constexpr size_t O_BVS = O_BKS + 128 * 128 * 128;
constexpr size_t O_CCP = O_BVS + 128 * 128 * 128;
constexpr size_t O_CHP = O_CCP + 2 * 3 * 1024;
constexpr size_t O_CCS = O_CHP + 2 * 1024;
constexpr size_t O_CHS = O_CCS + 128 * 3 * 1024;
constexpr size_t O_END = O_CHS + 128 * 1024;

constexpr size_t W_A_IN = 0;
constexpr size_t W_A_OUT = W_A_IN + (size_t)2 * 6144 * 1024 * 2;
constexpr size_t W_B_IN = W_A_OUT + (size_t)2 * 1024 * 2048 * 2;
constexpr size_t W_B_OUT = W_B_IN + (size_t)2304 * 1024 * 2;
constexpr size_t W_C_IN = W_B_OUT + (size_t)1024 * 1024 * 2;
constexpr size_t W_C_G = W_C_IN + (size_t)2048 * 1024 * 2;
constexpr size_t W_C_OUT = W_C_G + (size_t)4 * 512 * 256 * 2;
constexpr size_t W_WS_A = W_C_OUT + (size_t)1024 * 1024 * 2;
constexpr size_t W_ROPE = W_WS_A + (size_t)2 * 4 * 128 * 128 * 2;
constexpr size_t W_H = W_ROPE + (size_t)8193 * 64 * 4;
constexpr size_t W_BUF1 = W_H + (size_t)MT * 1024 * 2;
constexpr size_t W_BUF2 = W_BUF1 + (size_t)MT * 2048 * 2;
constexpr size_t W_KB = W_BUF2 + (size_t)MT * 2048 * 2;
constexpr size_t W_STATS = W_KB;
constexpr size_t W_CARRY = W_KB + (size_t)MT * 256 * 2;
constexpr size_t W_YPART = W_CARRY + (size_t)128 * 1024 * 2 * 4;
constexpr size_t W_XB = W_YPART + (size_t)8 * 128 * 1024 * 4;
constexpr size_t W_END = W_XB + (size_t)MT * 1024 * 2;

struct Params {
    const float* in[26];
    float* out;
    unsigned char* ws;
    int ph_lo, ph_hi;
};

__device__ __forceinline__ unsigned cvt_pk(float lo, float hi) {
    unsigned r;
    asm("v_cvt_pk_bf16_f32 %0, %1, %2" : "=v"(r) : "v"(lo), "v"(hi));
    return r;
}
__device__ __forceinline__ float bf_lo(unsigned u) { return __uint_as_float(u << 16); }
__device__ __forceinline__ float bf_hi(unsigned u) { return __uint_as_float(u & 0xffff0000u); }
__device__ __forceinline__ float bf2f(bf16_t h) { return __uint_as_float(((unsigned)h) << 16); }
__device__ __forceinline__ float sigmoid_f(float x) { return __builtin_amdgcn_rcpf(1.f + __expf(-x)); }
__device__ __forceinline__ float silu_f(float x) { return x * sigmoid_f(x); }
__device__ __forceinline__ float gelu_f(float x) { return x * sigmoid_f(1.5957691216057308f * (x + 0.044715f * x * x * x)); }
__device__ __forceinline__ float gelu_silu(float u, float g) {
    const float eu = __expf(-1.5957691216057308f * (u + 0.044715f * u * u * u)), eg = __expf(-g);
    const float den = (1.f + eu) * (1.f + eg);
    return (u * g) * __builtin_amdgcn_rcpf(den);
}
template <int CTRL> __device__ __forceinline__ float dpp_add(float x) {
    return x + __builtin_bit_cast(float, __builtin_amdgcn_update_dpp(0, __builtin_bit_cast(int, x), CTRL, 0xF, 0xF, true));
}
__device__ __forceinline__ float row16_sum(float x) {
    x = dpp_add<0xB1>(x);
    x = dpp_add<0x4E>(x);
    x = dpp_add<0x141>(x);
    x = dpp_add<0x140>(x);
    return x;
}
__device__ __forceinline__ float wave_sum(float v) {
#pragma unroll
    for (int o = 1; o < 64; o <<= 1) v += __shfl_xor(v, o);
    return v;
}

__device__ __forceinline__ int perm32(int rho) { return 8 * ((rho & 15) >> 2) + 4 * (rho >> 4) + (rho & 3); }
__device__ __forceinline__ int permcol(int c) { return (c & ~31) + perm32(c & 31); }
__device__ __forceinline__ int swz(int row, int chunk) { return (chunk ^ (((row >> 3) & 1) << 1)) * 8; }

template <bool TRANS>
__device__ __forceinline__ void mma_stage(const bf16_t* As, const bf16_t* Bs, int apanel, int bpanel, f32x4 (&acc)[4][4], int wr, int wc, int lane) {
    const int fr = lane & 15, fq = lane >> 4;
    const int co = swz(fr, fq);
#pragma unroll
    for (int kk = 0; kk < 2; ++kk) {
        bf16x8 a[4], b[4];
#pragma unroll
        for (int i = 0; i < 4; ++i) {
            a[i] = *(const bf16x8*)(As + kk * apanel + (wr * 64 + i * 16 + fr) * 32 + co);
            b[i] = *(const bf16x8*)(Bs + kk * bpanel + (wc * 64 + i * 16 + fr) * 32 + co);
        }
#pragma unroll
        for (int i = 0; i < 4; ++i)
#pragma unroll
            for (int j = 0; j < 4; ++j)
                acc[i][j] = TRANS ? __builtin_amdgcn_mfma_f32_16x16x32_bf16(b[j], a[i], acc[i][j], 0, 0, 0)
                                  : __builtin_amdgcn_mfma_f32_16x16x32_bf16(a[i], b[j], acc[i][j], 0, 0, 0);
    }
}

__device__ __forceinline__ void g2r(const bf16_t* __restrict__ g, int ld, int row0, int k0, int tid, u32x4 (&r)[4]) {
    const int rl = 2 * (tid >> 4) + ((tid >> 2) & 1), kc = ((tid >> 3) & 1) * 4 + (tid & 3);
    const unsigned voff = (unsigned)(rl * ld + kc * 8) * 2u;
#pragma unroll
    for (int i = 0; i < 4; ++i) {
        const char* b = (const char*)(g + (size_t)(row0 + 32 * i) * ld + k0);
        r[i] = *(const u32x4*)(b + voff);
    }
}
__device__ __forceinline__ void r2s(bf16_t* s, int tid, const u32x4 (&r)[4]) {
    const int rl = 2 * (tid >> 4) + ((tid >> 2) & 1), kc = ((tid >> 3) & 1) * 4 + (tid & 3);
#pragma unroll
    for (int i = 0; i < 4; ++i) {
        const int row = rl + 32 * i;
        *(u32x4*)(s + (kc >> 2) * 4096 + row * 32 + swz(row, kc & 3)) = r[i];
    }
}

__device__ __forceinline__ void g2r32(const bf16_t* __restrict__ g, int ld, int row0, int k0, int tid, u32x4 (&r)[2]) {
    const unsigned voff = (unsigned)((tid >> 2) * ld + (tid & 3) * 8) * 2u;
#pragma unroll
    for (int i = 0; i < 2; ++i) {
        const char* b = (const char*)(g + (size_t)(row0 + 64 * i) * ld + k0);
        r[i] = *(const u32x4*)(b + voff);
    }
}
__device__ __forceinline__ void r2s32(bf16_t* s, int tid, const u32x4 (&r)[2]) {
#pragma unroll
    for (int i = 0; i < 2; ++i) {
        const int row = (tid >> 2) + 64 * i;
        *(u32x4*)(s + row * 32 + swz(row, tid & 3)) = r[i];
    }
}
__device__ __forceinline__ void ldfrag(const bf16_t* st, bf16x8 (&a)[4], bf16x8 (&b)[4], int wr, int wc, int fr, int co) {
#pragma unroll
    for (int i = 0; i < 4; ++i) {
        a[i] = *(const bf16x8*)(st + (wr * 64 + i * 16 + fr) * 32 + co);
        b[i] = *(const bf16x8*)(st + 4096 + (wc * 64 + i * 16 + fr) * 32 + co);
    }
}
template <bool TRANS>
__device__ __forceinline__ void mma16(const bf16x8 (&a)[4], const bf16x8 (&b)[4], f32x4 (&acc)[4][4]) {
    __builtin_amdgcn_s_setprio(1);
#pragma unroll
    for (int i = 0; i < 4; ++i)
#pragma unroll
        for (int j = 0; j < 4; ++j)
            acc[i][j] = TRANS ? __builtin_amdgcn_mfma_f32_16x16x32_bf16(b[j], a[i], acc[i][j], 0, 0, 0)
                              : __builtin_amdgcn_mfma_f32_16x16x32_bf16(a[i], b[j], acc[i][j], 0, 0, 0);
    __builtin_amdgcn_s_setprio(0);
}

struct Stage { u32x4 ra0[2], rb0[2], ra1[2], rb1[2]; };

template <bool TRANS, class Epi>
__device__ __forceinline__ void gemm_tile(const bf16_t* __restrict__ A, int lda, const bf16_t* __restrict__ Bt, int ldb, int K, int m0, int n0,
                                          bf16_t* smem, const Epi epi, Stage& st, bool pre, bool has_next, const bf16_t* __restrict__ An,
                                          const bf16_t* __restrict__ Bn, int m0n, int n0n) {
    const int tid = threadIdx.x, wid = tid >> 6, lane = tid & 63, wr = wid >> 1, wc = wid & 1, fr = lane & 15, fq = lane >> 4;
    const int co = swz(fr, fq);
    f32x4 acc[4][4];
#pragma unroll
    for (int i = 0; i < 4; ++i)
#pragma unroll
        for (int j = 0; j < 4; ++j) acc[i][j] = (f32x4){0.f, 0.f, 0.f, 0.f};
    const int nk = K >> 5;
    bf16x8 a0[4], b0[4], a1[4], b1[4];
    if (!pre) {
        g2r32(A, lda, m0, 0, tid, st.ra0);
        g2r32(Bt, ldb, n0, 0, tid, st.rb0);
        g2r32(A, lda, m0, 32, tid, st.ra1);
        g2r32(Bt, ldb, n0, 32, tid, st.rb1);
    }
    __syncthreads();
    r2s32(smem, tid, st.ra0);
    r2s32(smem + 4096, tid, st.rb0);
    r2s32(smem + 8192, tid, st.ra1);
    r2s32(smem + 8192 + 4096, tid, st.rb1);
    g2r32(A, lda, m0, 64, tid, st.ra0);
    g2r32(Bt, ldb, n0, 64, tid, st.rb0);
    g2r32(A, lda, m0, 96, tid, st.ra1);
    g2r32(Bt, ldb, n0, 96, tid, st.rb1);
    __syncthreads();
    ldfrag(smem, a0, b0, wr, wc, fr, co);
    for (int kt = 0; kt < nk; kt += 2) {
        {
            bf16_t* w = smem + ((kt + 2) & 3) * 8192;
            r2s32(w, tid, st.ra0);
            r2s32(w + 4096, tid, st.rb0);
            const int kn = (kt + 4 < nk ? kt + 4 : nk - 1) * 32;
            g2r32(A, lda, m0, kn, tid, st.ra0);
            g2r32(Bt, ldb, n0, kn, tid, st.rb0);
            ldfrag(smem + ((kt + 1) & 3) * 8192, a1, b1, wr, wc, fr, co);
            mma16<TRANS>(a0, b0, acc);
            __syncthreads();
        }
        {
            bf16_t* w = smem + ((kt + 3) & 3) * 8192;
            r2s32(w, tid, st.ra1);
            r2s32(w + 4096, tid, st.rb1);
            const int kn = (kt + 5 < nk ? kt + 5 : nk - 1) * 32;
            g2r32(A, lda, m0, kn, tid, st.ra1);
            g2r32(Bt, ldb, n0, kn, tid, st.rb1);
            ldfrag(smem + ((kt + 2) & 3) * 8192, a0, b0, wr, wc, fr, co);
            mma16<TRANS>(a1, b1, acc);
            __syncthreads();
        }
    }
    if (has_next) {
        g2r32(An, lda, m0n, 0, tid, st.ra0);
        g2r32(Bn, ldb, n0n, 0, tid, st.rb0);
        g2r32(An, lda, m0n, 32, tid, st.ra1);
        g2r32(Bn, ldb, n0n, 32, tid, st.rb1);
    }
    epi(acc, m0, n0, wr, wc, lane);
}

__device__ __forceinline__ void wt_tile(const float* colptr, int ldsrc, bf16_t* dst, int ldd, float* tile, int tid) {
    const int tx = tid & 63, ty = tid >> 6;
    float v[16];
#pragma unroll
    for (int q = 0; q < 16; ++q) v[q] = colptr[(size_t)(ty + 4 * q) * ldsrc];
#pragma unroll
    for (int q = 0; q < 16; ++q) tile[(ty + 4 * q) * 65 + tx] = v[q];
    __syncthreads();
    const int c2 = tid & 31, r0 = tid >> 5;
#pragma unroll
    for (int rr = r0; rr < 64; rr += 8)
        *(unsigned*)(dst + (size_t)rr * ldd + 2 * c2) = cvt_pk(tile[(2 * c2) * 65 + rr], tile[(2 * c2 + 1) * 65 + rr]);
    __syncthreads();
}

__device__ __forceinline__ void sincos_d(double x, double& s, double& c) {
    const double k = rint(x * 0.63661977236758134308);
    double r = fma(-k, 1.57079632673412561417e+00, x);
    r = fma(-k, 6.07710050650619224932e-11, r);
    const double z = r * r;
    const double sp = r + r * z * (-1.66666666666666324348e-01 + z * (8.33333333332248946124e-03 + z * (-1.98412698298579493134e-04 + z * (2.75573137070700676789e-06 + z * (-2.50507602534068634195e-08 + z * 1.58969099521155010221e-10)))));
    const double cp = 1.0 - 0.5 * z + z * z * (4.16666666666666019037e-02 + z * (-1.38888888888741095749e-03 + z * (2.48015872894767294178e-05 + z * (-2.75573143513906633035e-07 + z * (2.08757232129817482790e-09 + z * -1.13596475577881948265e-11)))));
    const int q = ((int)k) & 3;
    s = (q == 0) ? sp : (q == 1) ? cp : (q == 2) ? -sp : -cp;
    c = (q == 0) ? cp : (q == 1) ? -sp : (q == 2) ? -cp : sp;
}

__device__ __forceinline__ void norm_phase(const float* __restrict__ Y, const float* __restrict__ Ypart, int nsplit, const float* xin_p, const float* xin_s,
                                           bf16_t* Xb, bool storeXb, float* Xf, const float* gpost, const float* gpre, bf16_t* H) {
    const int lane = threadIdx.x & 63;
    const int gw = blockIdx.x * 4 + (threadIdx.x >> 6), nw = gridDim.x * 4;
    for (int ri = gw; ri < MT; ri += nw) {
        const int row = ri < M_S ? M_P + ri : ri - M_S;
        f32x4 x[4];
        if (xin_p) {
            const float* xr = row < M_P ? xin_p + (size_t)row * D : xin_s + (size_t)(row - M_P) * D;
#pragma unroll
            for (int j = 0; j < 4; ++j) x[j] = *(const f32x4*)(xr + j * 256 + lane * 4);
        } else {
#pragma unroll
            for (int j = 0; j < 4; ++j) {
                const u32x2 w = *(const u32x2*)(Xb + (size_t)row * D + j * 256 + lane * 4);
                x[j] = (f32x4){bf_lo(w.x), bf_hi(w.x), bf_lo(w.y), bf_hi(w.y)};
            }
        }
        if (Y) {
            f32x4 y[4];
            float ss = 0.f;
            if (row < M_P) {
#pragma unroll
                for (int j = 0; j < 4; ++j) {
                    const u32x2 w = *(const u32x2*)((const bf16_t*)Y + (size_t)row * D + j * 256 + lane * 4);
                    y[j] = (f32x4){bf_lo(w.x), bf_hi(w.x), bf_lo(w.y), bf_hi(w.y)};
                }
            } else {
#pragma unroll
                for (int j = 0; j < 4; ++j) y[j] = (f32x4){0.f, 0.f, 0.f, 0.f};
                for (int s = 0; s < nsplit; s += 4) {
                    f32x4 t[4][4];
#pragma unroll
                    for (int u = 0; u < 4; ++u)
#pragma unroll
                        for (int j = 0; j < 4; ++j) t[u][j] = *(const f32x4*)(Ypart + ((size_t)(s + u) * 128 + (row - M_P)) * D + j * 256 + lane * 4);
#pragma unroll
                    for (int u = 0; u < 4; ++u)
#pragma unroll
                        for (int j = 0; j < 4; ++j) y[j] += t[u][j];
                }
            }
#pragma unroll
            for (int j = 0; j < 4; ++j) ss += y[j].x * y[j].x + y[j].y * y[j].y + y[j].z * y[j].z + y[j].w * y[j].w;
            ss = wave_sum(ss);
            const float rstd = rsqrtf(ss * (1.f / 1024.f) + 1e-6f);
#pragma unroll
            for (int j = 0; j < 4; ++j) {
                const f32x4 g = *(const f32x4*)(gpost + j * 256 + lane * 4);
                x[j] = x[j] + y[j] * rstd * g;
            }
        }
        if (storeXb) {
#pragma unroll
            for (int j = 0; j < 4; ++j) {
                u32x2 w;
                w.x = cvt_pk(x[j].x, x[j].y);
                w.y = cvt_pk(x[j].z, x[j].w);
                *(u32x2*)(Xb + (size_t)row * D + j * 256 + lane * 4) = w;
            }
        }
        if (Xf) {
#pragma unroll
            for (int j = 0; j < 4; ++j) *(f32x4*)(Xf + (size_t)row * D + j * 256 + lane * 4) = x[j];
        }
        if (gpre) {
            float ss = 0.f;
#pragma unroll
            for (int j = 0; j < 4; ++j) ss += x[j].x * x[j].x + x[j].y * x[j].y + x[j].z * x[j].z + x[j].w * x[j].w;
            ss = wave_sum(ss);
            const float rstd = rsqrtf(ss * (1.f / 1024.f) + 1e-6f);
#pragma unroll
            for (int j = 0; j < 4; ++j) {
                const f32x4 g = *(const f32x4*)(gpre + j * 256 + lane * 4);
                const f32x4 h = x[j] * rstd * g;
                u32x2 w;
                w.x = cvt_pk(h.x, h.y);
                w.y = cvt_pk(h.z, h.w);
                *(u32x2*)(H + (size_t)row * D + j * 256 + lane * 4) = w;
            }
        }
    }
}

constexpr int WT_FIRST = 96 * 16;
constexpr int WT_TOTAL = 2 * 96 * 16 + 2 * 16 * 32 + 36 * 16 + 256 + 32 * 16 + 128 + 256;
__device__ __forceinline__ void wt_jobs(const Params& p, unsigned char* smem, int lo, int hi, int w, int nw) {
    float* tile = (float*)smem;
    const int tid = threadIdx.x, tx = tid & 63;
    constexpr int T_AIN = 96 * 16, T_AOUT = 16 * 32, T_BIN = 36 * 16, T_BOUT = 256, T_CIN = 32 * 16, T_CG = 128, T_COUT = 256;
    for (int it = lo + w; it < hi; it += nw) {
        int r = it;
        if (r < 2 * T_AIN) {
            const int j = r / T_AIN; r -= j * T_AIN;
            const int nt = r >> 4, kt = r & 15, np = permcol(nt * 64 + tx);
            int col;
            const int T = np >> 7, w = np & 127;
            if (T < 32) {
                const int wc = w >> 6, jn = (w >> 4) & 3, i = w & 15;
                col = ((jn < 2) ? 0 : 4096) + 64 * T + 32 * wc + 16 * (jn & 1) + i;
            } else col = 2048 + (np - 4096);
            wt_tile(p.in[8] + (size_t)j * 1024 * 6144 + (size_t)(kt * 64) * 6144 + col, 6144,
                    (bf16_t*)(p.ws + W_A_IN) + (size_t)j * 6144 * 1024 + (size_t)(nt * 64) * 1024 + kt * 64, 1024, tile, tid);
            continue;
        }
        r -= 2 * T_AIN;
        if (r < 2 * T_AOUT) {
            const int j = r / T_AOUT; r -= j * T_AOUT;
            const int nt = r >> 5, kt = r & 31;
            wt_tile(p.in[13] + (size_t)j * 2048 * 1024 + (size_t)(kt * 64) * 1024 + permcol(nt * 64 + tx), 1024,
                    (bf16_t*)(p.ws + W_A_OUT) + (size_t)j * 1024 * 2048 + (size_t)(nt * 64) * 2048 + kt * 64, 2048, tile, tid);
            continue;
        }
        r -= 2 * T_AOUT;
        if (r < T_BIN) {
            const int nt = r >> 4, kt = r & 15;
            wt_tile(p.in[14] + (size_t)(kt * 64) * 2304 + permcol(nt * 64 + tx), 2304, (bf16_t*)(p.ws + W_B_IN) + (size_t)(nt * 64) * 1024 + kt * 64, 1024, tile, tid);
            continue;
        }
        r -= T_BIN;
        if (r < T_BOUT) {
            const int nt = r >> 4, kt = r & 15;
            wt_tile(p.in[16] + (size_t)(kt * 64) * 1024 + permcol(nt * 64 + tx), 1024, (bf16_t*)(p.ws + W_B_OUT) + (size_t)(nt * 64) * 1024 + kt * 64, 1024, tile, tid);
            continue;
        }
        r -= T_BOUT;
        if (r < T_CIN) {
            const int nt = r >> 4, kt = r & 15;
            wt_tile(p.in[17] + (size_t)(kt * 64) * 2048 + permcol(nt * 64 + tx), 2048, (bf16_t*)(p.ws + W_C_IN) + (size_t)(nt * 64) * 1024 + kt * 64, 1024, tile, tid);
            continue;
        }
        r -= T_CIN;
        if (r < T_CG) {
            const int blk = r >> 5, rr = r & 31, nt = rr >> 2, kt = rr & 3;
            const int np = permcol(nt * 64 + tx), j4 = np >> 7, w = np & 127, wc = w >> 6, jn = (w >> 4) & 3, i = w & 15;
            const int dl = 64 * j4 + 32 * wc + 16 * (jn & 1) + i;
            const float* src = ((jn < 2) ? p.in[20] : p.in[22]) + (size_t)blk * 65536;
            wt_tile(src + (size_t)(kt * 64) * 256 + dl, 256, (bf16_t*)(p.ws + W_C_G) + (size_t)blk * 512 * 256 + (size_t)(nt * 64) * 256 + kt * 64, 256, tile, tid);
            continue;
        }
        r -= T_CG;
        {
            const int nt = r >> 4, kt = r & 15;
            wt_tile(p.in[24 + 1] + (size_t)(kt * 64) * 1024 + permcol(nt * 64 + tx), 1024, (bf16_t*)(p.ws + W_C_OUT) + (size_t)(nt * 64) * 1024 + kt * 64, 1024, tile, tid);
        }
    }
}

__device__ __forceinline__ void prep_phase(const Params& p, unsigned char* smem) {
    const int tid = threadIdx.x;
    wt_jobs(p, smem, 0, WT_FIRST, blockIdx.x, gridDim.x);
    const int gt = blockIdx.x * NTHREADS + tid, gn = gridDim.x * NTHREADS;
    {
        bf16_t* wsa = (bf16_t*)(p.ws + W_WS_A);
        const float* src = p.in[11];
        for (int idx = gt; idx < 2 * 4 * 128 * 128 / 2; idx += gn) {
            const int e = idx * 2, t = (e >> 7) & 127, s = e & 127;
            const float a = (s <= t) ? src[e] : 0.f, b = (s + 1 <= t) ? src[e + 1] : 0.f;
            *(unsigned*)(wsa + e) = cvt_pk(a, b);
        }
    }
    {
        float* rt = (float*)(p.ws + W_ROPE);
        for (int idx = gt; idx < 8193 * 32; idx += gn) {
            const int pos = idx >> 5, i = idx & 31;
            const float ang = (float)pos * exp2f(-(float)i * (13.287712379549449f / 32.0f));
            double s, c;
            sincos_d((double)ang, s, c);
            rt[pos * 64 + i] = (float)c;
            rt[pos * 64 + 32 + i] = (float)s;
        }
    }
    norm_phase(nullptr, nullptr, 0, p.in[0], p.in[1], nullptr, false, nullptr, nullptr, p.in[6], (bf16_t*)(p.ws + W_H));
}

struct EpiUG {
    bf16_t* P;
    int T;
    __device__ __forceinline__ void operator()(f32x4 (&acc)[4][4], int m0, int n0, int wr, int wc, int lane) const {
        const int fr = lane & 15, fq = lane >> 4;
#pragma unroll
        for (int i = 0; i < 4; ++i) {
            const int m = m0 + wr * 64 + i * 16 + fr;
            const int ch = 64 * T + 32 * wc + 8 * fq;
            u32x4 w;
            {
                const f32x4 u = acc[i][0], g = acc[i][2];
                w.x = cvt_pk(gelu_silu(u.x, g.x), gelu_silu(u.y, g.y));
                w.y = cvt_pk(gelu_silu(u.z, g.z), gelu_silu(u.w, g.w));
            }
            {
                const f32x4 u = acc[i][1], g = acc[i][3];
                w.z = cvt_pk(gelu_silu(u.x, g.x), gelu_silu(u.y, g.y));
                w.w = cvt_pk(gelu_silu(u.z, g.z), gelu_silu(u.w, g.w));
            }
            *(u32x4*)(P + (size_t)m * 2048 + ch) = w;
        }
    }
};
struct EpiV {
    bf16_t* GVt;
    float* stats;
    int mt, tv;
    __device__ __forceinline__ void operator()(f32x4 (&acc)[4][4], int m0, int n0, int wr, int wc, int lane) const {
        const int fr = lane & 15, fq = lane >> 4;
#pragma unroll
        for (int i = 0; i < 4; ++i) {
            const int sl = wr * 64 + i * 16 + fq * 4;
            f32x4 sum = {0.f, 0.f, 0.f, 0.f}, sq = {0.f, 0.f, 0.f, 0.f};
#pragma unroll
            for (int jn = 0; jn < 4; ++jn) {
                const int ch = 128 * tv + wc * 64 + 32 * (jn >> 1) + perm32(16 * (jn & 1) + fr);
                f32x4 v = acc[i][jn];
                v.x = gelu_f(v.x); v.y = gelu_f(v.y); v.z = gelu_f(v.z); v.w = gelu_f(v.w);
                u32x2 w;
                w.x = cvt_pk(v.x, v.y);
                w.y = cvt_pk(v.z, v.w);
                *(u32x2*)(GVt + ((size_t)mt * 2048 + ch) * 128 + sl) = w;
                sum += v;
                sq += v * v;
            }
            sum.x = row16_sum(sum.x); sum.y = row16_sum(sum.y); sum.z = row16_sum(sum.z); sum.w = row16_sum(sum.w);
            sq.x = row16_sum(sq.x); sq.y = row16_sum(sq.y); sq.z = row16_sum(sq.z); sq.w = row16_sum(sq.w);
            if (fr == 0) {
                float* st = stats + (size_t)(m0 + sl) * 64 + (tv * 2 + wc) * 2;
                st[0] = sum.x; st[1] = sq.x;
                st[64] = sum.y; st[65] = sq.y;
                st[128] = sum.z; st[129] = sq.z;
                st[192] = sum.w; st[193] = sq.w;
            }
        }
    }
};

__device__ __forceinline__ void a_in_phase(const Params& p, int j, bf16_t* smem) {
    const bf16_t* H = (const bf16_t*)(p.ws + W_H);
    const bf16_t* Wt = (const bf16_t*)(p.ws + W_A_IN) + (size_t)j * 6144 * 1024;
    bf16_t* P = (bf16_t*)(p.ws + W_BUF1);
    bf16_t* GVt = (bf16_t*)(p.ws + W_BUF2);
    float* stats = (float*)(p.ws + W_STATS);
    Stage st;
    bool pre = false;
    for (int t = blockIdx.x; t < 129 * 48; t += gridDim.x) {
        const int mt = t / 48, nt = t % 48;
        const int tn = t + gridDim.x;
        const bool hn = tn < 129 * 48;
        const int m0n = (tn / 48) * 128, n0n = (tn % 48) * 128;
        if (nt < 32) {
            EpiUG e{P, nt};
            gemm_tile<true>(H, 1024, Wt, 1024, 1024, mt * 128, nt * 128, smem, e, st, pre, hn, H, Wt, m0n, n0n);
        } else {
            EpiV e{GVt, stats, mt, nt - 32};
            gemm_tile<false>(H, 1024, Wt, 1024, 1024, mt * 128, nt * 128, smem, e, st, pre, hn, H, Wt, m0n, n0n);
        }
        pre = hn;
    }
    if (j == 0) {
        const int busy = (129 * 48) % gridDim.x, idle = gridDim.x - busy;
        if (idle > 0 && (int)blockIdx.x >= busy) wt_jobs(p, (unsigned char*)smem, WT_FIRST, WT_TOTAL, blockIdx.x - busy, idle);
        else if (idle <= 0) wt_jobs(p, (unsigned char*)smem, WT_FIRST, WT_TOTAL, blockIdx.x, gridDim.x);
    }
}

__device__ __forceinline__ void a_mix_phase(const Params& p, int j, bf16_t* smem) {
    const int tid = threadIdx.x, wid = tid >> 6, lane = tid & 63, wr = wid >> 1, wc = wid & 1, fr = lane & 15, fq = lane >> 4;
    bf16_t* P = (bf16_t*)(p.ws + W_BUF1);
    const bf16_t* GVt = (const bf16_t*)(p.ws + W_BUF2);
    const float* stats = (const float*)(p.ws + W_STATS);
    const bf16_t* wsa = (const bf16_t*)(p.ws + W_WS_A) + (size_t)j * 4 * 128 * 128;
    const float* ln_g = p.in[9] + j * 2048;
    const float* ln_b = p.in[10] + j * 2048;
    const float* b_s = p.in[12] + j * 4 * 128;
    const float* w_s = p.in[11] + (size_t)j * 4 * 128 * 128;
    float* av_out = p.out + O_AV + (size_t)j * 128 * 2048;
    bf16_t* As = smem;
    bf16_t* Bs = smem + 16384;
    float* mu = (float*)(smem + 16384);
    float* rs = mu + 128;
    for (int it = blockIdx.x; it < 129 * 16; it += gridDim.x) {
        const int chunk = it >> 4, g = (it >> 2) & 3, slab = it & 3;
        const bool samp = (chunk == 128);
        f32x4 sv[8];
        {
            const float* stp = stats + (size_t)(chunk * 128 + (tid >> 1)) * 64 + (tid & 1) * 32;
#pragma unroll
            for (int k = 0; k < 8; ++k) sv[k] = *(const f32x4*)(stp + k * 4);
        }
        u32x4 araw[8], braw[8];
        float lg[8], lb[8];
        const float w00 = w_s[g * 16384];
        {
            const bf16_t* wg = wsa + g * 16384;
#pragma unroll
            for (int i = 0; i < 8; ++i) {
                const int c = tid + 256 * i, row = c >> 4, sc = c & 15;
                araw[i] = (u32x4){0u, 0u, 0u, 0u};
                if (!samp) araw[i] = *(const u32x4*)(wg + row * 128 + sc * 8);
                const int ch = g * 512 + slab * 128 + permcol(row);
                braw[i] = *(const u32x4*)(GVt + ((size_t)chunk * 2048 + ch) * 128 + sc * 8);
                lg[i] = ln_g[ch];
                lb[i] = ln_b[ch];
            }
        }
        float s = 0.f, q = 0.f;
#pragma unroll
        for (int k = 0; k < 8; ++k) { s += sv[k].x + sv[k].z; q += sv[k].y + sv[k].w; }
        s += __shfl_xor(s, 1);
        q += __shfl_xor(q, 1);
        const float mean = s * (1.f / 2048.f);
        const float var = fmaxf(q * (1.f / 2048.f) - mean * mean, 0.f);
        __syncthreads();
        if ((tid & 1) == 0) { mu[tid >> 1] = mean; rs[tid >> 1] = rsqrtf(var + 1e-5f); }
        if (samp) {
#pragma unroll
            for (int i = 0; i < 8; ++i) {
                const int c = tid + 256 * i, row = c >> 4, sc = c & 15;
                if ((row >> 3) == sc) {
                    const unsigned lo = cvt_pk(w00, 0.f), hi = cvt_pk(0.f, w00);
                    const int e = row & 7;
                    const unsigned val = (e & 1) ? hi : lo;
                    if ((e >> 1) == 0) araw[i].x = val; else if ((e >> 1) == 1) araw[i].y = val; else if ((e >> 1) == 2) araw[i].z = val; else araw[i].w = val;
                }
            }
        }
#pragma unroll
        for (int i = 0; i < 8; ++i) {
            const int c = tid + 256 * i, row = c >> 4, sc = c & 15;
            *(u32x4*)(As + (sc >> 2) * 4096 + row * 32 + swz(row, sc & 3)) = araw[i];
        }
        __syncthreads();
        float mur[8], rsr[8];
#pragma unroll
        for (int e = 0; e < 8; ++e) { mur[e] = mu[(tid & 15) * 8 + e]; rsr[e] = rs[(tid & 15) * 8 + e]; }
        __syncthreads();
#pragma unroll
        for (int i = 0; i < 8; ++i) {
            const int c = tid + 256 * i, n = c >> 4, sc = c & 15;
            const int ch = g * 512 + slab * 128 + permcol(n);
            const u32x4 v = braw[i];
            float x[8];
            x[0] = bf_lo(v.x); x[1] = bf_hi(v.x); x[2] = bf_lo(v.y); x[3] = bf_hi(v.y);
            x[4] = bf_lo(v.z); x[5] = bf_hi(v.z); x[6] = bf_lo(v.w); x[7] = bf_hi(v.w);
#pragma unroll
            for (int e = 0; e < 8; ++e) x[e] = (x[e] - mur[e]) * rsr[e] * lg[i] + lb[i];
            if (samp) {
#pragma unroll
                for (int e = 0; e < 8; ++e) av_out[(size_t)(sc * 8 + e) * 2048 + ch] = x[e];
            }
            u32x4 o;
            o.x = cvt_pk(x[0], x[1]); o.y = cvt_pk(x[2], x[3]); o.z = cvt_pk(x[4], x[5]); o.w = cvt_pk(x[6], x[7]);
            *(u32x4*)(Bs + (sc >> 2) * 4096 + n * 32 + swz(n, sc & 3)) = o;
        }
        __syncthreads();
        f32x4 acc[4][4];
#pragma unroll
        for (int i = 0; i < 4; ++i)
#pragma unroll
            for (int jn = 0; jn < 4; ++jn) acc[i][jn] = (f32x4){0.f, 0.f, 0.f, 0.f};
        u32x4 pvv[4][2];
#pragma unroll
        for (int i = 0; i < 4; ++i)
#pragma unroll
            for (int g2 = 0; g2 < 2; ++g2)
                pvv[i][g2] = *(const u32x4*)(P + (size_t)(chunk * 128 + wr * 64 + i * 16 + fr) * 2048 + g * 512 + slab * 128 + wc * 64 + 32 * g2 + 8 * fq);
        mma_stage<true>(As, Bs, 4096, 4096, acc, wr, wc, lane);
        mma_stage<true>(As + 8192, Bs + 8192, 4096, 4096, acc, wr, wc, lane);
#pragma unroll
        for (int i = 0; i < 4; ++i) {
            const int t = wr * 64 + i * 16 + fr;
            const float bs = b_s[g * 128 + (samp ? 0 : t)];
            const size_t rowoff = (size_t)(chunk * 128 + t) * 2048 + g * 512 + slab * 128;
#pragma unroll
            for (int g2 = 0; g2 < 2; ++g2) {
                bf16_t* pp = P + rowoff + wc * 64 + 32 * g2 + 8 * fq;
                const u32x4 pv = pvv[i][g2];
                const f32x4 a = acc[i][2 * g2], b = acc[i][2 * g2 + 1];
                u32x4 w;
                w.x = cvt_pk(bf_lo(pv.x) * (a.x + bs), bf_hi(pv.x) * (a.y + bs));
                w.y = cvt_pk(bf_lo(pv.y) * (a.z + bs), bf_hi(pv.y) * (a.w + bs));
                w.z = cvt_pk(bf_lo(pv.z) * (b.x + bs), bf_hi(pv.z) * (b.y + bs));
                w.w = cvt_pk(bf_lo(pv.w) * (b.z + bs), bf_hi(pv.w) * (b.w + bs));
                *(u32x4*)pp = w;
            }
        }
    }
}

struct EpiY {
    bf16_t* Yb;
    float* Yp;
    __device__ __forceinline__ void operator()(f32x4 (&acc)[4][4], int m0, int n0, int wr, int wc, int lane) const {
        const int fr = lane & 15, fq = lane >> 4;
        const bool part = (m0 == M_P);
#pragma unroll
        for (int i = 0; i < 4; ++i) {
            const int m = m0 + wr * 64 + i * 16 + fr;
#pragma unroll
            for (int g2 = 0; g2 < 2; ++g2) {
                const int n = n0 + wc * 64 + 32 * g2 + 8 * fq;
                const f32x4 a = acc[i][2 * g2], b = acc[i][2 * g2 + 1];
                if (part) {
                    float* o = Yp + (size_t)(m - M_P) * 1024 + n;
                    *(f32x4*)o = a;
                    *(f32x4*)(o + 4) = b;
                } else {
                    u32x4 w;
                    w.x = cvt_pk(a.x, a.y); w.y = cvt_pk(a.z, a.w); w.z = cvt_pk(b.x, b.y); w.w = cvt_pk(b.z, b.w);
                    *(u32x4*)(Yb + (size_t)m * 1024 + n) = w;
                }
            }
        }
    }
};
__device__ __forceinline__ void out_gemm_phase(const bf16_t* A, int K, const bf16_t* Wt, float* Y, float* Ypart, bf16_t* smem) {
    const int nsplit = K >> 8;
    const int ntile = 1024 + 8 * nsplit;
    Stage st;
    bool pre = false;
    for (int t = blockIdx.x; t < ntile; t += gridDim.x) {
        const bool full = t < 1024;
        const int u = t - 1024, ks = full ? 0 : (u >> 3);
        const int m0 = full ? (t >> 3) * 128 : M_P, n0 = (full ? (t & 7) : (u & 7)) * 128, Kt = full ? K : 256;
        const int tn = t + gridDim.x;
        const bool hn = tn < ntile, fulln = tn < 1024;
        const int un = tn - 1024, ksn = fulln ? 0 : (un >> 3);
        const int m0n = fulln ? (tn >> 3) * 128 : M_P, n0n = (fulln ? (tn & 7) : (un & 7)) * 128;
        EpiY e{(bf16_t*)Y, Ypart + (size_t)ks * 128 * 1024};
        gemm_tile<true>(A + ks * 256, K, Wt + ks * 256, K, Kt, m0, n0, smem, e, st, pre, hn, A + ksn * 256, Wt + ksn * 256, m0n, n0n);
        pre = hn;
    }
}

struct EpiSilu {
    bf16_t* O;
    int ldo, col0;
    __device__ __forceinline__ void operator()(f32x4 (&acc)[4][4], int m0, int n0, int wr, int wc, int lane) const {
        const int fr = lane & 15, fq = lane >> 4;
#pragma unroll
        for (int i = 0; i < 4; ++i) {
            const int m = m0 + wr * 64 + i * 16 + fr;
#pragma unroll
            for (int jn = 0; jn < 4; ++jn) {
                const f32x4 a = acc[i][jn];
                u32x2 w;
                w.x = cvt_pk(silu_f(a.x), silu_f(a.y));
                w.y = cvt_pk(silu_f(a.z), silu_f(a.w));
                *(u32x2*)(O + (size_t)m * ldo + col0 + wc * 64 + jn * 16 + fq * 4) = w;
            }
        }
    }
};
struct EpiCopy {
    bf16_t* O;
    int ldo, col0;
    __device__ __forceinline__ void operator()(f32x4 (&acc)[4][4], int m0, int n0, int wr, int wc, int lane) const {
        const int fr = lane & 15, fq = lane >> 4;
#pragma unroll
        for (int i = 0; i < 4; ++i) {
            const int m = m0 + wr * 64 + i * 16 + fr;
#pragma unroll
            for (int jn = 0; jn < 4; ++jn) {
                const f32x4 a = acc[i][jn];
                u32x2 w;
                w.x = cvt_pk(a.x, a.y);
                w.y = cvt_pk(a.z, a.w);
                *(u32x2*)(O + (size_t)m * ldo + col0 + wc * 64 + jn * 16 + fq * 4) = w;
            }
        }
    }
};
template <int isk> struct EpiRope {
    bf16_t* O;
    int ldo, col0;
    const float* rope;
    float* out;
    __device__ __forceinline__ void operator()(f32x4 (&acc)[4][4], int m0, int n0, int wr, int wc, int lane) const {
        const int fr = lane & 15, fq = lane >> 4;
#pragma unroll
        for (int i = 0; i < 4; ++i) {
            const int m = m0 + wr * 64 + i * 16 + fr;
            const int pos = (m < M_P) ? (m & (SEQ - 1)) : SEQ;
            const float* rt = rope + (size_t)pos * 64;
            const float scale = isk ? 1.0f : 0.125f;
#pragma unroll
            for (int jn = 0; jn < 2; ++jn) {
                const int d = jn * 16 + fq * 4;
                const f32x4 c = *(const f32x4*)(rt + d), s = *(const f32x4*)(rt + 32 + d);
                const f32x4 x1 = acc[i][jn], x2 = acc[i][jn + 2];
                const f32x4 o1 = (x1 * c - x2 * s) * scale, o2 = (x2 * c + x1 * s) * scale;
                u32x2 w1, w2;
                w1.x = cvt_pk(o1.x, o1.y); w1.y = cvt_pk(o1.z, o1.w);
                w2.x = cvt_pk(o2.x, o2.y); w2.y = cvt_pk(o2.z, o2.w);
                bf16_t* dst = O + (size_t)m * ldo + col0 + wc * 64 + d;
                *(u32x2*)dst = w1;
                *(u32x2*)(dst + 32) = w2;
                if (isk) {
                    if (m < M_P) {
                        const int t = m & (SEQ - 1), b = m >> 13;
                        if (t >= SEQ - 128) {
                            float* o = out + O_BKP + ((size_t)(b * 128 + t - (SEQ - 128)) * 2 + wc) * 64 + d;
                            *(f32x4*)o = o1;
                            *(f32x4*)(o + 32) = o2;
                        }
                    } else {
                        float* o = out + O_BKS + ((size_t)((m - M_P) * 128 + 127) * 2 + wc) * 64 + d;
                        *(f32x4*)o = o1;
                        *(f32x4*)(o + 32) = o2;
                    }
                }
            }
        }
    }
};
struct EpiVt {
    bf16_t* Vt;
    float* out;
    __device__ __forceinline__ void operator()(f32x4 (&acc)[4][4], int m0, int n0, int wr, int wc, int lane) const {
        const int fr = lane & 15, fq = lane >> 4;
#pragma unroll
        for (int i = 0; i < 4; ++i) {
            const int m = m0 + wr * 64 + i * 16 + fq * 4;
#pragma unroll
            for (int jn = 0; jn < 4; ++jn) {
                const int d = jn * 16 + fr;
                const f32x4 a = acc[i][jn];
                if (m < M_P) {
                    const int t = m & (SEQ - 1), b = m >> 13;
                    u32x2 w;
                    w.x = cvt_pk(a.x, a.y);
                    w.y = cvt_pk(a.z, a.w);
                    *(u32x2*)(Vt + ((size_t)(b * 2 + wc) * 64 + d) * SEQ + t) = w;
                    if (t >= SEQ - 128) {
                        float* o = out + O_BVP + ((size_t)(b * 128 + t - (SEQ - 128)) * 2 + wc) * 64 + d;
                        o[0] = a.x; o[128] = a.y; o[256] = a.z; o[384] = a.w;
                    }
                } else {
                    float* o = out + O_BVS + ((size_t)((m - M_P) * 128 + 127) * 2 + wc) * 64 + d;
                    o[0] = a.x; o[16384] = a.y; o[32768] = a.z; o[49152] = a.w;
                }
            }
        }
    }
};

struct EpiB {
    bf16_t *Q, *SG, *KV;
    const float* rope;
    float* out;
    int nt;
    __device__ __forceinline__ void operator()(f32x4 (&acc)[4][4], int m0, int n0, int wr, int wc, int lane) const {
        const int fr = lane & 15, fq = lane >> 4;
        if (nt < 9) {
            const bool isk = (nt == 8);
            const float scale = isk ? 1.0f : 0.125f;
#pragma unroll
            for (int i = 0; i < 4; ++i) {
                const int m = m0 + wr * 64 + i * 16 + fr;
                const int pos = (m < M_P) ? (m & (SEQ - 1)) : SEQ;
                const float* rt = rope + (size_t)pos * 64;
                const int d = 8 * fq;
                f32x4 o1[2], o2[2];
#pragma unroll
                for (int jl = 0; jl < 2; ++jl) {
                    const f32x4 c = *(const f32x4*)(rt + d + 4 * jl), s = *(const f32x4*)(rt + 32 + d + 4 * jl);
                    const f32x4 x1 = acc[i][jl], x2 = acc[i][jl + 2];
                    o1[jl] = (x1 * c - x2 * s) * scale;
                    o2[jl] = (x2 * c + x1 * s) * scale;
                }
                u32x4 w1, w2;
                w1.x = cvt_pk(o1[0].x, o1[0].y); w1.y = cvt_pk(o1[0].z, o1[0].w); w1.z = cvt_pk(o1[1].x, o1[1].y); w1.w = cvt_pk(o1[1].z, o1[1].w);
                w2.x = cvt_pk(o2[0].x, o2[0].y); w2.y = cvt_pk(o2[0].z, o2[0].w); w2.z = cvt_pk(o2[1].x, o2[1].y); w2.w = cvt_pk(o2[1].z, o2[1].w);
                bf16_t* dst = isk ? KV + (size_t)m * 256 + wc * 64 + d : Q + (size_t)m * 1024 + nt * 128 + wc * 64 + d;
                *(u32x4*)dst = w1;
                *(u32x4*)(dst + 32) = w2;
                if (isk) {
                    float* o = nullptr;
                    if (m < M_P) {
                        const int t = m & (SEQ - 1), b = m >> 13;
                        if (t >= SEQ - 128) o = out + O_BKP + ((size_t)(b * 128 + t - (SEQ - 128)) * 2 + wc) * 64 + d;
                    } else o = out + O_BKS + ((size_t)((m - M_P) * 128 + 127) * 2 + wc) * 64 + d;
                    if (o) { *(f32x4*)o = o1[0]; *(f32x4*)(o + 4) = o1[1]; *(f32x4*)(o + 32) = o2[0]; *(f32x4*)(o + 36) = o2[1]; }
                }
            }
        } else if (nt == 9) {
#pragma unroll
            for (int i = 0; i < 4; ++i) {
                const int m = m0 + wr * 64 + i * 16 + fr;
                float* o = nullptr;
                if (m < M_P) {
                    const int t = m & (SEQ - 1), b = m >> 13;
                    if (t >= SEQ - 128) o = out + O_BVP + ((size_t)(b * 128 + t - (SEQ - 128)) * 2 + wc) * 64;
                } else o = out + O_BVS + ((size_t)((m - M_P) * 128 + 127) * 2 + wc) * 64;
#pragma unroll
                for (int g2 = 0; g2 < 2; ++g2) {
                    const int d = 32 * g2 + 8 * fq;
                    const f32x4 a = acc[i][2 * g2], b = acc[i][2 * g2 + 1];
                    u32x4 w;
                    w.x = cvt_pk(a.x, a.y); w.y = cvt_pk(a.z, a.w); w.z = cvt_pk(b.x, b.y); w.w = cvt_pk(b.z, b.w);
                    *(u32x4*)(KV + (size_t)m * 256 + 128 + wc * 64 + d) = w;
                    if (o) { *(f32x4*)(o + d) = a; *(f32x4*)(o + d + 4) = b; }
                }
            }
        } else {
#pragma unroll
            for (int i = 0; i < 4; ++i) {
                const int m = m0 + wr * 64 + i * 16 + fr;
#pragma unroll
                for (int g2 = 0; g2 < 2; ++g2) {
                    const f32x4 a = acc[i][2 * g2], b = acc[i][2 * g2 + 1];
                    u32x4 w;
                    w.x = cvt_pk(silu_f(a.x), silu_f(a.y)); w.y = cvt_pk(silu_f(a.z), silu_f(a.w));
                    w.z = cvt_pk(silu_f(b.x), silu_f(b.y)); w.w = cvt_pk(silu_f(b.z), silu_f(b.w));
                    *(u32x4*)(SG + (size_t)m * 1024 + (nt - 10) * 128 + wc * 64 + 32 * g2 + 8 * fq) = w;
                }
            }
        }
    }
};

__device__ __forceinline__ void b_in_phase(const Params& p, bf16_t* smem) {
    const bf16_t* H = (const bf16_t*)(p.ws + W_H);
    const bf16_t* Wt = (const bf16_t*)(p.ws + W_B_IN);
    bf16_t* Q = (bf16_t*)(p.ws + W_BUF1);
    bf16_t* SG = Q + (size_t)MT * 1024;
    bf16_t* KV = (bf16_t*)(p.ws + W_KB);
    const float* rope = (const float*)(p.ws + W_ROPE);
    Stage st;
    bool pre = false;
    for (int t = blockIdx.x; t < 129 * 18; t += gridDim.x) {
        const int mt = t < 2064 ? (t >> 4) : ((t - 2064) >> 1), nt = t < 2064 ? (t & 15) : 16 + ((t - 2064) & 1);
        const int tn = t + gridDim.x;
        const bool hn = tn < 129 * 18;
        const int mtn = tn < 2064 ? (tn >> 4) : ((tn - 2064) >> 1), ntn = tn < 2064 ? (tn & 15) : 16 + ((tn - 2064) & 1);
        EpiB e{Q, SG, KV, rope, p.out, nt};
        gemm_tile<true>(H, 1024, Wt, 1024, 1024, mt * 128, nt * 128, smem, e, st, pre, hn, H, Wt, mtn * 128, ntn * 128);
        pre = hn;
    }
}

constexpr int VT_LD = 256;
__device__ __forceinline__ void attn_prompt_item(const Params& p, int item, bf16_t* smem) {
    const int tid = threadIdx.x, w = tid >> 6, lane = tid & 63, fr = lane & 15, fq = lane >> 4;
    const int half = item & 1, kvh = (item >> 1) & 1, nb = (item >> 2) & 63, b = item >> 8;
    const bf16_t* Q = (const bf16_t*)(p.ws + W_BUF1);
    const bf16_t* SG = Q + (size_t)MT * 1024;
    const bf16_t* KV = (const bf16_t*)(p.ws + W_KB);
    bf16_t* Z = (bf16_t*)(p.ws + W_H);
    bf16_t* Ks = smem;
    bf16_t* Vs = smem + 16384;
    const int row0 = b * SEQ + nb * 128;
    u32x4 kraw[8], vraw[8];
#pragma unroll
    for (int i = 0; i < 8; ++i) {
        const int c = tid + 256 * i, key = c >> 3, kc = c & 7;
        kraw[i] = (u32x4){0u, 0u, 0u, 0u};
        vraw[i] = (u32x4){0u, 0u, 0u, 0u};
        if (nb > 0 || key >= 128) {
            const bf16_t* src_row = KV + (size_t)(row0 - 128 + key) * 256 + kvh * 64 + kc * 8;
            kraw[i] = *(const u32x4*)src_row;
            vraw[i] = *(const u32x4*)(src_row + 128);
        }
    }
    __syncthreads();
#pragma unroll
    for (int i = 0; i < 8; ++i) {
        const int c = tid + 256 * i, key = c >> 3, kc = c & 7;
        *(u32x4*)(Ks + (kc >> 2) * 8192 + key * 32 + swz(key, kc & 3)) = kraw[i];
    }
#pragma unroll
    for (int i = 0; i < 8; ++i) {
        const int c = tid + 256 * i, key = c >> 3, dc = c & 7;
        const unsigned wv[4] = {vraw[i].x, vraw[i].y, vraw[i].z, vraw[i].w};
#pragma unroll
        for (int e = 0; e < 8; ++e) {
            const int d = dc * 8 + e;
            const unsigned short hv = (e & 1) ? (unsigned short)(wv[e >> 1] >> 16) : (unsigned short)(wv[e >> 1] & 0xffff);
            Vs[d * VT_LD + (((key >> 3) ^ ((d & 15) << 1)) << 3) + (key & 7)] = hv;
        }
    }
    __syncthreads();
    const int co = swz(fr, fq);
#pragma unroll 1
    for (int gq = half * 8; gq < half * 8 + 8; ++gq) {
        const int g = gq >> 1, qt = gq & 1;
        const int h = kvh * 8 + g;
        const float sink = p.in[15][h];
        const int qi = 32 * w + 16 * qt + fr;
        bf16x8 qf[2];
#pragma unroll
        for (int kk = 0; kk < 2; ++kk)
            qf[kk] = *(const bf16x8*)(Q + (size_t)(row0 + qi) * 1024 + h * 64 + kk * 32 + fq * 8);
        f32x4 s[10];
#pragma unroll
        for (int kt = 0; kt < 10; ++kt) s[kt] = (f32x4){0.f, 0.f, 0.f, 0.f};
#pragma unroll
        for (int kt = 0; kt < 10; ++kt) {
#pragma unroll
            for (int kk = 0; kk < 2; ++kk) {
                const bf16x8 kf = *(const bf16x8*)(Ks + kk * 8192 + (16 * (2 * w + kt) + fr) * 32 + co);
                s[kt] = __builtin_amdgcn_mfma_f32_16x16x32_bf16(kf, qf[kk], s[kt], 0, 0, 0);
            }
            if (kt & 1) __builtin_amdgcn_sched_barrier(0);
        }
        float mx = sink;
#pragma unroll
        for (int kt = 0; kt < 10; ++kt) {
            const int key0 = 16 * (2 * w + kt) + fq * 4;
#pragma unroll
            for (int r = 0; r < 4; ++r) {
                const int key = key0 + r;
                const bool valid = (key >= qi) && (key <= qi + 128) && (nb > 0 || key >= 128);
                const float v = valid ? s[kt][r] : -1e30f;
                s[kt][r] = v;
                mx = fmaxf(mx, v);
            }
        }
        mx = fmaxf(mx, __shfl_xor(mx, 16));
        mx = fmaxf(mx, __shfl_xor(mx, 32));
        float sum = 0.f;
#pragma unroll
        for (int kt = 0; kt < 10; ++kt)
#pragma unroll
            for (int r = 0; r < 4; ++r) {
                const float e = __expf(s[kt][r] - mx);
                s[kt][r] = e;
                sum += e;
            }
        sum += __shfl_xor(sum, 16);
        sum += __shfl_xor(sum, 32);
        const float inv = __builtin_amdgcn_rcpf(sum + __expf(sink - mx));
        u32x2 sgv[4];
#pragma unroll
        for (int dt = 0; dt < 4; ++dt) sgv[dt] = *(const u32x2*)(SG + (size_t)(row0 + qi) * 1024 + h * 64 + 16 * dt + fq * 4);
        f32x4 o[4];
#pragma unroll
        for (int dt = 0; dt < 4; ++dt) o[dt] = (f32x4){0.f, 0.f, 0.f, 0.f};
#pragma unroll
        for (int ks = 0; ks < 5; ++ks) {
            u32x4 pw;
            pw.x = cvt_pk(s[2 * ks][0], s[2 * ks][1]);
            pw.y = cvt_pk(s[2 * ks][2], s[2 * ks][3]);
            pw.z = cvt_pk(s[2 * ks + 1][0], s[2 * ks + 1][1]);
            pw.w = cvt_pk(s[2 * ks + 1][2], s[2 * ks + 1][3]);
            const bf16x8 pf = __builtin_bit_cast(bf16x8, pw);
            const int kc0 = (((2 * w + 2 * ks) ^ fr) << 4) + fq * 4, kc1 = (((2 * w + 2 * ks + 1) ^ fr) << 4) + fq * 4;
#pragma unroll
            for (int dt = 0; dt < 4; ++dt) {
                const bf16_t* vp = Vs + (16 * dt + fr) * VT_LD;
                u32x4 vw;
                const u32x2 v0 = *(const u32x2*)(vp + kc0), v1 = *(const u32x2*)(vp + kc1);
                vw.x = v0.x; vw.y = v0.y; vw.z = v1.x; vw.w = v1.y;
                const bf16x8 vf = __builtin_bit_cast(bf16x8, vw);
                o[dt] = __builtin_amdgcn_mfma_f32_16x16x32_bf16(vf, pf, o[dt], 0, 0, 0);
            }
            __builtin_amdgcn_sched_barrier(0);
        }
        const size_t ro = (size_t)(row0 + qi) * 1024 + h * 64;
#pragma unroll
        for (int dt = 0; dt < 4; ++dt) {
            const int d = 16 * dt + fq * 4;
            const u32x2 sg = sgv[dt];
            const f32x4 ov = o[dt] * inv;
            u32x2 wv;
            wv.x = cvt_pk(ov.x * bf_lo(sg.x), ov.y * bf_hi(sg.x));
            wv.y = cvt_pk(ov.z * bf_lo(sg.y), ov.w * bf_hi(sg.y));
            *(u32x2*)(Z + ro + d) = wv;
        }
    }
}

__device__ __forceinline__ void attn_sample_item(const Params& p, int item, unsigned char* smem_raw) {
    const int tid = threadIdx.x, g = tid >> 5, l = tid & 31;
    const int kvh = item & 1, b = item >> 1;
    const bf16_t* Q = (const bf16_t*)(p.ws + W_BUF1);
    const bf16_t* SG = Q + (size_t)MT * 1024;
    bf16_t* Z = (bf16_t*)(p.ws + W_H);
    float* kv = (float*)smem_raw;
    float* qs = kv + 129 * 65;
    float* ps = qs + 512;
    const float* ck = p.in[2];
    const float* cv = p.in[3];
    float* oks = p.out + O_BKS;
    float* ovs = p.out + O_BVS;
    const int row = M_P + b;
    f32x4 knew = {0.f, 0.f, 0.f, 0.f}, vnew = {0.f, 0.f, 0.f, 0.f};
    if (tid < 16) knew = *(const f32x4*)(oks + ((size_t)(b * 128 + 127) * 2 + kvh) * 64 + tid * 4);
    const float q0 = bf2f(Q[(size_t)row * 1024 + kvh * 512 + tid]), q1 = bf2f(Q[(size_t)row * 1024 + kvh * 512 + 256 + tid]);
    __syncthreads();
#pragma unroll 1
    for (int hb = 0; hb < 2; ++hb) {
        f32x4 kreg[4];
#pragma unroll
        for (int i = 0; i < 4; ++i) {
            const int c = tid + 256 * (hb * 4 + i), key = c >> 4, d4 = (c & 15) * 4;
            kreg[i] = *(const f32x4*)(ck + ((size_t)(b * 128 + key) * 2 + kvh) * 64 + d4);
        }
#pragma unroll
        for (int i = 0; i < 4; ++i) {
            const int c = tid + 256 * (hb * 4 + i), key = c >> 4, d4 = (c & 15) * 4;
            if (key >= 1) *(f32x4*)(oks + ((size_t)(b * 128 + key - 1) * 2 + kvh) * 64 + d4) = kreg[i];
            float* kp = kv + key * 65 + d4;
            kp[0] = kreg[i].x; kp[1] = kreg[i].y; kp[2] = kreg[i].z; kp[3] = kreg[i].w;
        }
    }
    if (tid < 16) { float* kp = kv + 128 * 65 + tid * 4; kp[0] = knew.x; kp[1] = knew.y; kp[2] = knew.z; kp[3] = knew.w; }
    qs[tid] = q0;
    qs[256 + tid] = q1;
    if (tid < 16) vnew = *(const f32x4*)(ovs + ((size_t)(b * 128 + 127) * 2 + kvh) * 64 + tid * 4);
    __syncthreads();
    const int h = kvh * 8 + g;
    const float sink = p.in[15][h];
    float sc[5];
    float mx = sink;
#pragma unroll
    for (int i = 0; i < 5; ++i) {
        const int key = l + 32 * i;
        float a = -1e30f;
        if (key < 129) {
            a = 0.f;
#pragma unroll 8
            for (int d = 0; d < 64; ++d) a += qs[g * 64 + d] * kv[key * 65 + d];
        }
        sc[i] = a;
        mx = fmaxf(mx, a);
    }
#pragma unroll
    for (int o = 1; o < 32; o <<= 1) mx = fmaxf(mx, __shfl_xor(mx, o));
    float sum = 0.f;
#pragma unroll
    for (int i = 0; i < 5; ++i) {
        const int key = l + 32 * i;
        const float e = (key < 129) ? __expf(sc[i] - mx) : 0.f;
        sc[i] = e;
        sum += e;
    }
#pragma unroll
    for (int o = 1; o < 32; o <<= 1) sum += __shfl_xor(sum, o);
    const float inv = __builtin_amdgcn_rcpf(sum + __expf(sink - mx));
#pragma unroll
    for (int i = 0; i < 5; ++i) {
        const int key = l + 32 * i;
        if (key < 129) ps[g * 132 + key] = sc[i] * inv;
    }
    __syncthreads();
#pragma unroll 1
    for (int hb = 0; hb < 2; ++hb) {
        f32x4 vreg[4];
#pragma unroll
        for (int i = 0; i < 4; ++i) {
            const int c = tid + 256 * (hb * 4 + i), key = c >> 4, d4 = (c & 15) * 4;
            vreg[i] = *(const f32x4*)(cv + ((size_t)(b * 128 + key) * 2 + kvh) * 64 + d4);
        }
#pragma unroll
        for (int i = 0; i < 4; ++i) {
            const int c = tid + 256 * (hb * 4 + i), key = c >> 4, d4 = (c & 15) * 4;
            if (key >= 1) *(f32x4*)(ovs + ((size_t)(b * 128 + key - 1) * 2 + kvh) * 64 + d4) = vreg[i];
            float* kp = kv + key * 65 + d4;
            kp[0] = vreg[i].x; kp[1] = vreg[i].y; kp[2] = vreg[i].z; kp[3] = vreg[i].w;
        }
    }
    if (tid < 16) { float* kp = kv + 128 * 65 + tid * 4; kp[0] = vnew.x; kp[1] = vnew.y; kp[2] = vnew.z; kp[3] = vnew.w; }
    __syncthreads();
    float o0 = 0.f, o1 = 0.f;
#pragma unroll 8
    for (int key = 0; key < 129; ++key) {
        const float pv = ps[g * 132 + key];
        o0 += pv * kv[key * 65 + l];
        o1 += pv * kv[key * 65 + l + 32];
    }
    const size_t ro = (size_t)row * 1024 + h * 64;
    Z[ro + l] = (bf16_t)(cvt_pk(o0 * bf2f(SG[ro + l]), 0.f) & 0xffff);
    Z[ro + l + 32] = (bf16_t)(cvt_pk(o1 * bf2f(SG[ro + l + 32]), 0.f) & 0xffff);
}

__device__ __forceinline__ void b_attn_phase(const Params& p, unsigned char* smem_raw) {
    for (int it = blockIdx.x; it < 768; it += gridDim.x) {
        if (it < 512) attn_prompt_item(p, it, (bf16_t*)smem_raw);
        else attn_sample_item(p, it - 512, smem_raw);
    }
}

struct EpiAct {
    bf16_t* XR;
    int ldo, col0, act;
    __device__ __forceinline__ void operator()(f32x4 (&acc)[4][4], int m0, int n0, int wr, int wc, int lane) const {
        const int fr = lane & 15, fq = lane >> 4;
        bf16_t* O = act ? XR + (size_t)MT * 1024 - 1024 : XR;
#pragma unroll
        for (int i = 0; i < 4; ++i) {
            const int m = m0 + wr * 64 + i * 16 + fr;
#pragma unroll
            for (int g2 = 0; g2 < 2; ++g2) {
                f32x4 a = acc[i][2 * g2], b = acc[i][2 * g2 + 1];
                if (act) {
                    a.x = silu_f(a.x); a.y = silu_f(a.y); a.z = silu_f(a.z); a.w = silu_f(a.w);
                    b.x = silu_f(b.x); b.y = silu_f(b.y); b.z = silu_f(b.z); b.w = silu_f(b.w);
                }
                u32x4 w;
                w.x = cvt_pk(a.x, a.y); w.y = cvt_pk(a.z, a.w); w.z = cvt_pk(b.x, b.y); w.w = cvt_pk(b.z, b.w);
                *(u32x4*)(O + (size_t)m * ldo + col0 + wc * 64 + 32 * g2 + 8 * fq) = w;
            }
        }
    }
};
__device__ __forceinline__ void c_in_phase(const Params& p, bf16_t* smem) {
    const bf16_t* H = (const bf16_t*)(p.ws + W_H);
    const bf16_t* Wt = (const bf16_t*)(p.ws + W_C_IN);
    bf16_t* XR = (bf16_t*)(p.ws + W_BUF1);
    bf16_t* SG = XR + (size_t)MT * 1024;
    Stage st;
    bool pre = false;
    for (int t = blockIdx.x; t < 129 * 16; t += gridDim.x) {
        const int mt = t >> 4, nt = t & 15;
        const int tn = t + gridDim.x;
        const bool hn = tn < 129 * 16;
        EpiAct e{XR, 1024, nt * 128, nt >= 8};
        gemm_tile<true>(H, 1024, Wt, 1024, 1024, mt * 128, nt * 128, smem, e, st, pre, hn, H, Wt, (tn >> 4) * 128, (tn & 15) * 128);
        pre = hn;
    }
}

__device__ __forceinline__ void unpack8(const u32x4 v, float (&x)[8]) {
    x[0] = bf_lo(v.x); x[1] = bf_hi(v.x); x[2] = bf_lo(v.y); x[3] = bf_hi(v.y);
    x[4] = bf_lo(v.z); x[5] = bf_hi(v.z); x[6] = bf_lo(v.w); x[7] = bf_hi(v.w);
}

__device__ __forceinline__ void c_conv_phase(const Params& p) {
    const bf16_t* XR = (const bf16_t*)(p.ws + W_BUF1);
    bf16_t* XC = (bf16_t*)(p.ws + W_H);
    const float* cw = p.in[18];
    const float* cb = p.in[19];
    const float* st = p.in[4];
    const int gt = blockIdx.x * NTHREADS + threadIdx.x, gn = gridDim.x * NTHREADS;
    const int c0 = (gt & 127) * 8;
    float w0[8], w1[8], w2[8], w3[8], bias[8];
#pragma unroll
    for (int e = 0; e < 8; ++e) {
        w0[e] = cw[c0 + e]; w1[e] = cw[1024 + c0 + e]; w2[e] = cw[2048 + c0 + e]; w3[e] = cw[3072 + c0 + e]; bias[e] = cb[c0 + e];
    }
    for (int run = gt >> 7; run < M_P / 8; run += gn >> 7) {
        const int r0 = run * 8, t0 = r0 & (SEQ - 1), b = r0 >> 13;
        u32x4 raw[11];
#pragma unroll
        for (int q = 0; q < 11; ++q) {
            raw[q] = (u32x4){0u, 0u, 0u, 0u};
            if (q >= 3 || t0 > 0) raw[q] = *(const u32x4*)(XR + (size_t)(r0 - 3 + q) * 1024 + c0);
        }
        float x0[8], x1[8], x2[8], x3[8];
        unpack8(raw[0], x0); unpack8(raw[1], x1); unpack8(raw[2], x2);
#pragma unroll
        for (int q = 0; q < 8; ++q) {
            unpack8(raw[q + 3], x3);
            float acc[8];
#pragma unroll
            for (int e = 0; e < 8; ++e) acc[e] = bias[e] + x0[e] * w0[e] + x1[e] * w1[e] + x2[e] * w2[e] + x3[e] * w3[e];
            u32x4 o;
            o.x = cvt_pk(acc[0], acc[1]); o.y = cvt_pk(acc[2], acc[3]); o.z = cvt_pk(acc[4], acc[5]); o.w = cvt_pk(acc[6], acc[7]);
            *(u32x4*)(XC + (size_t)(r0 + q) * 1024 + c0) = o;
            const int t = t0 + q;
            if (t >= SEQ - 3) {
                float* oo = p.out + O_CCP + ((size_t)b * 3 + (t - (SEQ - 3))) * 1024 + c0;
#pragma unroll
                for (int e = 0; e < 8; ++e) oo[e] = x3[e];
            }
#pragma unroll
            for (int e = 0; e < 8; ++e) { x0[e] = x1[e]; x1[e] = x2[e]; x2[e] = x3[e]; }
        }
    }
    for (int b = gt >> 7; b < M_S; b += gn >> 7) {
        const int row = M_P + b;
        float xv[8], acc[8];
        unpack8(*(const u32x4*)(XR + (size_t)row * 1024 + c0), xv);
#pragma unroll
        for (int e = 0; e < 8; ++e) {
            const float s0 = st[((size_t)b * 3 + 0) * 1024 + c0 + e], s1 = st[((size_t)b * 3 + 1) * 1024 + c0 + e], s2 = st[((size_t)b * 3 + 2) * 1024 + c0 + e];
            acc[e] = bias[e] + s0 * w0[e] + s1 * w1[e] + s2 * w2[e] + xv[e] * w3[e];
            p.out[O_CCS + ((size_t)b * 3 + 0) * 1024 + c0 + e] = s1;
            p.out[O_CCS + ((size_t)b * 3 + 1) * 1024 + c0 + e] = s2;
            p.out[O_CCS + ((size_t)b * 3 + 2) * 1024 + c0 + e] = xv[e];
        }
        u32x4 o;
        o.x = cvt_pk(acc[0], acc[1]); o.y = cvt_pk(acc[2], acc[3]); o.z = cvt_pk(acc[4], acc[5]); o.w = cvt_pk(acc[6], acc[7]);
        *(u32x4*)(XC + (size_t)row * 1024 + c0) = o;
    }
}

struct EpiGate {
    const bf16_t* XC;
    float* Aa;
    bf16_t* Bb;
    const float *b_a, *b_x, *lam;
    int blk, nt;
    float* lds;
    float* carry;
    __device__ __forceinline__ void operator()(f32x4 (&acc)[4][4], int m0, int n0, int wr, int wc, int lane) const {
        const int fr = lane & 15, fq = lane >> 4;
        const bool prompt = (m0 < M_P);
        __syncthreads();
#pragma unroll
        for (int jn = 0; jn < 2; ++jn) {
            const int cl = 32 * wc + 8 * fq + 4 * jn;
            const int d = blk * 256 + 64 * nt + cl;
            const f32x4 ba = *(const f32x4*)(b_a + d), bx = *(const f32x4*)(b_x + d), lm = *(const f32x4*)(lam + d);
            f32x4 sp;
            sp.x = log1pf(__expf(-lm.x)); sp.y = log1pf(__expf(-lm.y)); sp.z = log1pf(__expf(-lm.z)); sp.w = log1pf(__expf(-lm.w));
#pragma unroll
            for (int i = 0; i < 4; ++i) {
                const int rl = wr * 64 + i * 16 + fr, m = m0 + rl;
                const bool first = (m < M_P) && ((m & (SEQ - 1)) == 0);
                const u32x2 xw = *(const u32x2*)(XC + (size_t)m * 1024 + d);
                const f32x4 xc = {bf_lo(xw.x), bf_hi(xw.x), bf_lo(xw.y), bf_hi(xw.y)};
                const f32x4 ra = acc[i][jn] + ba, ia = acc[i][jn + 2] + bx;
                f32x4 av, bv;
#pragma unroll
                for (int r = 0; r < 4; ++r) {
                    const float rg = sigmoid_f(ra[r]), ig = sigmoid_f(ia[r]);
                    const float la = -8.0f * rg * sp[r];
                    const float a = __expf(la);
                    av[r] = a;
                    const float mult = first ? 1.0f : __builtin_amdgcn_sqrtf(fmaxf(1.0f - a * a, 0.f));
                    bv[r] = mult * (ig * xc[r]);
                }
                *(f32x4*)(Aa + (size_t)m * 1024 + d) = av;
                u32x2 w;
                w.x = cvt_pk(bv.x, bv.y);
                w.y = cvt_pk(bv.z, bv.w);
                *(u32x2*)(Bb + (size_t)m * 1024 + d) = w;
                if (prompt) {
                    *(f32x4*)(lds + rl * 64 + cl) = av;
                    *(f32x4*)(lds + 8192 + rl * 64 + cl) = (f32x4){bf_lo(w.x), bf_hi(w.x), bf_lo(w.y), bf_hi(w.y)};
                }
            }
        }
        __syncthreads();
        if (prompt && threadIdx.x < 64) {
            float A = 1.f, h = 0.f;
#pragma unroll 16
            for (int r = 0; r < 128; ++r) {
                const float a = lds[r * 64 + threadIdx.x], b = lds[8192 + r * 64 + threadIdx.x];
                A *= a;
                h = a * h + b;
            }
            const int chunk = m0 >> 7, d = blk * 256 + 64 * nt + threadIdx.x;
            carry[(size_t)chunk * 2048 + d] = A;
            carry[(size_t)chunk * 2048 + 1024 + d] = h;
        }
    }
};

__device__ __forceinline__ void c_gate_phase(const Params& p, bf16_t* smem) {
    const bf16_t* XC = (const bf16_t*)(p.ws + W_H);
    const bf16_t* Wg = (const bf16_t*)(p.ws + W_C_G);
    float* Aa = (float*)(p.ws + W_BUF2);
    bf16_t* Bb = (bf16_t*)(p.ws + W_BUF1);
    Stage st;
    bool pre = false;
    for (int t = blockIdx.x; t < 129 * 16; t += gridDim.x) {
        const int mt = t >> 4, blk = (t >> 2) & 3, nt = t & 3;
        const int tn = t + gridDim.x, blkn = (tn >> 2) & 3;
        const bool hn = tn < 129 * 16;
        EpiGate e{XC, Aa, Bb, p.in[21], p.in[23], p.in[24], blk, nt, (float*)smem, (float*)(p.ws + W_CARRY)};
        gemm_tile<true>(XC + blk * 256, 1024, Wg + (size_t)blk * 512 * 256, 256, 256, mt * 128, nt * 128, smem, e, st, pre, hn,
                        XC + blkn * 256, Wg + (size_t)blkn * 512 * 256, (tn >> 4) * 128, (tn & 3) * 128);
        pre = hn;
    }
}

__device__ __forceinline__ void c_scan1_phase(const Params& p) {
    const float* Aa = (const float*)(p.ws + W_BUF2);
    const bf16_t* Bb = (const bf16_t*)(p.ws + W_BUF1);
    float* carry = (float*)(p.ws + W_CARRY);
    for (int it = blockIdx.x; it < 512; it += gridDim.x) {
        const int chunk = it >> 2, d = (it & 3) * 256 + threadIdx.x;
        float A = 1.f, h = 0.f;
        const size_t base = (size_t)chunk * 128 * 1024 + d;
#pragma unroll 8
        for (int r = 0; r < 128; ++r) {
            const float a = Aa[base + (size_t)r * 1024], b = bf2f(Bb[base + (size_t)r * 1024]);
            A *= a;
            h = a * h + b;
        }
        carry[(size_t)chunk * 2048 + d] = A;
        carry[(size_t)chunk * 2048 + 1024 + d] = h;
    }
}

__device__ __forceinline__ void c_scan2_phase(const Params& p) {
    const float* Aa = (const float*)(p.ws + W_BUF2);
    const bf16_t* Bb = (const bf16_t*)(p.ws + W_BUF1);
    const bf16_t* SG = Bb + (size_t)MT * 1024;
    const float* carry = (const float*)(p.ws + W_CARRY);
    bf16_t* Z = (bf16_t*)(p.ws + W_H);
    for (int it = blockIdx.x; it < 512 + 512; it += gridDim.x) {
        if (it < 512) {
            const int chunk = it >> 2, d = (it & 3) * 256 + threadIdx.x;
            const int b = chunk >> 6, ci = chunk & 63;
            float h = 0.f;
            {
                const float* c0 = carry + (size_t)(b * 64) * 2048 + d;
                int jc = 0;
                for (; jc + 16 <= ci; jc += 16) {
                    float ca[16], ch[16];
#pragma unroll
                    for (int q = 0; q < 16; ++q) { ca[q] = c0[(size_t)(jc + q) * 2048]; ch[q] = c0[(size_t)(jc + q) * 2048 + 1024]; }
#pragma unroll
                    for (int q = 0; q < 16; ++q) h = ca[q] * h + ch[q];
                }
                for (; jc < ci; ++jc) h = c0[(size_t)jc * 2048] * h + c0[(size_t)jc * 2048 + 1024];
            }
            const size_t base = (size_t)chunk * 128 * 1024 + d;
for (int r0 = 0; r0 < 128; r0 += 32) {
                float av[32];
                bf16_t bv[32], sv[32];
#pragma unroll
                for (int q = 0; q < 32; ++q) {
                    const size_t o = base + (size_t)(r0 + q) * 1024;
                    av[q] = Aa[o]; bv[q] = Bb[o]; sv[q] = SG[o];
                }
#pragma unroll
                for (int q = 0; q < 32; ++q) {
                    h = av[q] * h + bf2f(bv[q]);
                    Z[base + (size_t)(r0 + q) * 1024] = (bf16_t)(cvt_pk(h * bf2f(sv[q]), 0.f) & 0xffff);
                }
            }
            if (ci == 63) p.out[O_CHP + (size_t)b * 1024 + d] = h;
        } else {
            const int s = it - 512, d = (s & 3) * 256 + threadIdx.x, b = s >> 2;
            const size_t o = (size_t)(M_P + b) * 1024 + d;
            const float h = Aa[o] * p.in[5][(size_t)b * 1024 + d] + bf2f(Bb[o]);
            Z[o] = (bf16_t)(cvt_pk(h * bf2f(SG[o]), 0.f) & 0xffff);
            p.out[O_CHS + (size_t)b * 1024 + d] = h;
        }
    }
}

constexpr int N_PHASES = 20;

__device__ __forceinline__ void run_phase(const Params& p, int ph, unsigned char* smem_raw) {
    bf16_t* smem = (bf16_t*)smem_raw;
    float* Y = (float*)(p.ws + W_BUF2);
    float* YP = (float*)(p.ws + W_YPART);
    float* X = p.out + O_X;
    bf16_t* XB = (bf16_t*)(p.ws + W_XB);
    bf16_t* H = (bf16_t*)(p.ws + W_H);
    switch (ph) {
        case 0: prep_phase(p, smem_raw); break;
        case 1: a_in_phase(p, 0, smem); break;
        case 2: a_mix_phase(p, 0, smem); break;
        case 3: out_gemm_phase((const bf16_t*)(p.ws + W_BUF1), 2048, (const bf16_t*)(p.ws + W_A_OUT), Y, YP, smem); break;
        case 4: norm_phase(Y, YP, 8, p.in[0], p.in[1], XB, true, nullptr, p.in[7] + 0 * 1024, p.in[6] + 1 * 1024, H); break;
        case 5: b_in_phase(p, smem); break;
        case 6: b_attn_phase(p, smem_raw); break;
        case 7: out_gemm_phase(H, 1024, (const bf16_t*)(p.ws + W_B_OUT), Y, YP, smem); break;
        case 8: norm_phase(Y, YP, 4, nullptr, nullptr, XB, true, nullptr, p.in[7] + 1 * 1024, p.in[6] + 2 * 1024, H); break;
        case 9: c_in_phase(p, smem); break;
        case 10: c_conv_phase(p); break;
        case 11: c_gate_phase(p, smem); break;
        case 12: c_scan1_phase(p); break;
        case 13: c_scan2_phase(p); break;
        case 14: out_gemm_phase(H, 1024, (const bf16_t*)(p.ws + W_C_OUT), Y, YP, smem); break;
        case 15: norm_phase(Y, YP, 4, nullptr, nullptr, XB, true, nullptr, p.in[7] + 2 * 1024, p.in[6] + 3 * 1024, H); break;
        case 16: a_in_phase(p, 1, smem); break;
        case 17: a_mix_phase(p, 1, smem); break;
        case 18: out_gemm_phase((const bf16_t*)(p.ws + W_BUF1), 2048, (const bf16_t*)(p.ws + W_A_OUT) + (size_t)1024 * 2048, Y, YP, smem); break;
        case 19: norm_phase(Y, YP, 8, nullptr, nullptr, XB, false, X, p.in[7] + 3 * 1024, nullptr, H); break;
        default: break;
    }
}


#define XB_TMO      128
#define XB_XCNT(j)  (256  + 64 * (j))
#define XB_XSUB(j)  (1280 + 64 * (j))
#define XB_XGEN(j)  (2304 + 64 * (j))
#define XB_TOP      3328
#define XB_TOPGEN   3392
#define XCD_BAR_WORDS 3456
#define XB_SPIN_CAP (1u << 20)
__device__ __forceinline__ unsigned xb_ld(unsigned* p) { return __hip_atomic_load(p, __ATOMIC_RELAXED, __HIP_MEMORY_SCOPE_AGENT); }
__device__ __forceinline__ unsigned xb_add(unsigned* p, unsigned v) { return __hip_atomic_fetch_add(p, v, __ATOMIC_RELAXED, __HIP_MEMORY_SCOPE_AGENT); }
__device__ __forceinline__ unsigned xb_xcc_id() { return (unsigned)__builtin_amdgcn_s_getreg((3 << 11) | 20) & 0xFu; }
#define XB_SPIN(cond, bar) do { unsigned _sp = 0; while (cond) { __builtin_amdgcn_s_sleep(1); \
    if ((++_sp & 255u) == 0u) { if (xb_ld(&(bar)[XB_TMO])) break; if (_sp > XB_SPIN_CAP) { atomicAdd(&(bar)[XB_TMO], 1u); break; } } } } while (0)
struct XcdBarrier { unsigned* bar; unsigned x, nloc, nx; };
__device__ __forceinline__ void xcd_barrier_complete(unsigned* bar, unsigned x, unsigned& nloc, unsigned& nx) {
    const unsigned G = gridDim.x;
    unsigned sum, cnt, mine, sp = 0u;
    for (;;) {
        sum = 0u; cnt = 0u; mine = 0u;
#pragma unroll
        for (unsigned j = 0; j < 16; ++j) { const unsigned c = xb_ld(&bar[XB_XCNT(j)]); sum += c; cnt += (c > 0u) ? 1u : 0u; mine = (j == x) ? c : mine; }
        if (sum == G) break;
        __builtin_amdgcn_s_sleep(1);
        if ((++sp & 255u) == 0u) { if (xb_ld(&bar[XB_TMO])) break; if (sp > XB_SPIN_CAP) { atomicAdd(&bar[XB_TMO], 1u); break; } }
    }
    nloc = mine > 0u ? mine : 1u; nx = cnt > 0u ? cnt : 1u;
}
__device__ __forceinline__ void xcd_barrier(XcdBarrier& b) {
    asm volatile("s_waitcnt vmcnt(0)" ::: "memory");
    __syncthreads();
    if (threadIdx.x == 0) {
        unsigned* bar = b.bar;
        __builtin_amdgcn_s_waitcnt(0);
        if (b.nloc == 0u) xcd_barrier_complete(bar, b.x, b.nloc, b.nx);
        const unsigned nloc = b.nloc, nx = b.nx;
        const unsigned old = xb_add(&bar[XB_XSUB(b.x)], 1u);
        const unsigned gen = old / nloc;
        if (old + 1u == (gen + 1u) * nloc) {
            __builtin_amdgcn_fence(__ATOMIC_RELEASE, "agent");
            asm volatile("s_waitcnt vmcnt(0)" ::: "memory");
            const unsigned og = xb_add(&bar[XB_TOP], 1u);
            const unsigned tg = og / nx;
            if (og + 1u == (tg + 1u) * nx) xb_add(&bar[XB_TOPGEN], 1u);
            else XB_SPIN(xb_ld(&bar[XB_TOPGEN]) == tg, bar);
            __builtin_amdgcn_fence(__ATOMIC_ACQUIRE, "agent");
            xb_add(&bar[XB_XGEN(b.x)], 1u);
            asm volatile("s_waitcnt vmcnt(0)" ::: "memory");
        } else {
            XB_SPIN(xb_ld(&bar[XB_XGEN(b.x)]) == gen, bar);
            __builtin_amdgcn_fence(__ATOMIC_ACQUIRE, "agent");
            asm volatile("s_waitcnt vmcnt(0)" ::: "memory");
        }
    }
    __syncthreads();
}

#ifndef PROBE_K
#define PROBE_K 20
#endif
__device__ __forceinline__ void dump_phase(const Params& p) {
    const unsigned* base = (const unsigned*)(p.ws);
    const size_t nwords = W_END / 4, n = (size_t)MT * D;
    const size_t gt = (size_t)blockIdx.x * NTHREADS + threadIdx.x, gn = (size_t)gridDim.x * NTHREADS;
    for (size_t i = gt; i < n; i += gn) {
        float a = 0.f;
        for (int k = 0; k < 4; ++k) {
            const size_t w = i + (size_t)k * n;
            if (w < nwords) { const unsigned u = base[w]; a += (float)((u * 2654435761u) >> 29); }
        }
        p.out[i] = a;
    }
}
constexpr size_t W_BAR = W_END;
#define PHASE(i) if (p.ph_lo <= (i) && (i) < p.ph_hi) { if ((i) > p.ph_lo) xcd_barrier(xb); run_phase(p, (i), smem_raw); }
__global__ void __launch_bounds__(NTHREADS, 2) mega_kernel(Params p) {
    __shared__ __attribute__((aligned(16))) unsigned char smem_raw[SMEM_BYTES];
    XcdBarrier xb;
    xb.bar = (unsigned*)(p.ws + W_BAR); xb.x = xb_xcc_id(); xb.nloc = 0u; xb.nx = 0u;
    if (threadIdx.x == 0) (void)xb_add(&xb.bar[XB_XCNT(xb.x)], 1u);
    if (p.ph_lo < 0) cg::this_grid().sync();
    PHASE(0) PHASE(1) PHASE(2) PHASE(3) PHASE(4) PHASE(5) PHASE(6) PHASE(7) PHASE(8) PHASE(9)
    PHASE(10) PHASE(11) PHASE(13) PHASE(14) PHASE(15) PHASE(16) PHASE(17) PHASE(18) PHASE(19)
    if (ONE_LAUNCH && p.ph_hi < N_PHASES && p.ph_lo == 0) { xcd_barrier(xb); dump_phase(p); }
    if (!ONE_LAUNCH && p.ph_lo == N_PHASES) dump_phase(p);
}

extern "C" void kernel_launch(void* const* d_in, const int* in_sizes, int n_in, void* d_out, int out_size, void* d_ws, size_t ws_size,
                              hipStream_t stream) {
    static int grid = 0;
    if (grid == 0) {
        if (n_in != 26 || (size_t)out_size != O_END || ws_size < W_END + XCD_BAR_WORDS * 4) {
            fprintf(stderr, "kernel_launch: unexpected shapes n_in=%d out=%d ws=%zu (need %zu)\n", n_in, out_size, ws_size, (size_t)W_END);
            grid = -1;
            return;
        }
        int dev = 0, cus = 0, per_cu = 0;
        (void)hipGetDevice(&dev);
        (void)hipDeviceGetAttribute(&cus, hipDeviceAttributeMultiprocessorCount, dev);
        (void)hipOccupancyMaxActiveBlocksPerMultiprocessor(&per_cu, (const void*)mega_kernel, NTHREADS, 0);
        if (per_cu < 1) per_cu = 1;
        if (per_cu > 2) per_cu = 2;
        grid = cus * per_cu;
    }
    if (grid < 0) return;
    Params p{};
    for (int i = 0; i < 26; ++i) p.in[i] = (const float*)d_in[i];
    p.out = (float*)d_out;
    p.ws = (unsigned char*)d_ws;
#if ONE_LAUNCH
    (void)hipMemsetAsync((unsigned char*)d_ws + W_BAR, 0, XCD_BAR_WORDS * 4, stream);
    p.ph_lo = 0;
    p.ph_hi = PROBE_K;
    void* args[] = {&p};
    hipError_t e = hipLaunchCooperativeKernel((const void*)mega_kernel, dim3(grid), dim3(NTHREADS), args, 0, stream);
    if (e != hipSuccess) fprintf(stderr, "cooperative launch failed: %s (grid %d)\n", hipGetErrorString(e), grid);
#else
    for (int ph = 0; ph < N_PHASES; ++ph) {
        p.ph_lo = ph;
        p.ph_hi = ph + 1;
        hipLaunchKernelGGL(mega_kernel, dim3(grid), dim3(NTHREADS), 0, stream, p);
    }
#endif
}
```

```cpp
#include <hip/hip_runtime.h>
#include <hip/hip_cooperative_groups.h>
#include <stdint.h>
#include <stdio.h>
#include <math.h>
namespace cg = cooperative_groups;

#ifndef ONE_LAUNCH
#define ONE_LAUNCH 1
#endif

typedef unsigned short bf16_t;
typedef short bf16x8 __attribute__((ext_vector_type(8)));
typedef float f32x4 __attribute__((ext_vector_type(4)));
typedef unsigned u32x4 __attribute__((ext_vector_type(4)));
typedef unsigned u32x2 __attribute__((ext_vector_type(2)));

constexpr int M_P = 16384, M_S = 128, MT = 16512, D = 1024, SEQ = 8192;
constexpr int NTHREADS = 256;
constexpr int SMEM_BYTES = 65536;

constexpr size_t O_X = 0;
constexpr size_t O_AV = (size_t)MT * D;
constexpr size_t O_BKP = O_AV + 2 * 128 * 2048;
constexpr size_t O_BVP = O_BKP + 2 * 128 * 128;
constexpr size_t O_BKS = O_BVP + 2 * 128 * 128;
constexpr size_t O_BVS = O_BKS + 128 * 128 * 128;
constexpr size_t O_CCP = O_BVS + 128 * 128 * 128;
constexpr size_t O_CHP = O_CCP + 2 * 3 * 1024;
constexpr size_t O_CCS = O_CHP + 2 * 1024;
constexpr size_t O_CHS = O_CCS + 128 * 3 * 1024;
constexpr size_t O_END = O_CHS + 128 * 1024;

constexpr size_t W_A_IN = 0;
constexpr size_t W_A_OUT = W_A_IN + (size_t)2 * 6144 * 1024 * 2;
constexpr size_t W_B_IN = W_A_OUT + (size_t)2 * 1024 * 2048 * 2;
constexpr size_t W_B_OUT = W_B_IN + (size_t)2304 * 1024 * 2;
constexpr size_t W_C_IN = W_B_OUT + (size_t)1024 * 1024 * 2;
constexpr size_t W_C_G = W_C_IN + (size_t)2048 * 1024 * 2;
constexpr size_t W_C_OUT = W_C_G + (size_t)4 * 512 * 256 * 2;
constexpr size_t W_WS_A = W_C_OUT + (size_t)1024 * 1024 * 2;
constexpr size_t W_ROPE = W_WS_A + (size_t)2 * 4 * 128 * 128 * 2;
constexpr size_t W_H = W_ROPE + (size_t)8193 * 64 * 4;
constexpr size_t W_BUF1 = W_H + (size_t)MT * 1024 * 2;
constexpr size_t W_BUF2 = W_BUF1 + (size_t)MT * 2048 * 2;
constexpr size_t W_KB = W_BUF2 + (size_t)MT * 2048 * 2;
constexpr size_t W_STATS = W_KB;
constexpr size_t W_CARRY = W_KB + (size_t)MT * 256 * 2;
constexpr size_t W_YPART = W_CARRY + (size_t)128 * 1024 * 2 * 4;
constexpr size_t W_XB = W_YPART + (size_t)8 * 128 * 1024 * 4;
constexpr size_t W_SP = W_XB + (size_t)MT * 1024 * 2;
constexpr size_t W_END = W_SP + 4096;

struct Params {
    const float* in[26];
    float* out;
    unsigned char* ws;
    int ph_lo, ph_hi;
};

__device__ __forceinline__ unsigned cvt_pk(float lo, float hi) {
    unsigned r;
    asm("v_cvt_pk_bf16_f32 %0, %1, %2" : "=v"(r) : "v"(lo), "v"(hi));
    return r;
}
__device__ __forceinline__ float bf_lo(unsigned u) { return __uint_as_float(u << 16); }
__device__ __forceinline__ float bf_hi(unsigned u) { return __uint_as_float(u & 0xffff0000u); }
__device__ __forceinline__ float bf2f(bf16_t h) { return __uint_as_float(((unsigned)h) << 16); }
__device__ __forceinline__ float sigmoid_f(float x) { return __builtin_amdgcn_rcpf(1.f + __expf(-x)); }
__device__ __forceinline__ float silu_f(float x) { return x * sigmoid_f(x); }
__device__ __forceinline__ float gelu_f(float x) { return x * sigmoid_f(1.5957691216057308f * (x + 0.044715f * x * x * x)); }
__device__ __forceinline__ float gelu_silu(float u, float g) {
    const float eu = __expf(-1.5957691216057308f * (u + 0.044715f * u * u * u)), eg = __expf(-g);
    const float den = (1.f + eu) * (1.f + eg);
    return (u * g) * __builtin_amdgcn_rcpf(den);
}
template <int CTRL> __device__ __forceinline__ float dpp_add(float x) {
    return x + __builtin_bit_cast(float, __builtin_amdgcn_update_dpp(0, __builtin_bit_cast(int, x), CTRL, 0xF, 0xF, true));
}
__device__ __forceinline__ float row16_sum(float x) {
    x = dpp_add<0xB1>(x);
    x = dpp_add<0x4E>(x);
    x = dpp_add<0x141>(x);
    x = dpp_add<0x140>(x);
    return x;
}
__device__ __forceinline__ float wave_sum(float v) {
#pragma unroll
    for (int o = 1; o < 64; o <<= 1) v += __shfl_xor(v, o);
    return v;
}

__device__ __forceinline__ int perm32(int rho) { return 8 * ((rho & 15) >> 2) + 4 * (rho >> 4) + (rho & 3); }
__device__ __forceinline__ int permcol(int c) { return (c & ~31) + perm32(c & 31); }
__device__ __forceinline__ int swz(int row, int chunk) { return (chunk ^ (((row >> 3) & 1) << 1)) * 8; }

template <bool TRANS>
__device__ __forceinline__ void mma_stage(const bf16_t* As, const bf16_t* Bs, int apanel, int bpanel, f32x4 (&acc)[4][4], int wr, int wc, int lane) {
    const int fr = lane & 15, fq = lane >> 4;
    const int co = swz(fr, fq);
#pragma unroll
    for (int kk = 0; kk < 2; ++kk) {
        bf16x8 a[4], b[4];
#pragma unroll
        for (int i = 0; i < 4; ++i) {
            a[i] = *(const bf16x8*)(As + kk * apanel + (wr * 64 + i * 16 + fr) * 32 + co);
            b[i] = *(const bf16x8*)(Bs + kk * bpanel + (wc * 64 + i * 16 + fr) * 32 + co);
        }
#pragma unroll
        for (int i = 0; i < 4; ++i)
#pragma unroll
            for (int j = 0; j < 4; ++j)
                acc[i][j] = TRANS ? __builtin_amdgcn_mfma_f32_16x16x32_bf16(b[j], a[i], acc[i][j], 0, 0, 0)
                                  : __builtin_amdgcn_mfma_f32_16x16x32_bf16(a[i], b[j], acc[i][j], 0, 0, 0);
    }
}

__device__ __forceinline__ void g2r(const bf16_t* __restrict__ g, int ld, int row0, int k0, int tid, u32x4 (&r)[4]) {
    const int rl = 2 * (tid >> 4) + ((tid >> 2) & 1), kc = ((tid >> 3) & 1) * 4 + (tid & 3);
    const unsigned voff = (unsigned)(rl * ld + kc * 8) * 2u;
#pragma unroll
    for (int i = 0; i < 4; ++i) {
        const char* b = (const char*)(g + (size_t)(row0 + 32 * i) * ld + k0);
        r[i] = *(const u32x4*)(b + voff);
    }
}
__device__ __forceinline__ void r2s(bf16_t* s, int tid, const u32x4 (&r)[4]) {
    const int rl = 2 * (tid >> 4) + ((tid >> 2) & 1), kc = ((tid >> 3) & 1) * 4 + (tid & 3);
#pragma unroll
    for (int i = 0; i < 4; ++i) {
        const int row = rl + 32 * i;
        *(u32x4*)(s + (kc >> 2) * 4096 + row * 32 + swz(row, kc & 3)) = r[i];
    }
}

__device__ __forceinline__ void g2r32(const bf16_t* __restrict__ g, int ld, int row0, int k0, int tid, u32x4 (&r)[2]) {
    const unsigned voff = (unsigned)((tid >> 2) * ld + (tid & 3) * 8) * 2u;
#pragma unroll
    for (int i = 0; i < 2; ++i) {
        const char* b = (const char*)(g + (size_t)(row0 + 64 * i) * ld + k0);
        r[i] = *(const u32x4*)(b + voff);
    }
}
__device__ __forceinline__ void r2s32(bf16_t* s, int tid, const u32x4 (&r)[2]) {
#pragma unroll
    for (int i = 0; i < 2; ++i) {
        const int row = (tid >> 2) + 64 * i;
        *(u32x4*)(s + row * 32 + swz(row, tid & 3)) = r[i];
    }
}
__device__ __forceinline__ void ldfrag(const bf16_t* st, bf16x8 (&a)[4], bf16x8 (&b)[4], int wr, int wc, int fr, int co) {
#pragma unroll
    for (int i = 0; i < 4; ++i) {
        a[i] = *(const bf16x8*)(st + (wr * 64 + i * 16 + fr) * 32 + co);
        b[i] = *(const bf16x8*)(st + 4096 + (wc * 64 + i * 16 + fr) * 32 + co);
    }
}
template <bool TRANS>
__device__ __forceinline__ void mma16(const bf16x8 (&a)[4], const bf16x8 (&b)[4], f32x4 (&acc)[4][4]) {
    __builtin_amdgcn_s_setprio(1);
#pragma unroll
    for (int i = 0; i < 4; ++i)
#pragma unroll
        for (int j = 0; j < 4; ++j)
            acc[i][j] = TRANS ? __builtin_amdgcn_mfma_f32_16x16x32_bf16(b[j], a[i], acc[i][j], 0, 0, 0)
                              : __builtin_amdgcn_mfma_f32_16x16x32_bf16(a[i], b[j], acc[i][j], 0, 0, 0);
    __builtin_amdgcn_s_setprio(0);
}

struct Stage { u32x4 ra0[2], rb0[2], ra1[2], rb1[2]; };

template <bool TRANS, class Epi>
__device__ __forceinline__ void gemm_tile(const bf16_t* __restrict__ A, int lda, const bf16_t* __restrict__ Bt, int ldb, int K, int m0, int n0,
                                          bf16_t* smem, const Epi epi, Stage& st, bool pre, bool has_next, const bf16_t* __restrict__ An,
                                          const bf16_t* __restrict__ Bn, int m0n, int n0n) {
    const int tid = threadIdx.x, wid = tid >> 6, lane = tid & 63, wr = wid >> 1, wc = wid & 1, fr = lane & 15, fq = lane >> 4;
    const int co = swz(fr, fq);
    f32x4 acc[4][4];
#pragma unroll
    for (int i = 0; i < 4; ++i)
#pragma unroll
        for (int j = 0; j < 4; ++j) acc[i][j] = (f32x4){0.f, 0.f, 0.f, 0.f};
    const int nk = K >> 5;
    bf16x8 a0[4], b0[4], a1[4], b1[4];
    if (!pre) {
        g2r32(A, lda, m0, 0, tid, st.ra0);
        g2r32(Bt, ldb, n0, 0, tid, st.rb0);
        g2r32(A, lda, m0, 32, tid, st.ra1);
        g2r32(Bt, ldb, n0, 32, tid, st.rb1);
    }
    __syncthreads();
    r2s32(smem, tid, st.ra0);
    r2s32(smem + 4096, tid, st.rb0);
    r2s32(smem + 8192, tid, st.ra1);
    r2s32(smem + 8192 + 4096, tid, st.rb1);
    g2r32(A, lda, m0, 64, tid, st.ra0);
    g2r32(Bt, ldb, n0, 64, tid, st.rb0);
    g2r32(A, lda, m0, 96, tid, st.ra1);
    g2r32(Bt, ldb, n0, 96, tid, st.rb1);
    __syncthreads();
    ldfrag(smem, a0, b0, wr, wc, fr, co);
    for (int kt = 0; kt < nk; kt += 2) {
        {
            bf16_t* w = smem + ((kt + 2) & 3) * 8192;
            r2s32(w, tid, st.ra0);
            r2s32(w + 4096, tid, st.rb0);
            const int kn = (kt + 4 < nk ? kt + 4 : nk - 1) * 32;
            g2r32(A, lda, m0, kn, tid, st.ra0);
            g2r32(Bt, ldb, n0, kn, tid, st.rb0);
            ldfrag(smem + ((kt + 1) & 3) * 8192, a1, b1, wr, wc, fr, co);
            mma16<TRANS>(a0, b0, acc);
            __syncthreads();
        }
        {
            bf16_t* w = smem + ((kt + 3) & 3) * 8192;
            r2s32(w, tid, st.ra1);
            r2s32(w + 4096, tid, st.rb1);
            const int kn = (kt + 5 < nk ? kt + 5 : nk - 1) * 32;
            g2r32(A, lda, m0, kn, tid, st.ra1);
            g2r32(Bt, ldb, n0, kn, tid, st.rb1);
            ldfrag(smem + ((kt + 2) & 3) * 8192, a0, b0, wr, wc, fr, co);
            mma16<TRANS>(a1, b1, acc);
            __syncthreads();
        }
    }
    if (has_next) {
        g2r32(An, lda, m0n, 0, tid, st.ra0);
        g2r32(Bn, ldb, n0n, 0, tid, st.rb0);
        g2r32(An, lda, m0n, 32, tid, st.ra1);
        g2r32(Bn, ldb, n0n, 32, tid, st.rb1);
    }
    epi(acc, m0, n0, wr, wc, lane);
}

__device__ __forceinline__ void wt_tile(const float* colptr, int ldsrc, bf16_t* dst, int ldd, float* tile, int tid) {
    const int tx = tid & 63, ty = tid >> 6;
    float v[16];
#pragma unroll
    for (int q = 0; q < 16; ++q) v[q] = colptr[(size_t)(ty + 4 * q) * ldsrc];
#pragma unroll
    for (int q = 0; q < 16; ++q) tile[(ty + 4 * q) * 65 + tx] = v[q];
    __syncthreads();
    const int c2 = tid & 31, r0 = tid >> 5;
#pragma unroll
    for (int rr = r0; rr < 64; rr += 8)
        *(unsigned*)(dst + (size_t)rr * ldd + 2 * c2) = cvt_pk(tile[(2 * c2) * 65 + rr], tile[(2 * c2 + 1) * 65 + rr]);
    __syncthreads();
}

__device__ __forceinline__ void sincos_d(double x, double& s, double& c) {
    const double k = rint(x * 0.63661977236758134308);
    double r = fma(-k, 1.57079632673412561417e+00, x);
    r = fma(-k, 6.07710050650619224932e-11, r);
    const double z = r * r;
    const double sp = r + r * z * (-1.66666666666666324348e-01 + z * (8.33333333332248946124e-03 + z * (-1.98412698298579493134e-04 + z * (2.75573137070700676789e-06 + z * (-2.50507602534068634195e-08 + z * 1.58969099521155010221e-10)))));
    const double cp = 1.0 - 0.5 * z + z * z * (4.16666666666666019037e-02 + z * (-1.38888888888741095749e-03 + z * (2.48015872894767294178e-05 + z * (-2.75573143513906633035e-07 + z * (2.08757232129817482790e-09 + z * -1.13596475577881948265e-11)))));
    const int q = ((int)k) & 3;
    s = (q == 0) ? sp : (q == 1) ? cp : (q == 2) ? -sp : -cp;
    c = (q == 0) ? cp : (q == 1) ? -sp : (q == 2) ? -cp : sp;
}

__device__ __forceinline__ void norm_phase(const float* __restrict__ Y, const float* __restrict__ Ypart, int nsplit, const float* xin_p, const float* xin_s,
                                           bf16_t* Xb, bool storeXb, float* Xf, const float* gpost, const float* gpre, bf16_t* H) {
    const int lane = threadIdx.x & 63;
    const int gw = blockIdx.x * 4 + (threadIdx.x >> 6), nw = gridDim.x * 4;
    for (int ri = gw; ri < MT; ri += nw) {
        const int row = ri < M_S ? M_P + ri : ri - M_S;
        f32x4 x[4];
        if (xin_p) {
            const float* xr = row < M_P ? xin_p + (size_t)row * D : xin_s + (size_t)(row - M_P) * D;
#pragma unroll
            for (int j = 0; j < 4; ++j) x[j] = *(const f32x4*)(xr + j * 256 + lane * 4);
        } else {
#pragma unroll
            for (int j = 0; j < 4; ++j) {
                const u32x2 w = *(const u32x2*)(Xb + (size_t)row * D + j * 256 + lane * 4);
                x[j] = (f32x4){bf_lo(w.x), bf_hi(w.x), bf_lo(w.y), bf_hi(w.y)};
            }
        }
        if (Y) {
            f32x4 y[4];
            float ss = 0.f;
            if (row < M_P) {
#pragma unroll
                for (int j = 0; j < 4; ++j) {
                    const u32x2 w = *(const u32x2*)((const bf16_t*)Y + (size_t)row * D + j * 256 + lane * 4);
                    y[j] = (f32x4){bf_lo(w.x), bf_hi(w.x), bf_lo(w.y), bf_hi(w.y)};
                }
            } else {
#pragma unroll
                for (int j = 0; j < 4; ++j) y[j] = (f32x4){0.f, 0.f, 0.f, 0.f};
                for (int s = 0; s < nsplit; s += 4) {
                    f32x4 t[4][4];
#pragma unroll
                    for (int u = 0; u < 4; ++u)
#pragma unroll
                        for (int j = 0; j < 4; ++j) t[u][j] = *(const f32x4*)(Ypart + ((size_t)(s + u) * 128 + (row - M_P)) * D + j * 256 + lane * 4);
#pragma unroll
                    for (int u = 0; u < 4; ++u)
#pragma unroll
                        for (int j = 0; j < 4; ++j) y[j] += t[u][j];
                }
            }
#pragma unroll
            for (int j = 0; j < 4; ++j) ss += y[j].x * y[j].x + y[j].y * y[j].y + y[j].z * y[j].z + y[j].w * y[j].w;
            ss = wave_sum(ss);
            const float rstd = rsqrtf(ss * (1.f / 1024.f) + 1e-6f);
#pragma unroll
            for (int j = 0; j < 4; ++j) {
                const f32x4 g = *(const f32x4*)(gpost + j * 256 + lane * 4);
                x[j] = x[j] + y[j] * rstd * g;
            }
        }
        if (storeXb) {
#pragma unroll
            for (int j = 0; j < 4; ++j) {
                u32x2 w;
                w.x = cvt_pk(x[j].x, x[j].y);
                w.y = cvt_pk(x[j].z, x[j].w);
                *(u32x2*)(Xb + (size_t)row * D + j * 256 + lane * 4) = w;
            }
        }
        if (Xf) {
#pragma unroll
            for (int j = 0; j < 4; ++j) *(f32x4*)(Xf + (size_t)row * D + j * 256 + lane * 4) = x[j];
        }
        if (gpre) {
            float ss = 0.f;
#pragma unroll
            for (int j = 0; j < 4; ++j) ss += x[j].x * x[j].x + x[j].y * x[j].y + x[j].z * x[j].z + x[j].w * x[j].w;
            ss = wave_sum(ss);
            const float rstd = rsqrtf(ss * (1.f / 1024.f) + 1e-6f);
#pragma unroll
            for (int j = 0; j < 4; ++j) {
                const f32x4 g = *(const f32x4*)(gpre + j * 256 + lane * 4);
                const f32x4 h = x[j] * rstd * g;
                u32x2 w;
                w.x = cvt_pk(h.x, h.y);
                w.y = cvt_pk(h.z, h.w);
                *(u32x2*)(H + (size_t)row * D + j * 256 + lane * 4) = w;
            }
        }
    }
}

constexpr int WT_FIRST = 96 * 16;
constexpr int WT_TOTAL = 2 * 96 * 16 + 2 * 16 * 32 + 36 * 16 + 256 + 32 * 16 + 128 + 256;
__device__ __forceinline__ void wt_jobs(const Params& p, unsigned char* smem, int lo, int hi, int w, int nw) {
    float* tile = (float*)smem;
    const int tid = threadIdx.x, tx = tid & 63;
    constexpr int T_AIN = 96 * 16, T_AOUT = 16 * 32, T_BIN = 36 * 16, T_BOUT = 256, T_CIN = 32 * 16, T_CG = 128, T_COUT = 256;
    for (int it = lo + w; it < hi; it += nw) {
        int r = it;
        if (r < 2 * T_AIN) {
            const int j = r / T_AIN; r -= j * T_AIN;
            const int nt = r >> 4, kt = r & 15, np = permcol(nt * 64 + tx);
            int col;
            const int T = np >> 7, w = np & 127;
            if (T < 32) {
                const int wc = w >> 6, jn = (w >> 4) & 3, i = w & 15;
                col = ((jn < 2) ? 0 : 4096) + 64 * T + 32 * wc + 16 * (jn & 1) + i;
            } else col = 2048 + (np - 4096);
            wt_tile(p.in[8] + (size_t)j * 1024 * 6144 + (size_t)(kt * 64) * 6144 + col, 6144,
                    (bf16_t*)(p.ws + W_A_IN) + (size_t)j * 6144 * 1024 + (size_t)(nt * 64) * 1024 + kt * 64, 1024, tile, tid);
            continue;
        }
        r -= 2 * T_AIN;
        if (r < 2 * T_AOUT) {
            const int j = r / T_AOUT; r -= j * T_AOUT;
            const int nt = r >> 5, kt = r & 31;
            wt_tile(p.in[13] + (size_t)j * 2048 * 1024 + (size_t)(kt * 64) * 1024 + permcol(nt * 64 + tx), 1024,
                    (bf16_t*)(p.ws + W_A_OUT) + (size_t)j * 1024 * 2048 + (size_t)(nt * 64) * 2048 + kt * 64, 2048, tile, tid);
            continue;
        }
        r -= 2 * T_AOUT;
        if (r < T_BIN) {
            const int nt = r >> 4, kt = r & 15;
            wt_tile(p.in[14] + (size_t)(kt * 64) * 2304 + permcol(nt * 64 + tx), 2304, (bf16_t*)(p.ws + W_B_IN) + (size_t)(nt * 64) * 1024 + kt * 64, 1024, tile, tid);
            continue;
        }
        r -= T_BIN;
        if (r < T_BOUT) {
            const int nt = r >> 4, kt = r & 15;
            wt_tile(p.in[16] + (size_t)(kt * 64) * 1024 + permcol(nt * 64 + tx), 1024, (bf16_t*)(p.ws + W_B_OUT) + (size_t)(nt * 64) * 1024 + kt * 64, 1024, tile, tid);
            continue;
        }
        r -= T_BOUT;
        if (r < T_CIN) {
            const int nt = r >> 4, kt = r & 15;
            wt_tile(p.in[17] + (size_t)(kt * 64) * 2048 + permcol(nt * 64 + tx), 2048, (bf16_t*)(p.ws + W_C_IN) + (size_t)(nt * 64) * 1024 + kt * 64, 1024, tile, tid);
            continue;
        }
        r -= T_CIN;
        if (r < T_CG) {
            const int blk = r >> 5, rr = r & 31, nt = rr >> 2, kt = rr & 3;
            const int np = permcol(nt * 64 + tx), j4 = np >> 7, w = np & 127, wc = w >> 6, jn = (w >> 4) & 3, i = w & 15;
            const int dl = 64 * j4 + 32 * wc + 16 * (jn & 1) + i;
            const float* src = ((jn < 2) ? p.in[20] : p.in[22]) + (size_t)blk * 65536;
            wt_tile(src + (size_t)(kt * 64) * 256 + dl, 256, (bf16_t*)(p.ws + W_C_G) + (size_t)blk * 512 * 256 + (size_t)(nt * 64) * 256 + kt * 64, 256, tile, tid);
            continue;
        }
        r -= T_CG;
        {
            const int nt = r >> 4, kt = r & 15;
            wt_tile(p.in[24 + 1] + (size_t)(kt * 64) * 1024 + permcol(nt * 64 + tx), 1024, (bf16_t*)(p.ws + W_C_OUT) + (size_t)(nt * 64) * 1024 + kt * 64, 1024, tile, tid);
        }
    }
}

__device__ __forceinline__ void prep_phase(const Params& p, unsigned char* smem) {
    const int tid = threadIdx.x;
    wt_jobs(p, smem, 0, WT_FIRST, blockIdx.x, gridDim.x);
    const int gt = blockIdx.x * NTHREADS + tid, gn = gridDim.x * NTHREADS;
    {
        bf16_t* wsa = (bf16_t*)(p.ws + W_WS_A);
        const float* src = p.in[11];
        for (int idx = gt; idx < 2 * 4 * 128 * 128 / 2; idx += gn) {
            const int e = idx * 2, t = (e >> 7) & 127, s = e & 127;
            const float a = (s <= t) ? src[e] : 0.f, b = (s + 1 <= t) ? src[e + 1] : 0.f;
            *(unsigned*)(wsa + e) = cvt_pk(a, b);
        }
    }
    if (gt < 1024) ((float*)(p.ws + W_SP))[gt] = log1pf(__expf(-p.in[24][gt]));
    {
        float* rt = (float*)(p.ws + W_ROPE);
        for (int idx = gt; idx < 8193 * 32; idx += gn) {
            const int pos = idx >> 5, i = idx & 31;
            const float ang = (float)pos * exp2f(-(float)i * (13.287712379549449f / 32.0f));
            double s, c;
            sincos_d((double)ang, s, c);
            rt[pos * 64 + i] = (float)c;
            rt[pos * 64 + 32 + i] = (float)s;
        }
    }
    norm_phase(nullptr, nullptr, 0, p.in[0], p.in[1], nullptr, false, nullptr, nullptr, p.in[6], (bf16_t*)(p.ws + W_H));
}

struct EpiUG {
    bf16_t* P;
    int T;
    __device__ __forceinline__ void operator()(f32x4 (&acc)[4][4], int m0, int n0, int wr, int wc, int lane) const {
        const int fr = lane & 15, fq = lane >> 4;
#pragma unroll
        for (int i = 0; i < 4; ++i) {
            const int m = m0 + wr * 64 + i * 16 + fr;
            const int ch = 64 * T + 32 * wc + 8 * fq;
            u32x4 w;
            {
                const f32x4 u = acc[i][0], g = acc[i][2];
                w.x = cvt_pk(gelu_silu(u.x, g.x), gelu_silu(u.y, g.y));
                w.y = cvt_pk(gelu_silu(u.z, g.z), gelu_silu(u.w, g.w));
            }
            {
                const f32x4 u = acc[i][1], g = acc[i][3];
                w.z = cvt_pk(gelu_silu(u.x, g.x), gelu_silu(u.y, g.y));
                w.w = cvt_pk(gelu_silu(u.z, g.z), gelu_silu(u.w, g.w));
            }
            *(u32x4*)(P + (size_t)m * 2048 + ch) = w;
        }
    }
};
struct EpiV {
    bf16_t* GVt;
    float* stats;
    int mt, tv;
    __device__ __forceinline__ void operator()(f32x4 (&acc)[4][4], int m0, int n0, int wr, int wc, int lane) const {
        const int fr = lane & 15, fq = lane >> 4;
#pragma unroll
        for (int i = 0; i < 4; ++i) {
            const int sl = wr * 64 + i * 16 + fq * 4;
            f32x4 sum = {0.f, 0.f, 0.f, 0.f}, sq = {0.f, 0.f, 0.f, 0.f};
#pragma unroll
            for (int jn = 0; jn < 4; ++jn) {
                const int ch = 128 * tv + wc * 64 + 32 * (jn >> 1) + perm32(16 * (jn & 1) + fr);
                f32x4 v = acc[i][jn];
                v.x = gelu_f(v.x); v.y = gelu_f(v.y); v.z = gelu_f(v.z); v.w = gelu_f(v.w);
                u32x2 w;
                w.x = cvt_pk(v.x, v.y);
                w.y = cvt_pk(v.z, v.w);
                *(u32x2*)(GVt + ((size_t)mt * 2048 + ch) * 128 + sl) = w;
                sum += v;
                sq += v * v;
            }
            sum.x = row16_sum(sum.x); sum.y = row16_sum(sum.y); sum.z = row16_sum(sum.z); sum.w = row16_sum(sum.w);
            sq.x = row16_sum(sq.x); sq.y = row16_sum(sq.y); sq.z = row16_sum(sq.z); sq.w = row16_sum(sq.w);
            if (fr == 0) {
                float* st = stats + (size_t)(m0 + sl) * 64 + (tv * 2 + wc) * 2;
                st[0] = sum.x; st[1] = sq.x;
                st[64] = sum.y; st[65] = sq.y;
                st[128] = sum.z; st[129] = sq.z;
                st[192] = sum.w; st[193] = sq.w;
            }
        }
    }
};

__device__ __forceinline__ void a_in_phase(const Params& p, int j, bf16_t* smem) {
    const bf16_t* H = (const bf16_t*)(p.ws + W_H);
    const bf16_t* Wt = (const bf16_t*)(p.ws + W_A_IN) + (size_t)j * 6144 * 1024;
    bf16_t* P = (bf16_t*)(p.ws + W_BUF1);
    bf16_t* GVt = (bf16_t*)(p.ws + W_BUF2);
    float* stats = (float*)(p.ws + W_STATS);
    Stage st;
    bool pre = false;
    for (int t = blockIdx.x; t < 129 * 48; t += gridDim.x) {
        const int mt = t / 48, nt = t % 48;
        const int tn = t + gridDim.x;
        const bool hn = tn < 129 * 48;
        const int m0n = (tn / 48) * 128, n0n = (tn % 48) * 128;
        if (nt < 32) {
            EpiUG e{P, nt};
            gemm_tile<true>(H, 1024, Wt, 1024, 1024, mt * 128, nt * 128, smem, e, st, pre, hn, H, Wt, m0n, n0n);
        } else {
            EpiV e{GVt, stats, mt, nt - 32};
            gemm_tile<false>(H, 1024, Wt, 1024, 1024, mt * 128, nt * 128, smem, e, st, pre, hn, H, Wt, m0n, n0n);
        }
        pre = hn;
    }
    if (j == 0) {
        const int busy = (129 * 48) % gridDim.x, idle = gridDim.x - busy;
        if (idle > 0 && (int)blockIdx.x >= busy) wt_jobs(p, (unsigned char*)smem, WT_FIRST, WT_TOTAL, blockIdx.x - busy, idle);
        else if (idle <= 0) wt_jobs(p, (unsigned char*)smem, WT_FIRST, WT_TOTAL, blockIdx.x, gridDim.x);
    }
}

__device__ __forceinline__ void a_mix_phase(const Params& p, int j, bf16_t* smem) {
    const int tid = threadIdx.x, wid = tid >> 6, lane = tid & 63, wr = wid >> 1, wc = wid & 1, fr = lane & 15, fq = lane >> 4;
    bf16_t* P = (bf16_t*)(p.ws + W_BUF1);
    const bf16_t* GVt = (const bf16_t*)(p.ws + W_BUF2);
    const float* stats = (const float*)(p.ws + W_STATS);
    const bf16_t* wsa = (const bf16_t*)(p.ws + W_WS_A) + (size_t)j * 4 * 128 * 128;
    const float* ln_g = p.in[9] + j * 2048;
    const float* ln_b = p.in[10] + j * 2048;
    const float* b_s = p.in[12] + j * 4 * 128;
    const float* w_s = p.in[11] + (size_t)j * 4 * 128 * 128;
    float* av_out = p.out + O_AV + (size_t)j * 128 * 2048;
    bf16_t* As = smem;
    bf16_t* Bs = smem + 16384;
    float* mu = (float*)(smem + 16384);
    float* rs = mu + 128;
    for (int it = blockIdx.x; it < 129 * 16; it += gridDim.x) {
        const int chunk = it >> 4, g = (it >> 2) & 3, slab = it & 3;
        const bool samp = (chunk == 128);
        f32x4 sv[8];
        {
            const float* stp = stats + (size_t)(chunk * 128 + (tid >> 1)) * 64 + (tid & 1) * 32;
#pragma unroll
            for (int k = 0; k < 8; ++k) sv[k] = *(const f32x4*)(stp + k * 4);
        }
        u32x4 araw[8], braw[8];
        float lg[8], lb[8];
        const float w00 = w_s[g * 16384];
        {
            const bf16_t* wg = wsa + g * 16384;
#pragma unroll
            for (int i = 0; i < 8; ++i) {
                const int c = tid + 256 * i, row = c >> 4, sc = c & 15;
                araw[i] = (u32x4){0u, 0u, 0u, 0u};
                if (!samp) araw[i] = *(const u32x4*)(wg + row * 128 + sc * 8);
                const int ch = g * 512 + slab * 128 + permcol(row);
                braw[i] = *(const u32x4*)(GVt + ((size_t)chunk * 2048 + ch) * 128 + sc * 8);
                lg[i] = ln_g[ch];
                lb[i] = ln_b[ch];
            }
        }
        float s = 0.f, q = 0.f;
#pragma unroll
        for (int k = 0; k < 8; ++k) { s += sv[k].x + sv[k].z; q += sv[k].y + sv[k].w; }
        s += __shfl_xor(s, 1);
        q += __shfl_xor(q, 1);
        const float mean = s * (1.f / 2048.f);
        const float var = fmaxf(q * (1.f / 2048.f) - mean * mean, 0.f);
        __syncthreads();
        if ((tid & 1) == 0) { mu[tid >> 1] = mean; rs[tid >> 1] = rsqrtf(var + 1e-5f); }
        if (samp) {
#pragma unroll
            for (int i = 0; i < 8; ++i) {
                const int c = tid + 256 * i, row = c >> 4, sc = c & 15;
                if ((row >> 3) == sc) {
                    const unsigned lo = cvt_pk(w00, 0.f), hi = cvt_pk(0.f, w00);
                    const int e = row & 7;
                    const unsigned val = (e & 1) ? hi : lo;
                    if ((e >> 1) == 0) araw[i].x = val; else if ((e >> 1) == 1) araw[i].y = val; else if ((e >> 1) == 2) araw[i].z = val; else araw[i].w = val;
                }
            }
        }
#pragma unroll
        for (int i = 0; i < 8; ++i) {
            const int c = tid + 256 * i, row = c >> 4, sc = c & 15;
            *(u32x4*)(As + (sc >> 2) * 4096 + row * 32 + swz(row, sc & 3)) = araw[i];
        }
        __syncthreads();
        float mur[8], rsr[8];
#pragma unroll
        for (int e = 0; e < 8; ++e) { mur[e] = mu[(tid & 15) * 8 + e]; rsr[e] = rs[(tid & 15) * 8 + e]; }
        __syncthreads();
#pragma unroll
        for (int i = 0; i < 8; ++i) {
            const int c = tid + 256 * i, n = c >> 4, sc = c & 15;
            const int ch = g * 512 + slab * 128 + permcol(n);
            const u32x4 v = braw[i];
            float x[8];
            x[0] = bf_lo(v.x); x[1] = bf_hi(v.x); x[2] = bf_lo(v.y); x[3] = bf_hi(v.y);
            x[4] = bf_lo(v.z); x[5] = bf_hi(v.z); x[6] = bf_lo(v.w); x[7] = bf_hi(v.w);
#pragma unroll
            for (int e = 0; e < 8; ++e) x[e] = (x[e] - mur[e]) * rsr[e] * lg[i] + lb[i];
            if (samp) {
#pragma unroll
                for (int e = 0; e < 8; ++e) av_out[(size_t)(sc * 8 + e) * 2048 + ch] = x[e];
            }
            u32x4 o;
            o.x = cvt_pk(x[0], x[1]); o.y = cvt_pk(x[2], x[3]); o.z = cvt_pk(x[4], x[5]); o.w = cvt_pk(x[6], x[7]);
            *(u32x4*)(Bs + (sc >> 2) * 4096 + n * 32 + swz(n, sc & 3)) = o;
        }
        __syncthreads();
        f32x4 acc[4][4];
#pragma unroll
        for (int i = 0; i < 4; ++i)
#pragma unroll
            for (int jn = 0; jn < 4; ++jn) acc[i][jn] = (f32x4){0.f, 0.f, 0.f, 0.f};
        u32x4 pvv[4][2];
#pragma unroll
        for (int i = 0; i < 4; ++i)
#pragma unroll
            for (int g2 = 0; g2 < 2; ++g2)
                pvv[i][g2] = *(const u32x4*)(P + (size_t)(chunk * 128 + wr * 64 + i * 16 + fr) * 2048 + g * 512 + slab * 128 + wc * 64 + 32 * g2 + 8 * fq);
        mma_stage<true>(As, Bs, 4096, 4096, acc, wr, wc, lane);
        mma_stage<true>(As + 8192, Bs + 8192, 4096, 4096, acc, wr, wc, lane);
#pragma unroll
        for (int i = 0; i < 4; ++i) {
            const int t = wr * 64 + i * 16 + fr;
            const float bs = b_s[g * 128 + (samp ? 0 : t)];
            const size_t rowoff = (size_t)(chunk * 128 + t) * 2048 + g * 512 + slab * 128;
#pragma unroll
            for (int g2 = 0; g2 < 2; ++g2) {
                bf16_t* pp = P + rowoff + wc * 64 + 32 * g2 + 8 * fq;
                const u32x4 pv = pvv[i][g2];
                const f32x4 a = acc[i][2 * g2], b = acc[i][2 * g2 + 1];
                u32x4 w;
                w.x = cvt_pk(bf_lo(pv.x) * (a.x + bs), bf_hi(pv.x) * (a.y + bs));
                w.y = cvt_pk(bf_lo(pv.y) * (a.z + bs), bf_hi(pv.y) * (a.w + bs));
                w.z = cvt_pk(bf_lo(pv.z) * (b.x + bs), bf_hi(pv.z) * (b.y + bs));
                w.w = cvt_pk(bf_lo(pv.w) * (b.z + bs), bf_hi(pv.w) * (b.w + bs));
                *(u32x4*)pp = w;
            }
        }
    }
}

struct EpiY {
    bf16_t* Yb;
    float* Yp;
    __device__ __forceinline__ void operator()(f32x4 (&acc)[4][4], int m0, int n0, int wr, int wc, int lane) const {
        const int fr = lane & 15, fq = lane >> 4;
        const bool part = (m0 == M_P);
#pragma unroll
        for (int i = 0; i < 4; ++i) {
            const int m = m0 + wr * 64 + i * 16 + fr;
#pragma unroll
            for (int g2 = 0; g2 < 2; ++g2) {
                const int n = n0 + wc * 64 + 32 * g2 + 8 * fq;
                const f32x4 a = acc[i][2 * g2], b = acc[i][2 * g2 + 1];
                if (part) {
                    float* o = Yp + (size_t)(m - M_P) * 1024 + n;
                    *(f32x4*)o = a;
                    *(f32x4*)(o + 4) = b;
                } else {
                    u32x4 w;
                    w.x = cvt_pk(a.x, a.y); w.y = cvt_pk(a.z, a.w); w.z = cvt_pk(b.x, b.y); w.w = cvt_pk(b.z, b.w);
                    *(u32x4*)(Yb + (size_t)m * 1024 + n) = w;
                }
            }
        }
    }
};
__device__ __forceinline__ void out_gemm_phase(const bf16_t* A, int K, const bf16_t* Wt, float* Y, float* Ypart, bf16_t* smem) {
    const int nsplit = K >> 8;
    const int ntile = 1024 + 8 * nsplit;
    Stage st;
    bool pre = false;
    for (int t = blockIdx.x; t < ntile; t += gridDim.x) {
        const bool full = t < 1024;
        const int u = t - 1024, ks = full ? 0 : (u >> 3);
        const int m0 = full ? (t >> 3) * 128 : M_P, n0 = (full ? (t & 7) : (u & 7)) * 128, Kt = full ? K : 256;
        const int tn = t + gridDim.x;
        const bool hn = tn < ntile, fulln = tn < 1024;
        const int un = tn - 1024, ksn = fulln ? 0 : (un >> 3);
        const int m0n = fulln ? (tn >> 3) * 128 : M_P, n0n = (fulln ? (tn & 7) : (un & 7)) * 128;
        EpiY e{(bf16_t*)Y, Ypart + (size_t)ks * 128 * 1024};
        gemm_tile<true>(A + ks * 256, K, Wt + ks * 256, K, Kt, m0, n0, smem, e, st, pre, hn, A + ksn * 256, Wt + ksn * 256, m0n, n0n);
        pre = hn;
    }
}

struct EpiSilu {
    bf16_t* O;
    int ldo, col0;
    __device__ __forceinline__ void operator()(f32x4 (&acc)[4][4], int m0, int n0, int wr, int wc, int lane) const {
        const int fr = lane & 15, fq = lane >> 4;
#pragma unroll
        for (int i = 0; i < 4; ++i) {
            const int m = m0 + wr * 64 + i * 16 + fr;
#pragma unroll
            for (int jn = 0; jn < 4; ++jn) {
                const f32x4 a = acc[i][jn];
                u32x2 w;
                w.x = cvt_pk(silu_f(a.x), silu_f(a.y));
                w.y = cvt_pk(silu_f(a.z), silu_f(a.w));
                *(u32x2*)(O + (size_t)m * ldo + col0 + wc * 64 + jn * 16 + fq * 4) = w;
            }
        }
    }
};
struct EpiCopy {
    bf16_t* O;
    int ldo, col0;
    __device__ __forceinline__ void operator()(f32x4 (&acc)[4][4], int m0, int n0, int wr, int wc, int lane) const {
        const int fr = lane & 15, fq = lane >> 4;
#pragma unroll
        for (int i = 0; i < 4; ++i) {
            const int m = m0 + wr * 64 + i * 16 + fr;
#pragma unroll
            for (int jn = 0; jn < 4; ++jn) {
                const f32x4 a = acc[i][jn];
                u32x2 w;
                w.x = cvt_pk(a.x, a.y);
                w.y = cvt_pk(a.z, a.w);
                *(u32x2*)(O + (size_t)m * ldo + col0 + wc * 64 + jn * 16 + fq * 4) = w;
            }
        }
    }
};
template <int isk> struct EpiRope {
    bf16_t* O;
    int ldo, col0;
    const float* rope;
    float* out;
    __device__ __forceinline__ void operator()(f32x4 (&acc)[4][4], int m0, int n0, int wr, int wc, int lane) const {
        const int fr = lane & 15, fq = lane >> 4;
#pragma unroll
        for (int i = 0; i < 4; ++i) {
            const int m = m0 + wr * 64 + i * 16 + fr;
            const int pos = (m < M_P) ? (m & (SEQ - 1)) : SEQ;
            const float* rt = rope + (size_t)pos * 64;
            const float scale = isk ? 1.0f : 0.125f;
#pragma unroll
            for (int jn = 0; jn < 2; ++jn) {
                const int d = jn * 16 + fq * 4;
                const f32x4 c = *(const f32x4*)(rt + d), s = *(const f32x4*)(rt + 32 + d);
                const f32x4 x1 = acc[i][jn], x2 = acc[i][jn + 2];
                const f32x4 o1 = (x1 * c - x2 * s) * scale, o2 = (x2 * c + x1 * s) * scale;
                u32x2 w1, w2;
                w1.x = cvt_pk(o1.x, o1.y); w1.y = cvt_pk(o1.z, o1.w);
                w2.x = cvt_pk(o2.x, o2.y); w2.y = cvt_pk(o2.z, o2.w);
                bf16_t* dst = O + (size_t)m * ldo + col0 + wc * 64 + d;
                *(u32x2*)dst = w1;
                *(u32x2*)(dst + 32) = w2;
                if (isk) {
                    if (m < M_P) {
                        const int t = m & (SEQ - 1), b = m >> 13;
                        if (t >= SEQ - 128) {
                            float* o = out + O_BKP + ((size_t)(b * 128 + t - (SEQ - 128)) * 2 + wc) * 64 + d;
                            *(f32x4*)o = o1;
                            *(f32x4*)(o + 32) = o2;
                        }
                    } else {
                        float* o = out + O_BKS + ((size_t)((m - M_P) * 128 + 127) * 2 + wc) * 64 + d;
                        *(f32x4*)o = o1;
                        *(f32x4*)(o + 32) = o2;
                    }
                }
            }
        }
    }
};
struct EpiVt {
    bf16_t* Vt;
    float* out;
    __device__ __forceinline__ void operator()(f32x4 (&acc)[4][4], int m0, int n0, int wr, int wc, int lane) const {
        const int fr = lane & 15, fq = lane >> 4;
#pragma unroll
        for (int i = 0; i < 4; ++i) {
            const int m = m0 + wr * 64 + i * 16 + fq * 4;
#pragma unroll
            for (int jn = 0; jn < 4; ++jn) {
                const int d = jn * 16 + fr;
                const f32x4 a = acc[i][jn];
                if (m < M_P) {
                    const int t = m & (SEQ - 1), b = m >> 13;
                    u32x2 w;
                    w.x = cvt_pk(a.x, a.y);
                    w.y = cvt_pk(a.z, a.w);
                    *(u32x2*)(Vt + ((size_t)(b * 2 + wc) * 64 + d) * SEQ + t) = w;
                    if (t >= SEQ - 128) {
                        float* o = out + O_BVP + ((size_t)(b * 128 + t - (SEQ - 128)) * 2 + wc) * 64 + d;
                        o[0] = a.x; o[128] = a.y; o[256] = a.z; o[384] = a.w;
                    }
                } else {
                    float* o = out + O_BVS + ((size_t)((m - M_P) * 128 + 127) * 2 + wc) * 64 + d;
                    o[0] = a.x; o[16384] = a.y; o[32768] = a.z; o[49152] = a.w;
                }
            }
        }
    }
};

struct EpiB {
    bf16_t *Q, *SG, *KV;
    const float* rope;
    float* out;
    int nt;
    __device__ __forceinline__ void operator()(f32x4 (&acc)[4][4], int m0, int n0, int wr, int wc, int lane) const {
        const int fr = lane & 15, fq = lane >> 4;
        if (nt < 9) {
            const bool isk = (nt == 8);
            const float scale = isk ? 1.0f : 0.125f;
#pragma unroll
            for (int i = 0; i < 4; ++i) {
                const int m = m0 + wr * 64 + i * 16 + fr;
                const int pos = (m < M_P) ? (m & (SEQ - 1)) : SEQ;
                const float* rt = rope + (size_t)pos * 64;
                const int d = 8 * fq;
                f32x4 o1[2], o2[2];
#pragma unroll
                for (int jl = 0; jl < 2; ++jl) {
                    const f32x4 c = *(const f32x4*)(rt + d + 4 * jl), s = *(const f32x4*)(rt + 32 + d + 4 * jl);
                    const f32x4 x1 = acc[i][jl], x2 = acc[i][jl + 2];
                    o1[jl] = (x1 * c - x2 * s) * scale;
                    o2[jl] = (x2 * c + x1 * s) * scale;
                }
                u32x4 w1, w2;
                w1.x = cvt_pk(o1[0].x, o1[0].y); w1.y = cvt_pk(o1[0].z, o1[0].w); w1.z = cvt_pk(o1[1].x, o1[1].y); w1.w = cvt_pk(o1[1].z, o1[1].w);
                w2.x = cvt_pk(o2[0].x, o2[0].y); w2.y = cvt_pk(o2[0].z, o2[0].w); w2.z = cvt_pk(o2[1].x, o2[1].y); w2.w = cvt_pk(o2[1].z, o2[1].w);
                bf16_t* dst = isk ? KV + (size_t)m * 256 + wc * 64 + d : Q + (size_t)m * 1024 + nt * 128 + wc * 64 + d;
                *(u32x4*)dst = w1;
                *(u32x4*)(dst + 32) = w2;
                if (isk) {
                    float* o = nullptr;
                    if (m < M_P) {
                        const int t = m & (SEQ - 1), b = m >> 13;
                        if (t >= SEQ - 128) o = out + O_BKP + ((size_t)(b * 128 + t - (SEQ - 128)) * 2 + wc) * 64 + d;
                    } else o = out + O_BKS + ((size_t)((m - M_P) * 128 + 127) * 2 + wc) * 64 + d;
                    if (o) { *(f32x4*)o = o1[0]; *(f32x4*)(o + 4) = o1[1]; *(f32x4*)(o + 32) = o2[0]; *(f32x4*)(o + 36) = o2[1]; }
                }
            }
        } else if (nt == 9) {
#pragma unroll
            for (int i = 0; i < 4; ++i) {
                const int m = m0 + wr * 64 + i * 16 + fr;
                float* o = nullptr;
                if (m < M_P) {
                    const int t = m & (SEQ - 1), b = m >> 13;
                    if (t >= SEQ - 128) o = out + O_BVP + ((size_t)(b * 128 + t - (SEQ - 128)) * 2 + wc) * 64;
                } else o = out + O_BVS + ((size_t)((m - M_P) * 128 + 127) * 2 + wc) * 64;
#pragma unroll
                for (int g2 = 0; g2 < 2; ++g2) {
                    const int d = 32 * g2 + 8 * fq;
                    const f32x4 a = acc[i][2 * g2], b = acc[i][2 * g2 + 1];
                    u32x4 w;
                    w.x = cvt_pk(a.x, a.y); w.y = cvt_pk(a.z, a.w); w.z = cvt_pk(b.x, b.y); w.w = cvt_pk(b.z, b.w);
                    *(u32x4*)(KV + (size_t)m * 256 + 128 + wc * 64 + d) = w;
                    if (o) { *(f32x4*)(o + d) = a; *(f32x4*)(o + d + 4) = b; }
                }
            }
        } else {
#pragma unroll
            for (int i = 0; i < 4; ++i) {
                const int m = m0 + wr * 64 + i * 16 + fr;
#pragma unroll
                for (int g2 = 0; g2 < 2; ++g2) {
                    const f32x4 a = acc[i][2 * g2], b = acc[i][2 * g2 + 1];
                    u32x4 w;
                    w.x = cvt_pk(silu_f(a.x), silu_f(a.y)); w.y = cvt_pk(silu_f(a.z), silu_f(a.w));
                    w.z = cvt_pk(silu_f(b.x), silu_f(b.y)); w.w = cvt_pk(silu_f(b.z), silu_f(b.w));
                    *(u32x4*)(SG + (size_t)m * 1024 + (nt - 10) * 128 + wc * 64 + 32 * g2 + 8 * fq) = w;
                }
            }
        }
    }
};

__device__ __forceinline__ void b_in_phase(const Params& p, bf16_t* smem) {
    const bf16_t* H = (const bf16_t*)(p.ws + W_H);
    const bf16_t* Wt = (const bf16_t*)(p.ws + W_B_IN);
    bf16_t* Q = (bf16_t*)(p.ws + W_BUF1);
    bf16_t* SG = Q + (size_t)MT * 1024;
    bf16_t* KV = (bf16_t*)(p.ws + W_KB);
    const float* rope = (const float*)(p.ws + W_ROPE);
    Stage st;
    bool pre = false;
    for (int t = blockIdx.x; t < 129 * 18; t += gridDim.x) {
        const int mt = t < 2064 ? (t >> 4) : ((t - 2064) >> 1), nt = t < 2064 ? (t & 15) : 16 + ((t - 2064) & 1);
        const int tn = t + gridDim.x;
        const bool hn = tn < 129 * 18;
        const int mtn = tn < 2064 ? (tn >> 4) : ((tn - 2064) >> 1), ntn = tn < 2064 ? (tn & 15) : 16 + ((tn - 2064) & 1);
        EpiB e{Q, SG, KV, rope, p.out, nt};
        gemm_tile<true>(H, 1024, Wt, 1024, 1024, mt * 128, nt * 128, smem, e, st, pre, hn, H, Wt, mtn * 128, ntn * 128);
        pre = hn;
    }
}

constexpr int VT_LD = 256;
__device__ __forceinline__ void attn_prompt_item(const Params& p, int item, bf16_t* smem) {
    const int tid = threadIdx.x, w = tid >> 6, lane = tid & 63, fr = lane & 15, fq = lane >> 4;
    const int half = item & 1, kvh = (item >> 1) & 1, nb = (item >> 2) & 63, b = item >> 8;
    const bf16_t* Q = (const bf16_t*)(p.ws + W_BUF1);
    const bf16_t* SG = Q + (size_t)MT * 1024;
    const bf16_t* KV = (const bf16_t*)(p.ws + W_KB);
    bf16_t* Z = (bf16_t*)(p.ws + W_H);
    bf16_t* Ks = smem;
    bf16_t* Vs = smem + 16384;
    const int row0 = b * SEQ + nb * 128;
    u32x4 kraw[8], vraw[8];
#pragma unroll
    for (int i = 0; i < 8; ++i) {
        const int c = tid + 256 * i, key = c >> 3, kc = c & 7;
        kraw[i] = (u32x4){0u, 0u, 0u, 0u};
        vraw[i] = (u32x4){0u, 0u, 0u, 0u};
        if (nb > 0 || key >= 128) {
            const bf16_t* src_row = KV + (size_t)(row0 - 128 + key) * 256 + kvh * 64 + kc * 8;
            kraw[i] = *(const u32x4*)src_row;
            vraw[i] = *(const u32x4*)(src_row + 128);
        }
    }
    __syncthreads();
#pragma unroll
    for (int i = 0; i < 8; ++i) {
        const int c = tid + 256 * i, key = c >> 3, kc = c & 7;
        *(u32x4*)(Ks + (kc >> 2) * 8192 + key * 32 + swz(key, kc & 3)) = kraw[i];
    }
#pragma unroll
    for (int i = 0; i < 8; ++i) {
        const int c = tid + 256 * i, key = c >> 3, dc = c & 7;
        const unsigned wv[4] = {vraw[i].x, vraw[i].y, vraw[i].z, vraw[i].w};
#pragma unroll
        for (int e = 0; e < 8; ++e) {
            const int d = dc * 8 + e;
            const unsigned short hv = (e & 1) ? (unsigned short)(wv[e >> 1] >> 16) : (unsigned short)(wv[e >> 1] & 0xffff);
            Vs[d * VT_LD + (((key >> 3) ^ ((d & 15) << 1)) << 3) + (key & 7)] = hv;
        }
    }
    __syncthreads();
    const int co = swz(fr, fq);
#pragma unroll 1
    for (int gq = half * 8; gq < half * 8 + 8; ++gq) {
        const int g = gq >> 1, qt = gq & 1;
        const int h = kvh * 8 + g;
        const float sink = p.in[15][h];
        const int qi = 32 * w + 16 * qt + fr;
        bf16x8 qf[2];
#pragma unroll
        for (int kk = 0; kk < 2; ++kk)
            qf[kk] = *(const bf16x8*)(Q + (size_t)(row0 + qi) * 1024 + h * 64 + kk * 32 + fq * 8);
        f32x4 s[10];
#pragma unroll
        for (int kt = 0; kt < 10; ++kt) s[kt] = (f32x4){0.f, 0.f, 0.f, 0.f};
#pragma unroll
        for (int kt = 0; kt < 10; ++kt) {
#pragma unroll
            for (int kk = 0; kk < 2; ++kk) {
                const bf16x8 kf = *(const bf16x8*)(Ks + kk * 8192 + (16 * (2 * w + kt) + fr) * 32 + co);
                s[kt] = __builtin_amdgcn_mfma_f32_16x16x32_bf16(kf, qf[kk], s[kt], 0, 0, 0);
            }
            if (kt & 1) __builtin_amdgcn_sched_barrier(0);
        }
        float mx = sink;
#pragma unroll
        for (int kt = 0; kt < 10; ++kt) {
            const int key0 = 16 * (2 * w + kt) + fq * 4;
#pragma unroll
            for (int r = 0; r < 4; ++r) {
                const int key = key0 + r;
                const bool valid = (key >= qi) && (key <= qi + 128) && (nb > 0 || key >= 128);
                const float v = valid ? s[kt][r] : -1e30f;
                s[kt][r] = v;
                mx = fmaxf(mx, v);
            }
        }
        mx = fmaxf(mx, __shfl_xor(mx, 16));
        mx = fmaxf(mx, __shfl_xor(mx, 32));
        float sum = 0.f;
#pragma unroll
        for (int kt = 0; kt < 10; ++kt)
#pragma unroll
            for (int r = 0; r < 4; ++r) {
                const float e = __expf(s[kt][r] - mx);
                s[kt][r] = e;
                sum += e;
            }
        sum += __shfl_xor(sum, 16);
        sum += __shfl_xor(sum, 32);
        const float inv = __builtin_amdgcn_rcpf(sum + __expf(sink - mx));
        u32x2 sgv[4];
#pragma unroll
        for (int dt = 0; dt < 4; ++dt) sgv[dt] = *(const u32x2*)(SG + (size_t)(row0 + qi) * 1024 + h * 64 + 16 * dt + fq * 4);
        f32x4 o[4];
#pragma unroll
        for (int dt = 0; dt < 4; ++dt) o[dt] = (f32x4){0.f, 0.f, 0.f, 0.f};
#pragma unroll
        for (int ks = 0; ks < 5; ++ks) {
            u32x4 pw;
            pw.x = cvt_pk(s[2 * ks][0], s[2 * ks][1]);
            pw.y = cvt_pk(s[2 * ks][2], s[2 * ks][3]);
            pw.z = cvt_pk(s[2 * ks + 1][0], s[2 * ks + 1][1]);
            pw.w = cvt_pk(s[2 * ks + 1][2], s[2 * ks + 1][3]);
            const bf16x8 pf = __builtin_bit_cast(bf16x8, pw);
            const int kc0 = (((2 * w + 2 * ks) ^ fr) << 4) + fq * 4, kc1 = (((2 * w + 2 * ks + 1) ^ fr) << 4) + fq * 4;
#pragma unroll
            for (int dt = 0; dt < 4; ++dt) {
                const bf16_t* vp = Vs + (16 * dt + fr) * VT_LD;
                u32x4 vw;
                const u32x2 v0 = *(const u32x2*)(vp + kc0), v1 = *(const u32x2*)(vp + kc1);
                vw.x = v0.x; vw.y = v0.y; vw.z = v1.x; vw.w = v1.y;
                const bf16x8 vf = __builtin_bit_cast(bf16x8, vw);
                o[dt] = __builtin_amdgcn_mfma_f32_16x16x32_bf16(vf, pf, o[dt], 0, 0, 0);
            }
            __builtin_amdgcn_sched_barrier(0);
        }
        const size_t ro = (size_t)(row0 + qi) * 1024 + h * 64;
#pragma unroll
        for (int dt = 0; dt < 4; ++dt) {
            const int d = 16 * dt + fq * 4;
            const u32x2 sg = sgv[dt];
            const f32x4 ov = o[dt] * inv;
            u32x2 wv;
            wv.x = cvt_pk(ov.x * bf_lo(sg.x), ov.y * bf_hi(sg.x));
            wv.y = cvt_pk(ov.z * bf_lo(sg.y), ov.w * bf_hi(sg.y));
            *(u32x2*)(Z + ro + d) = wv;
        }
    }
}

__device__ __forceinline__ void attn_sample_item(const Params& p, int item, unsigned char* smem_raw) {
    const int tid = threadIdx.x, g = tid >> 5, l = tid & 31;
    const int kvh = item & 1, b = item >> 1;
    const bf16_t* Q = (const bf16_t*)(p.ws + W_BUF1);
    const bf16_t* SG = Q + (size_t)MT * 1024;
    bf16_t* Z = (bf16_t*)(p.ws + W_H);
    float* kv = (float*)smem_raw;
    float* qs = kv + 129 * 65;
    float* ps = qs + 512;
    const float* ck = p.in[2];
    const float* cv = p.in[3];
    float* oks = p.out + O_BKS;
    float* ovs = p.out + O_BVS;
    const int row = M_P + b;
    f32x4 knew = {0.f, 0.f, 0.f, 0.f}, vnew = {0.f, 0.f, 0.f, 0.f};
    if (tid < 16) knew = *(const f32x4*)(oks + ((size_t)(b * 128 + 127) * 2 + kvh) * 64 + tid * 4);
    const float q0 = bf2f(Q[(size_t)row * 1024 + kvh * 512 + tid]), q1 = bf2f(Q[(size_t)row * 1024 + kvh * 512 + 256 + tid]);
    __syncthreads();
#pragma unroll 1
    for (int hb = 0; hb < 2; ++hb) {
        f32x4 kreg[4];
#pragma unroll
        for (int i = 0; i < 4; ++i) {
            const int c = tid + 256 * (hb * 4 + i), key = c >> 4, d4 = (c & 15) * 4;
            kreg[i] = *(const f32x4*)(ck + ((size_t)(b * 128 + key) * 2 + kvh) * 64 + d4);
        }
#pragma unroll
        for (int i = 0; i < 4; ++i) {
            const int c = tid + 256 * (hb * 4 + i), key = c >> 4, d4 = (c & 15) * 4;
            if (key >= 1) *(f32x4*)(oks + ((size_t)(b * 128 + key - 1) * 2 + kvh) * 64 + d4) = kreg[i];
            float* kp = kv + key * 65 + d4;
            kp[0] = kreg[i].x; kp[1] = kreg[i].y; kp[2] = kreg[i].z; kp[3] = kreg[i].w;
        }
    }
    if (tid < 16) { float* kp = kv + 128 * 65 + tid * 4; kp[0] = knew.x; kp[1] = knew.y; kp[2] = knew.z; kp[3] = knew.w; }
    qs[tid] = q0;
    qs[256 + tid] = q1;
    if (tid < 16) vnew = *(const f32x4*)(ovs + ((size_t)(b * 128 + 127) * 2 + kvh) * 64 + tid * 4);
    __syncthreads();
    const int h = kvh * 8 + g;
    const float sink = p.in[15][h];
    float sc[5];
    float mx = sink;
#pragma unroll
    for (int i = 0; i < 5; ++i) {
        const int key = l + 32 * i;
        float a = -1e30f;
        if (key < 129) {
            a = 0.f;
#pragma unroll 8
            for (int d = 0; d < 64; ++d) a += qs[g * 64 + d] * kv[key * 65 + d];
        }
        sc[i] = a;
        mx = fmaxf(mx, a);
    }
#pragma unroll
    for (int o = 1; o < 32; o <<= 1) mx = fmaxf(mx, __shfl_xor(mx, o));
    float sum = 0.f;
#pragma unroll
    for (int i = 0; i < 5; ++i) {
        const int key = l + 32 * i;
        const float e = (key < 129) ? __expf(sc[i] - mx) : 0.f;
        sc[i] = e;
        sum += e;
    }
#pragma unroll
    for (int o = 1; o < 32; o <<= 1) sum += __shfl_xor(sum, o);
    const float inv = __builtin_amdgcn_rcpf(sum + __expf(sink - mx));
#pragma unroll
    for (int i = 0; i < 5; ++i) {
        const int key = l + 32 * i;
        if (key < 129) ps[g * 132 + key] = sc[i] * inv;
    }
    __syncthreads();
#pragma unroll 1
    for (int hb = 0; hb < 2; ++hb) {
        f32x4 vreg[4];
#pragma unroll
        for (int i = 0; i < 4; ++i) {
            const int c = tid + 256 * (hb * 4 + i), key = c >> 4, d4 = (c & 15) * 4;
            vreg[i] = *(const f32x4*)(cv + ((size_t)(b * 128 + key) * 2 + kvh) * 64 + d4);
        }
#pragma unroll
        for (int i = 0; i < 4; ++i) {
            const int c = tid + 256 * (hb * 4 + i), key = c >> 4, d4 = (c & 15) * 4;
            if (key >= 1) *(f32x4*)(ovs + ((size_t)(b * 128 + key - 1) * 2 + kvh) * 64 + d4) = vreg[i];
            float* kp = kv + key * 65 + d4;
            kp[0] = vreg[i].x; kp[1] = vreg[i].y; kp[2] = vreg[i].z; kp[3] = vreg[i].w;
        }
    }
    if (tid < 16) { float* kp = kv + 128 * 65 + tid * 4; kp[0] = vnew.x; kp[1] = vnew.y; kp[2] = vnew.z; kp[3] = vnew.w; }
    __syncthreads();
    float o0 = 0.f, o1 = 0.f;
#pragma unroll 8
    for (int key = 0; key < 129; ++key) {
        const float pv = ps[g * 132 + key];
        o0 += pv * kv[key * 65 + l];
        o1 += pv * kv[key * 65 + l + 32];
    }
    const size_t ro = (size_t)row * 1024 + h * 64;
    Z[ro + l] = (bf16_t)(cvt_pk(o0 * bf2f(SG[ro + l]), 0.f) & 0xffff);
    Z[ro + l + 32] = (bf16_t)(cvt_pk(o1 * bf2f(SG[ro + l + 32]), 0.f) & 0xffff);
}

__device__ __forceinline__ void b_attn_phase(const Params& p, unsigned char* smem_raw) {
    for (int it = blockIdx.x; it < 768; it += gridDim.x) {
        if (it < 512) attn_prompt_item(p, it, (bf16_t*)smem_raw);
        else attn_sample_item(p, it - 512, smem_raw);
    }
}

struct EpiAct {
    bf16_t* XR;
    int ldo, col0, act;
    __device__ __forceinline__ void operator()(f32x4 (&acc)[4][4], int m0, int n0, int wr, int wc, int lane) const {
        const int fr = lane & 15, fq = lane >> 4;
        bf16_t* O = act ? XR + (size_t)MT * 1024 - 1024 : XR;
#pragma unroll
        for (int i = 0; i < 4; ++i) {
            const int m = m0 + wr * 64 + i * 16 + fr;
#pragma unroll
            for (int g2 = 0; g2 < 2; ++g2) {
                f32x4 a = acc[i][2 * g2], b = acc[i][2 * g2 + 1];
                if (act) {
                    a.x = silu_f(a.x); a.y = silu_f(a.y); a.z = silu_f(a.z); a.w = silu_f(a.w);
                    b.x = silu_f(b.x); b.y = silu_f(b.y); b.z = silu_f(b.z); b.w = silu_f(b.w);
                }
                u32x4 w;
                w.x = cvt_pk(a.x, a.y); w.y = cvt_pk(a.z, a.w); w.z = cvt_pk(b.x, b.y); w.w = cvt_pk(b.z, b.w);
                *(u32x4*)(O + (size_t)m * ldo + col0 + wc * 64 + 32 * g2 + 8 * fq) = w;
            }
        }
    }
};
__device__ __forceinline__ void c_in_phase(const Params& p, bf16_t* smem) {
    const bf16_t* H = (const bf16_t*)(p.ws + W_H);
    const bf16_t* Wt = (const bf16_t*)(p.ws + W_C_IN);
    bf16_t* XR = (bf16_t*)(p.ws + W_BUF1);
    bf16_t* SG = XR + (size_t)MT * 1024;
    Stage st;
    bool pre = false;
    for (int t = blockIdx.x; t < 129 * 16; t += gridDim.x) {
        const int mt = t >> 4, nt = t & 15;
        const int tn = t + gridDim.x;
        const bool hn = tn < 129 * 16;
        EpiAct e{XR, 1024, nt * 128, nt >= 8};
        gemm_tile<true>(H, 1024, Wt, 1024, 1024, mt * 128, nt * 128, smem, e, st, pre, hn, H, Wt, (tn >> 4) * 128, (tn & 15) * 128);
        pre = hn;
    }
}

__device__ __forceinline__ void unpack8(const u32x4 v, float (&x)[8]) {
    x[0] = bf_lo(v.x); x[1] = bf_hi(v.x); x[2] = bf_lo(v.y); x[3] = bf_hi(v.y);
    x[4] = bf_lo(v.z); x[5] = bf_hi(v.z); x[6] = bf_lo(v.w); x[7] = bf_hi(v.w);
}

__device__ __forceinline__ void c_conv_phase(const Params& p) {
    const bf16_t* XR = (const bf16_t*)(p.ws + W_BUF1);
    bf16_t* XC = (bf16_t*)(p.ws + W_H);
    const float* cw = p.in[18];
    const float* cb = p.in[19];
    const float* st = p.in[4];
    const int gt = blockIdx.x * NTHREADS + threadIdx.x, gn = gridDim.x * NTHREADS;
    const int c0 = (gt & 127) * 8;
    float w0[8], w1[8], w2[8], w3[8], bias[8];
#pragma unroll
    for (int e = 0; e < 8; ++e) {
        w0[e] = cw[c0 + e]; w1[e] = cw[1024 + c0 + e]; w2[e] = cw[2048 + c0 + e]; w3[e] = cw[3072 + c0 + e]; bias[e] = cb[c0 + e];
    }
    for (int run = gt >> 7; run < M_P / 8; run += gn >> 7) {
        const int r0 = run * 8, t0 = r0 & (SEQ - 1), b = r0 >> 13;
        u32x4 raw[11];
#pragma unroll
        for (int q = 0; q < 11; ++q) {
            raw[q] = (u32x4){0u, 0u, 0u, 0u};
            if (q >= 3 || t0 > 0) raw[q] = *(const u32x4*)(XR + (size_t)(r0 - 3 + q) * 1024 + c0);
        }
        float x0[8], x1[8], x2[8], x3[8];
        unpack8(raw[0], x0); unpack8(raw[1], x1); unpack8(raw[2], x2);
#pragma unroll
        for (int q = 0; q < 8; ++q) {
            unpack8(raw[q + 3], x3);
            float acc[8];
#pragma unroll
            for (int e = 0; e < 8; ++e) acc[e] = bias[e] + x0[e] * w0[e] + x1[e] * w1[e] + x2[e] * w2[e] + x3[e] * w3[e];
            u32x4 o;
            o.x = cvt_pk(acc[0], acc[1]); o.y = cvt_pk(acc[2], acc[3]); o.z = cvt_pk(acc[4], acc[5]); o.w = cvt_pk(acc[6], acc[7]);
            *(u32x4*)(XC + (size_t)(r0 + q) * 1024 + c0) = o;
            const int t = t0 + q;
            if (t >= SEQ - 3) {
                float* oo = p.out + O_CCP + ((size_t)b * 3 + (t - (SEQ - 3))) * 1024 + c0;
#pragma unroll
                for (int e = 0; e < 8; ++e) oo[e] = x3[e];
            }
#pragma unroll
            for (int e = 0; e < 8; ++e) { x0[e] = x1[e]; x1[e] = x2[e]; x2[e] = x3[e]; }
        }
    }
    for (int b = gt >> 7; b < M_S; b += gn >> 7) {
        const int row = M_P + b;
        float xv[8], acc[8];
        unpack8(*(const u32x4*)(XR + (size_t)row * 1024 + c0), xv);
#pragma unroll
        for (int e = 0; e < 8; ++e) {
            const float s0 = st[((size_t)b * 3 + 0) * 1024 + c0 + e], s1 = st[((size_t)b * 3 + 1) * 1024 + c0 + e], s2 = st[((size_t)b * 3 + 2) * 1024 + c0 + e];
            acc[e] = bias[e] + s0 * w0[e] + s1 * w1[e] + s2 * w2[e] + xv[e] * w3[e];
            p.out[O_CCS + ((size_t)b * 3 + 0) * 1024 + c0 + e] = s1;
            p.out[O_CCS + ((size_t)b * 3 + 1) * 1024 + c0 + e] = s2;
            p.out[O_CCS + ((size_t)b * 3 + 2) * 1024 + c0 + e] = xv[e];
        }
        u32x4 o;
        o.x = cvt_pk(acc[0], acc[1]); o.y = cvt_pk(acc[2], acc[3]); o.z = cvt_pk(acc[4], acc[5]); o.w = cvt_pk(acc[6], acc[7]);
        *(u32x4*)(XC + (size_t)row * 1024 + c0) = o;
    }
}

struct EpiGate {
    const bf16_t* XC;
    float* Aa;
    bf16_t* Bb;
    const float *b_a, *b_x, *lam;
    int blk, nt;
    float* lds;
    float* carry;
    __device__ __forceinline__ void operator()(f32x4 (&acc)[4][4], int m0, int n0, int wr, int wc, int lane) const {
        const int fr = lane & 15, fq = lane >> 4;
        const bool prompt = (m0 < M_P);
#pragma unroll
        for (int jn = 0; jn < 2; ++jn) {
            const int cl = 32 * wc + 8 * fq + 4 * jn;
            const int d = blk * 256 + 64 * nt + cl;
            const f32x4 ba = *(const f32x4*)(b_a + d), bx = *(const f32x4*)(b_x + d), sp = *(const f32x4*)(lam + d);
#pragma unroll
            for (int i = 0; i < 4; ++i) {
                const int rl = wr * 64 + i * 16 + fr, m = m0 + rl;
                const bool first = (m < M_P) && ((m & (SEQ - 1)) == 0);
                const u32x2 xw = *(const u32x2*)(XC + (size_t)m * 1024 + d);
                const f32x4 xc = {bf_lo(xw.x), bf_hi(xw.x), bf_lo(xw.y), bf_hi(xw.y)};
                const f32x4 ra = acc[i][jn] + ba, ia = acc[i][jn + 2] + bx;
                f32x4 av, bv;
#pragma unroll
                for (int r = 0; r < 4; ++r) {
                    const float rg = sigmoid_f(ra[r]), ig = sigmoid_f(ia[r]);
                    const float la = -8.0f * rg * sp[r];
                    const float a = __expf(la);
                    av[r] = a;
                    const float mult = first ? 1.0f : __builtin_amdgcn_sqrtf(fmaxf(1.0f - a * a, 0.f));
                    bv[r] = mult * (ig * xc[r]);
                }
                u32x2 ow;
                ow.x = cvt_pk(1.0f - av.x, 1.0f - av.y);
                ow.y = cvt_pk(1.0f - av.z, 1.0f - av.w);
                *(u32x2*)((bf16_t*)Aa + (size_t)m * 1024 + d) = ow;
                av = (f32x4){1.0f - bf_lo(ow.x), 1.0f - bf_hi(ow.x), 1.0f - bf_lo(ow.y), 1.0f - bf_hi(ow.y)};
                u32x2 w;
                w.x = cvt_pk(bv.x, bv.y);
                w.y = cvt_pk(bv.z, bv.w);
                *(u32x2*)(Bb + (size_t)m * 1024 + d) = w;
                if (prompt) {
                    *(f32x4*)(lds + rl * 64 + cl) = av;
                    *(f32x4*)(lds + 8192 + rl * 64 + cl) = (f32x4){bf_lo(w.x), bf_hi(w.x), bf_lo(w.y), bf_hi(w.y)};
                }
            }
        }
        __syncthreads();
        if (prompt && threadIdx.x < 64) {
            float A = 1.f, h = 0.f;
#pragma unroll 16
            for (int r = 0; r < 128; ++r) {
                const float a = lds[r * 64 + threadIdx.x], b = lds[8192 + r * 64 + threadIdx.x];
                A *= a;
                h = a * h + b;
            }
            const int chunk = m0 >> 7, d = blk * 256 + 64 * nt + threadIdx.x;
            carry[(size_t)chunk * 2048 + d] = A;
            carry[(size_t)chunk * 2048 + 1024 + d] = h;
        }
    }
};

__device__ __forceinline__ void c_gate_phase(const Params& p, bf16_t* smem) {
    const bf16_t* XC = (const bf16_t*)(p.ws + W_H);
    const bf16_t* Wg = (const bf16_t*)(p.ws + W_C_G);
    float* Aa = (float*)(p.ws + W_BUF2);
    bf16_t* Bb = (bf16_t*)(p.ws + W_BUF1);
    Stage st;
    bool pre = false;
    for (int t = blockIdx.x; t < 129 * 16; t += gridDim.x) {
        const int mt = t >> 4, blk = (t >> 2) & 3, nt = t & 3;
        const int tn = t + gridDim.x, blkn = (tn >> 2) & 3;
        const bool hn = tn < 129 * 16;
        EpiGate e{XC, Aa, Bb, p.in[21], p.in[23], (const float*)(p.ws + W_SP), blk, nt, (float*)smem, (float*)(p.ws + W_CARRY)};
        gemm_tile<true>(XC + blk * 256, 1024, Wg + (size_t)blk * 512 * 256, 256, 256, mt * 128, nt * 128, smem, e, st, pre, hn,
                        XC + blkn * 256, Wg + (size_t)blkn * 512 * 256, (tn >> 4) * 128, (tn & 3) * 128);
        pre = hn;
    }
}

__device__ __forceinline__ void c_scan1_phase(const Params& p) {
    const float* Aa = (const float*)(p.ws + W_BUF2);
    const bf16_t* Bb = (const bf16_t*)(p.ws + W_BUF1);
    float* carry = (float*)(p.ws + W_CARRY);
    for (int it = blockIdx.x; it < 512; it += gridDim.x) {
        const int chunk = it >> 2, d = (it & 3) * 256 + threadIdx.x;
        float A = 1.f, h = 0.f;
        const size_t base = (size_t)chunk * 128 * 1024 + d;
#pragma unroll 8
        for (int r = 0; r < 128; ++r) {
            const float a = 1.0f - bf2f(((const bf16_t*)Aa)[base + (size_t)r * 1024]), b = bf2f(Bb[base + (size_t)r * 1024]);
            A *= a;
            h = a * h + b;
        }
        carry[(size_t)chunk * 2048 + d] = A;
        carry[(size_t)chunk * 2048 + 1024 + d] = h;
    }
}

__device__ __forceinline__ void c_scan2_phase(const Params& p) {
    const float* Aa = (const float*)(p.ws + W_BUF2);
    const bf16_t* Bb = (const bf16_t*)(p.ws + W_BUF1);
    const bf16_t* SG = Bb + (size_t)MT * 1024;
    const float* carry = (const float*)(p.ws + W_CARRY);
    bf16_t* Z = (bf16_t*)(p.ws + W_H);
    for (int it = blockIdx.x; it < 512 + 512; it += gridDim.x) {
        if (it < 512) {
            const int chunk = it >> 2, d = (it & 3) * 256 + threadIdx.x;
            const int b = chunk >> 6, ci = chunk & 63;
            float h = 0.f;
            {
                const float* c0 = carry + (size_t)(b * 64) * 2048 + d;
                int jc = 0;
                for (; jc + 16 <= ci; jc += 16) {
                    float ca[16], ch[16];
#pragma unroll
                    for (int q = 0; q < 16; ++q) { ca[q] = c0[(size_t)(jc + q) * 2048]; ch[q] = c0[(size_t)(jc + q) * 2048 + 1024]; }
#pragma unroll
                    for (int q = 0; q < 16; ++q) h = ca[q] * h + ch[q];
                }
                for (; jc < ci; ++jc) h = c0[(size_t)jc * 2048] * h + c0[(size_t)jc * 2048 + 1024];
            }
            const size_t base = (size_t)chunk * 128 * 1024 + d;
for (int r0 = 0; r0 < 128; r0 += 32) {
                float av[32];
                bf16_t bv[32], sv[32];
#pragma unroll
                for (int q = 0; q < 32; ++q) {
                    const size_t o = base + (size_t)(r0 + q) * 1024;
                    av[q] = 1.0f - bf2f(((const bf16_t*)Aa)[o]); bv[q] = Bb[o]; sv[q] = SG[o];
                }
#pragma unroll
                for (int q = 0; q < 32; ++q) {
                    h = av[q] * h + bf2f(bv[q]);
                    Z[base + (size_t)(r0 + q) * 1024] = (bf16_t)(cvt_pk(h * bf2f(sv[q]), 0.f) & 0xffff);
                }
            }
            if (ci == 63) p.out[O_CHP + (size_t)b * 1024 + d] = h;
        } else {
            const int s = it - 512, d = (s & 3) * 256 + threadIdx.x, b = s >> 2;
            const size_t o = (size_t)(M_P + b) * 1024 + d;
            const float h = (1.0f - bf2f(((const bf16_t*)Aa)[o])) * p.in[5][(size_t)b * 1024 + d] + bf2f(Bb[o]);
            Z[o] = (bf16_t)(cvt_pk(h * bf2f(SG[o]), 0.f) & 0xffff);
            p.out[O_CHS + (size_t)b * 1024 + d] = h;
        }
    }
}

constexpr int N_PHASES = 20;

__device__ __forceinline__ void run_phase(const Params& p, int ph, unsigned char* smem_raw) {
    bf16_t* smem = (bf16_t*)smem_raw;
    float* Y = (float*)(p.ws + W_BUF2);
    float* YP = (float*)(p.ws + W_YPART);
    float* X = p.out + O_X;
    bf16_t* XB = (bf16_t*)(p.ws + W_XB);
    bf16_t* H = (bf16_t*)(p.ws + W_H);
    switch (ph) {
        case 0: prep_phase(p, smem_raw); break;
        case 1: a_in_phase(p, 0, smem); break;
        case 2: a_mix_phase(p, 0, smem); break;
        case 3: out_gemm_phase((const bf16_t*)(p.ws + W_BUF1), 2048, (const bf16_t*)(p.ws + W_A_OUT), Y, YP, smem); break;
        case 4: norm_phase(Y, YP, 8, p.in[0], p.in[1], XB, true, nullptr, p.in[7] + 0 * 1024, p.in[6] + 1 * 1024, H); break;
        case 5: b_in_phase(p, smem); break;
        case 6: b_attn_phase(p, smem_raw); break;
        case 7: out_gemm_phase(H, 1024, (const bf16_t*)(p.ws + W_B_OUT), Y, YP, smem); break;
        case 8: norm_phase(Y, YP, 4, nullptr, nullptr, XB, true, nullptr, p.in[7] + 1 * 1024, p.in[6] + 2 * 1024, H); break;
        case 9: c_in_phase(p, smem); break;
        case 10: c_conv_phase(p); break;
        case 11: c_gate_phase(p, smem); break;
        case 12: c_scan1_phase(p); break;
        case 13: c_scan2_phase(p); break;
        case 14: out_gemm_phase(H, 1024, (const bf16_t*)(p.ws + W_C_OUT), Y, YP, smem); break;
        case 15: norm_phase(Y, YP, 4, nullptr, nullptr, XB, true, nullptr, p.in[7] + 2 * 1024, p.in[6] + 3 * 1024, H); break;
        case 16: a_in_phase(p, 1, smem); break;
        case 17: a_mix_phase(p, 1, smem); break;
        case 18: out_gemm_phase((const bf16_t*)(p.ws + W_BUF1), 2048, (const bf16_t*)(p.ws + W_A_OUT) + (size_t)1024 * 2048, Y, YP, smem); break;
        case 19: norm_phase(Y, YP, 8, nullptr, nullptr, XB, false, X, p.in[7] + 3 * 1024, nullptr, H); break;
        default: break;
    }
}


#define XB_TMO      128
#define XB_XCNT(j)  (256  + 64 * (j))
#define XB_XSUB(j)  (1280 + 64 * (j))
#define XB_XGEN(j)  (2304 + 64 * (j))
#define XB_TOP      3328
#define XB_TOPGEN   3392
#define XCD_BAR_WORDS 3456
#define XB_SPIN_CAP (1u << 20)
__device__ __forceinline__ unsigned xb_ld(unsigned* p) { return __hip_atomic_load(p, __ATOMIC_RELAXED, __HIP_MEMORY_SCOPE_AGENT); }
__device__ __forceinline__ unsigned xb_add(unsigned* p, unsigned v) { return __hip_atomic_fetch_add(p, v, __ATOMIC_RELAXED, __HIP_MEMORY_SCOPE_AGENT); }
__device__ __forceinline__ unsigned xb_xcc_id() { return (unsigned)__builtin_amdgcn_s_getreg((3 << 11) | 20) & 0xFu; }
#define XB_SPIN(cond, bar) do { unsigned _sp = 0; while (cond) { __builtin_amdgcn_s_sleep(1); \
    if ((++_sp & 255u) == 0u) { if (xb_ld(&(bar)[XB_TMO])) break; if (_sp > XB_SPIN_CAP) { atomicAdd(&(bar)[XB_TMO], 1u); break; } } } } while (0)
struct XcdBarrier { unsigned* bar; unsigned x, nloc, nx; };
__device__ __forceinline__ void xcd_barrier_complete(unsigned* bar, unsigned x, unsigned& nloc, unsigned& nx) {
    const unsigned G = gridDim.x;
    unsigned sum, cnt, mine, sp = 0u;
    for (;;) {
        sum = 0u; cnt = 0u; mine = 0u;
#pragma unroll
        for (unsigned j = 0; j < 16; ++j) { const unsigned c = xb_ld(&bar[XB_XCNT(j)]); sum += c; cnt += (c > 0u) ? 1u : 0u; mine = (j == x) ? c : mine; }
        if (sum == G) break;
        __builtin_amdgcn_s_sleep(1);
        if ((++sp & 255u) == 0u) { if (xb_ld(&bar[XB_TMO])) break; if (sp > XB_SPIN_CAP) { atomicAdd(&bar[XB_TMO], 1u); break; } }
    }
    nloc = mine > 0u ? mine : 1u; nx = cnt > 0u ? cnt : 1u;
}
__device__ __forceinline__ void xcd_barrier(XcdBarrier& b) {
    asm volatile("s_waitcnt vmcnt(0)" ::: "memory");
    __syncthreads();
    if (threadIdx.x == 0) {
        unsigned* bar = b.bar;
        __builtin_amdgcn_s_waitcnt(0);
        if (b.nloc == 0u) xcd_barrier_complete(bar, b.x, b.nloc, b.nx);
        const unsigned nloc = b.nloc, nx = b.nx;
        const unsigned old = xb_add(&bar[XB_XSUB(b.x)], 1u);
        const unsigned gen = old / nloc;
        if (old + 1u == (gen + 1u) * nloc) {
            __builtin_amdgcn_fence(__ATOMIC_RELEASE, "agent");
            asm volatile("s_waitcnt vmcnt(0)" ::: "memory");
            const unsigned og = xb_add(&bar[XB_TOP], 1u);
            const unsigned tg = og / nx;
            if (og + 1u == (tg + 1u) * nx) xb_add(&bar[XB_TOPGEN], 1u);
            else XB_SPIN(xb_ld(&bar[XB_TOPGEN]) == tg, bar);
            __builtin_amdgcn_fence(__ATOMIC_ACQUIRE, "agent");
            xb_add(&bar[XB_XGEN(b.x)], 1u);
            asm volatile("s_waitcnt vmcnt(0)" ::: "memory");
        } else {
            XB_SPIN(xb_ld(&bar[XB_XGEN(b.x)]) == gen, bar);
            __builtin_amdgcn_fence(__ATOMIC_ACQUIRE, "agent");
            asm volatile("s_waitcnt vmcnt(0)" ::: "memory");
        }
    }
    __syncthreads();
}

#ifndef PROBE_K
#define PROBE_K 20
#endif
__device__ __forceinline__ void dump_phase(const Params& p) {
    const unsigned* base = (const unsigned*)(p.ws);
    const size_t nwords = W_END / 4, n = (size_t)MT * D;
    const size_t gt = (size_t)blockIdx.x * NTHREADS + threadIdx.x, gn = (size_t)gridDim.x * NTHREADS;
    for (size_t i = gt; i < n; i += gn) {
        float a = 0.f;
        for (int k = 0; k < 4; ++k) {
            const size_t w = i + (size_t)k * n;
            if (w < nwords) { const unsigned u = base[w]; a += (float)((u * 2654435761u) >> 29); }
        }
        p.out[i] = a;
    }
}
constexpr size_t W_BAR = W_END;
#define PHASE(i) if (p.ph_lo <= (i) && (i) < p.ph_hi) { if ((i) > p.ph_lo) xcd_barrier(xb); run_phase(p, (i), smem_raw); }
__global__ void __launch_bounds__(NTHREADS, 2) mega_kernel(Params p) {
    __shared__ __attribute__((aligned(16))) unsigned char smem_raw[SMEM_BYTES];
    XcdBarrier xb;
    xb.bar = (unsigned*)(p.ws + W_BAR); xb.x = xb_xcc_id(); xb.nloc = 0u; xb.nx = 0u;
    if (threadIdx.x == 0) (void)xb_add(&xb.bar[XB_XCNT(xb.x)], 1u);
    if (p.ph_lo < 0) cg::this_grid().sync();
    PHASE(0) PHASE(1) PHASE(2) PHASE(3) PHASE(4) PHASE(5) PHASE(6) PHASE(7) PHASE(8) PHASE(9)
    PHASE(10) PHASE(11) PHASE(13) PHASE(14) PHASE(15) PHASE(16) PHASE(17) PHASE(18) PHASE(19)
    if (ONE_LAUNCH && p.ph_hi < N_PHASES && p.ph_lo == 0) { xcd_barrier(xb); dump_phase(p); }
    if (!ONE_LAUNCH && p.ph_lo == N_PHASES) dump_phase(p);
}

extern "C" void kernel_launch(void* const* d_in, const int* in_sizes, int n_in, void* d_out, int out_size, void* d_ws, size_t ws_size,
                              hipStream_t stream) {
    static int grid = 0;
    if (grid == 0) {
        if (n_in != 26 || (size_t)out_size != O_END || ws_size < W_END + XCD_BAR_WORDS * 4) {
            fprintf(stderr, "kernel_launch: unexpected shapes n_in=%d out=%d ws=%zu (need %zu)\n", n_in, out_size, ws_size, (size_t)W_END);
            grid = -1;
            return;
        }
        int dev = 0, cus = 0, per_cu = 0;
        (void)hipGetDevice(&dev);
        (void)hipDeviceGetAttribute(&cus, hipDeviceAttributeMultiprocessorCount, dev);
        (void)hipOccupancyMaxActiveBlocksPerMultiprocessor(&per_cu, (const void*)mega_kernel, NTHREADS, 0);
        if (per_cu < 1) per_cu = 1;
        if (per_cu > 2) per_cu = 2;
        grid = cus * per_cu;
    }
    if (grid < 0) return;
    Params p{};
    for (int i = 0; i < 26; ++i) p.in[i] = (const float*)d_in[i];
    p.out = (float*)d_out;
    p.ws = (unsigned char*)d_ws;
#if ONE_LAUNCH
    (void)hipMemsetAsync((unsigned char*)d_ws + W_BAR, 0, XCD_BAR_WORDS * 4, stream);
    p.ph_lo = 0;
    p.ph_hi = PROBE_K;
    void* args[] = {&p};
    hipError_t e = hipLaunchCooperativeKernel((const void*)mega_kernel, dim3(grid), dim3(NTHREADS), args, 0, stream);
    if (e != hipSuccess) fprintf(stderr, "cooperative launch failed: %s (grid %d)\n", hipGetErrorString(e), grid);
#else
    for (int ph = 0; ph < N_PHASES; ++ph) {
        p.ph_lo = ph;
        p.ph_hi = ph + 1;
        hipLaunchKernelGGL(mega_kernel, dim3(grid), dim3(NTHREADS), 0, stream, p);
    }
#endif
}
```

```cpp
#include <hip/hip_runtime.h>
#include <hip/hip_cooperative_groups.h>
#include <stdint.h>
#include <stdio.h>
#include <math.h>
namespace cg = cooperative_groups;

#ifndef ONE_LAUNCH
#define ONE_LAUNCH 1
#endif

typedef unsigned short bf16_t;
typedef short bf16x8 __attribute__((ext_vector_type(8)));
typedef float f32x4 __attribute__((ext_vector_type(4)));
typedef unsigned u32x4 __attribute__((ext_vector_type(4)));
typedef unsigned u32x2 __attribute__((ext_vector_type(2)));

constexpr int M_P = 16384, M_S = 128, MT = 16512, D = 1024, SEQ = 8192;
constexpr int NTHREADS = 256;
constexpr int SMEM_BYTES = 65536;

constexpr size_t O_X = 0;
constexpr size_t O_AV = (size_t)MT * D;
constexpr size_t O_BKP = O_AV + 2 * 128 * 2048;
constexpr size_t O_BVP = O_BKP + 2 * 128 * 128;
constexpr size_t O_BKS = O_BVP + 2 * 128 * 128;
constexpr size_t O_BVS = O_BKS + 128 * 128 * 128;
constexpr size_t O_CCP = O_BVS + 128 * 128 * 128;
constexpr size_t O_CHP = O_CCP + 2 * 3 * 1024;
constexpr size_t O_CCS = O_CHP + 2 * 1024;
constexpr size_t O_CHS = O_CCS + 128 * 3 * 1024;
constexpr size_t O_END = O_CHS + 128 * 1024;

constexpr size_t W_A_IN = 0;
constexpr size_t W_A_OUT = W_A_IN + (size_t)2 * 6144 * 1024 * 2;
constexpr size_t W_B_IN = W_A_OUT + (size_t)2 * 1024 * 2048 * 2;
constexpr size_t W_B_OUT = W_B_IN + (size_t)2304 * 1024 * 2;
constexpr size_t W_C_IN = W_B_OUT + (size_t)1024 * 1024 * 2;
constexpr size_t W_C_G = W_C_IN + (size_t)2048 * 1024 * 2;
constexpr size_t W_C_OUT = W_C_G + (size_t)4 * 512 * 256 * 2;
constexpr size_t W_WS_A = W_C_OUT + (size_t)1024 * 1024 * 2;
constexpr size_t W_ROPE = W_WS_A + (size_t)2 * 4 * 128 * 128 * 2;
constexpr size_t W_H = W_ROPE + (size_t)8193 * 64 * 4;
constexpr size_t W_BUF1 = W_H + (size_t)MT * 1024 * 2;
constexpr size_t W_BUF2 = W_BUF1 + (size_t)MT * 2048 * 2;
constexpr size_t W_KB = W_BUF2 + (size_t)MT * 2048 * 2;
constexpr size_t W_STATS = W_KB;
constexpr size_t W_CARRY = W_KB + (size_t)MT * 256 * 2;
constexpr size_t W_YPART = W_CARRY + (size_t)128 * 1024 * 2 * 4;
constexpr size_t W_XB = W_YPART + (size_t)8 * 128 * 1024 * 4;
constexpr size_t W_SP = W_XB + (size_t)MT * 1024 * 2;
constexpr size_t W_RS = W_SP + 4096;
constexpr size_t W_END = W_RS + (size_t)MT * 4;

struct Params {
    const float* in[26];
    float* out;
    unsigned char* ws;
    int ph_lo, ph_hi;
};

__device__ __forceinline__ unsigned cvt_pk(float lo, float hi) {
    unsigned r;
    asm("v_cvt_pk_bf16_f32 %0, %1, %2" : "=v"(r) : "v"(lo), "v"(hi));
    return r;
}
__device__ __forceinline__ float bf_lo(unsigned u) { return __uint_as_float(u << 16); }
__device__ __forceinline__ float bf_hi(unsigned u) { return __uint_as_float(u & 0xffff0000u); }
__device__ __forceinline__ float bf2f(bf16_t h) { return __uint_as_float(((unsigned)h) << 16); }
__device__ __forceinline__ float sigmoid_f(float x) { return __builtin_amdgcn_rcpf(1.f + __expf(-x)); }
__device__ __forceinline__ float silu_f(float x) { return x * sigmoid_f(x); }
__device__ __forceinline__ float gelu_f(float x) { return x * sigmoid_f(1.5957691216057308f * (x + 0.044715f * x * x * x)); }
__device__ __forceinline__ float gelu_silu(float u, float g) {
    const float eu = __expf(-1.5957691216057308f * (u + 0.044715f * u * u * u)), eg = __expf(-g);
    const float den = (1.f + eu) * (1.f + eg);
    return (u * g) * __builtin_amdgcn_rcpf(den);
}
template <int CTRL> __device__ __forceinline__ float dpp_add(float x) {
    return x + __builtin_bit_cast(float, __builtin_amdgcn_update_dpp(0, __builtin_bit_cast(int, x), CTRL, 0xF, 0xF, true));
}
__device__ __forceinline__ float row16_sum(float x) {
    x = dpp_add<0xB1>(x);
    x = dpp_add<0x4E>(x);
    x = dpp_add<0x141>(x);
    x = dpp_add<0x140>(x);
    return x;
}
__device__ __forceinline__ float wave_sum(float v) {
#pragma unroll
    for (int o = 1; o < 64; o <<= 1) v += __shfl_xor(v, o);
    return v;
}

__device__ __forceinline__ int perm32(int rho) { return 8 * ((rho & 15) >> 2) + 4 * (rho >> 4) + (rho & 3); }
__device__ __forceinline__ int permcol(int c) { return (c & ~31) + perm32(c & 31); }
__device__ __forceinline__ int swz(int row, int chunk) { return (chunk ^ (((row >> 3) & 1) << 1)) * 8; }

template <bool TRANS>
__device__ __forceinline__ void mma_stage(const bf16_t* As, const bf16_t* Bs, int apanel, int bpanel, f32x4 (&acc)[4][4], int wr, int wc, int lane) {
    const int fr = lane & 15, fq = lane >> 4;
    const int co = swz(fr, fq);
#pragma unroll
    for (int kk = 0; kk < 2; ++kk) {
        bf16x8 a[4], b[4];
#pragma unroll
        for (int i = 0; i < 4; ++i) {
            a[i] = *(const bf16x8*)(As + kk * apanel + (wr * 64 + i * 16 + fr) * 32 + co);
            b[i] = *(const bf16x8*)(Bs + kk * bpanel + (wc * 64 + i * 16 + fr) * 32 + co);
        }
#pragma unroll
        for (int i = 0; i < 4; ++i)
#pragma unroll
            for (int j = 0; j < 4; ++j)
                acc[i][j] = TRANS ? __builtin_amdgcn_mfma_f32_16x16x32_bf16(b[j], a[i], acc[i][j], 0, 0, 0)
                                  : __builtin_amdgcn_mfma_f32_16x16x32_bf16(a[i], b[j], acc[i][j], 0, 0, 0);
    }
}

__device__ __forceinline__ void g2r(const bf16_t* __restrict__ g, int ld, int row0, int k0, int tid, u32x4 (&r)[4]) {
    const int rl = 2 * (tid >> 4) + ((tid >> 2) & 1), kc = ((tid >> 3) & 1) * 4 + (tid & 3);
    const unsigned voff = (unsigned)(rl * ld + kc * 8) * 2u;
#pragma unroll
    for (int i = 0; i < 4; ++i) {
        const char* b = (const char*)(g + (size_t)(row0 + 32 * i) * ld + k0);
        r[i] = *(const u32x4*)(b + voff);
    }
}
__device__ __forceinline__ void r2s(bf16_t* s, int tid, const u32x4 (&r)[4]) {
    const int rl = 2 * (tid >> 4) + ((tid >> 2) & 1), kc = ((tid >> 3) & 1) * 4 + (tid & 3);
#pragma unroll
    for (int i = 0; i < 4; ++i) {
        const int row = rl + 32 * i;
        *(u32x4*)(s + (kc >> 2) * 4096 + row * 32 + swz(row, kc & 3)) = r[i];
    }
}

__device__ __forceinline__ void g2r32(const bf16_t* __restrict__ g, int ld, int row0, int k0, int tid, u32x4 (&r)[2]) {
    const unsigned voff = (unsigned)((tid >> 2) * ld + (tid & 3) * 8) * 2u;
#pragma unroll
    for (int i = 0; i < 2; ++i) {
        const char* b = (const char*)(g + (size_t)(row0 + 64 * i) * ld + k0);
        r[i] = *(const u32x4*)(b + voff);
    }
}
__device__ __forceinline__ void r2s32(bf16_t* s, int tid, const u32x4 (&r)[2]) {
#pragma unroll
    for (int i = 0; i < 2; ++i) {
        const int row = (tid >> 2) + 64 * i;
        *(u32x4*)(s + row * 32 + swz(row, tid & 3)) = r[i];
    }
}
__device__ __forceinline__ void ldfrag(const bf16_t* st, bf16x8 (&a)[4], bf16x8 (&b)[4], int wr, int wc, int fr, int co) {
#pragma unroll
    for (int i = 0; i < 4; ++i) {
        a[i] = *(const bf16x8*)(st + (wr * 64 + i * 16 + fr) * 32 + co);
        b[i] = *(const bf16x8*)(st + 4096 + (wc * 64 + i * 16 + fr) * 32 + co);
    }
}
template <bool TRANS>
__device__ __forceinline__ void mma16(const bf16x8 (&a)[4], const bf16x8 (&b)[4], f32x4 (&acc)[4][4]) {
    __builtin_amdgcn_s_setprio(1);
#pragma unroll
    for (int i = 0; i < 4; ++i)
#pragma unroll
        for (int j = 0; j < 4; ++j)
            acc[i][j] = TRANS ? __builtin_amdgcn_mfma_f32_16x16x32_bf16(b[j], a[i], acc[i][j], 0, 0, 0)
                              : __builtin_amdgcn_mfma_f32_16x16x32_bf16(a[i], b[j], acc[i][j], 0, 0, 0);
    __builtin_amdgcn_s_setprio(0);
}

struct Stage { u32x4 ra0[2], rb0[2], ra1[2], rb1[2]; };

template <bool TRANS, class Epi>
__device__ __forceinline__ void gemm_tile(const bf16_t* __restrict__ A, int lda, const bf16_t* __restrict__ Bt, int ldb, int K, int m0, int n0,
                                          bf16_t* smem, const Epi epi, Stage& st, bool pre, bool has_next, const bf16_t* __restrict__ An,
                                          const bf16_t* __restrict__ Bn, int m0n, int n0n) {
    const int tid = threadIdx.x, wid = tid >> 6, lane = tid & 63, wr = wid >> 1, wc = wid & 1, fr = lane & 15, fq = lane >> 4;
    const int co = swz(fr, fq);
    f32x4 acc[4][4];
#pragma unroll
    for (int i = 0; i < 4; ++i)
#pragma unroll
        for (int j = 0; j < 4; ++j) acc[i][j] = (f32x4){0.f, 0.f, 0.f, 0.f};
    const int nk = K >> 5;
    bf16x8 a0[4], b0[4], a1[4], b1[4];
    if (!pre) {
        g2r32(A, lda, m0, 0, tid, st.ra0);
        g2r32(Bt, ldb, n0, 0, tid, st.rb0);
        g2r32(A, lda, m0, 32, tid, st.ra1);
        g2r32(Bt, ldb, n0, 32, tid, st.rb1);
    }
    __syncthreads();
    r2s32(smem, tid, st.ra0);
    r2s32(smem + 4096, tid, st.rb0);
    r2s32(smem + 8192, tid, st.ra1);
    r2s32(smem + 8192 + 4096, tid, st.rb1);
    g2r32(A, lda, m0, 64, tid, st.ra0);
    g2r32(Bt, ldb, n0, 64, tid, st.rb0);
    g2r32(A, lda, m0, 96, tid, st.ra1);
    g2r32(Bt, ldb, n0, 96, tid, st.rb1);
    __syncthreads();
    ldfrag(smem, a0, b0, wr, wc, fr, co);
    for (int kt = 0; kt < nk; kt += 2) {
        {
            bf16_t* w = smem + ((kt + 2) & 3) * 8192;
            r2s32(w, tid, st.ra0);
            r2s32(w + 4096, tid, st.rb0);
            const int kn = (kt + 4 < nk ? kt + 4 : nk - 1) * 32;
            g2r32(A, lda, m0, kn, tid, st.ra0);
            g2r32(Bt, ldb, n0, kn, tid, st.rb0);
            ldfrag(smem + ((kt + 1) & 3) * 8192, a1, b1, wr, wc, fr, co);
            mma16<TRANS>(a0, b0, acc);
            __syncthreads();
        }
        {
            bf16_t* w = smem + ((kt + 3) & 3) * 8192;
            r2s32(w, tid, st.ra1);
            r2s32(w + 4096, tid, st.rb1);
            const int kn = (kt + 5 < nk ? kt + 5 : nk - 1) * 32;
            g2r32(A, lda, m0, kn, tid, st.ra1);
            g2r32(Bt, ldb, n0, kn, tid, st.rb1);
            ldfrag(smem + ((kt + 2) & 3) * 8192, a0, b0, wr, wc, fr, co);
            mma16<TRANS>(a1, b1, acc);
            __syncthreads();
        }
    }
    if (has_next) {
        g2r32(An, lda, m0n, 0, tid, st.ra0);
        g2r32(Bn, ldb, n0n, 0, tid, st.rb0);
        g2r32(An, lda, m0n, 32, tid, st.ra1);
        g2r32(Bn, ldb, n0n, 32, tid, st.rb1);
    }
    epi(acc, m0, n0, wr, wc, lane);
}

__device__ __forceinline__ void wt_tile(const float* colptr, int ldsrc, bf16_t* dst, int ldd, float* tile, int tid, const float* ksc = nullptr) {
    const int tx = tid & 63, ty = tid >> 6;
    float v[16];
#pragma unroll
    for (int q = 0; q < 16; ++q) v[q] = colptr[(size_t)(ty + 4 * q) * ldsrc];
    if (ksc) {
#pragma unroll
        for (int q = 0; q < 16; ++q) v[q] *= ksc[ty + 4 * q];
    }
#pragma unroll
    for (int q = 0; q < 16; ++q) tile[(ty + 4 * q) * 65 + tx] = v[q];
    __syncthreads();
    const int c2 = tid & 31, r0 = tid >> 5;
#pragma unroll
    for (int rr = r0; rr < 64; rr += 8)
        *(unsigned*)(dst + (size_t)rr * ldd + 2 * c2) = cvt_pk(tile[(2 * c2) * 65 + rr], tile[(2 * c2 + 1) * 65 + rr]);
    __syncthreads();
}

__device__ __forceinline__ void sincos_d(double x, double& s, double& c) {
    const double k = rint(x * 0.63661977236758134308);
    double r = fma(-k, 1.57079632673412561417e+00, x);
    r = fma(-k, 6.07710050650619224932e-11, r);
    const double z = r * r;
    const double sp = r + r * z * (-1.66666666666666324348e-01 + z * (8.33333333332248946124e-03 + z * (-1.98412698298579493134e-04 + z * (2.75573137070700676789e-06 + z * (-2.50507602534068634195e-08 + z * 1.58969099521155010221e-10)))));
    const double cp = 1.0 - 0.5 * z + z * z * (4.16666666666666019037e-02 + z * (-1.38888888888741095749e-03 + z * (2.48015872894767294178e-05 + z * (-2.75573143513906633035e-07 + z * (2.08757232129817482790e-09 + z * -1.13596475577881948265e-11)))));
    const int q = ((int)k) & 3;
    s = (q == 0) ? sp : (q == 1) ? cp : (q == 2) ? -sp : -cp;
    c = (q == 0) ? cp : (q == 1) ? -sp : (q == 2) ? -cp : sp;
}

__device__ __forceinline__ void norm_phase(const float* __restrict__ Y, const float* __restrict__ Ypart, int nsplit, const float* xin_p, const float* xin_s,
                                           bf16_t* Xb, bool storeXb, float* Xf, const float* gpost, const float* gpre, bf16_t* H) {
    const int lane = threadIdx.x & 63;
    const int gw = blockIdx.x * 4 + (threadIdx.x >> 6), nw = gridDim.x * 4;
    for (int ri = gw; ri < MT; ri += nw) {
        const int row = ri < M_S ? M_P + ri : ri - M_S;
        f32x4 x[4];
        if (xin_p) {
            const float* xr = row < M_P ? xin_p + (size_t)row * D : xin_s + (size_t)(row - M_P) * D;
#pragma unroll
            for (int j = 0; j < 4; ++j) x[j] = *(const f32x4*)(xr + j * 256 + lane * 4);
        } else {
#pragma unroll
            for (int j = 0; j < 4; ++j) {
                const u32x2 w = *(const u32x2*)(Xb + (size_t)row * D + j * 256 + lane * 4);
                x[j] = (f32x4){bf_lo(w.x), bf_hi(w.x), bf_lo(w.y), bf_hi(w.y)};
            }
        }
        if (Y) {
            f32x4 y[4];
            float ss = 0.f;
            if (row < M_P) {
#pragma unroll
                for (int j = 0; j < 4; ++j) {
                    const u32x2 w = *(const u32x2*)((const bf16_t*)Y + (size_t)row * D + j * 256 + lane * 4);
                    y[j] = (f32x4){bf_lo(w.x), bf_hi(w.x), bf_lo(w.y), bf_hi(w.y)};
                }
            } else {
#pragma unroll
                for (int j = 0; j < 4; ++j) y[j] = (f32x4){0.f, 0.f, 0.f, 0.f};
                for (int s = 0; s < nsplit; s += 4) {
                    f32x4 t[4][4];
#pragma unroll
                    for (int u = 0; u < 4; ++u)
#pragma unroll
                        for (int j = 0; j < 4; ++j) t[u][j] = *(const f32x4*)(Ypart + ((size_t)(s + u) * 128 + (row - M_P)) * D + j * 256 + lane * 4);
#pragma unroll
                    for (int u = 0; u < 4; ++u)
#pragma unroll
                        for (int j = 0; j < 4; ++j) y[j] += t[u][j];
                }
            }
#pragma unroll
            for (int j = 0; j < 4; ++j) ss += y[j].x * y[j].x + y[j].y * y[j].y + y[j].z * y[j].z + y[j].w * y[j].w;
            ss = wave_sum(ss);
            const float rstd = rsqrtf(ss * (1.f / 1024.f) + 1e-6f);
#pragma unroll
            for (int j = 0; j < 4; ++j) {
                const f32x4 g = *(const f32x4*)(gpost + j * 256 + lane * 4);
                x[j] = x[j] + y[j] * rstd * g;
            }
        }
        if (storeXb) {
#pragma unroll
            for (int j = 0; j < 4; ++j) {
                u32x2 w;
                w.x = cvt_pk(x[j].x, x[j].y);
                w.y = cvt_pk(x[j].z, x[j].w);
                *(u32x2*)(Xb + (size_t)row * D + j * 256 + lane * 4) = w;
            }
        }
        if (Xf) {
#pragma unroll
            for (int j = 0; j < 4; ++j) *(f32x4*)(Xf + (size_t)row * D + j * 256 + lane * 4) = x[j];
        }
        if (gpre) {
            float ss = 0.f;
#pragma unroll
            for (int j = 0; j < 4; ++j) ss += x[j].x * x[j].x + x[j].y * x[j].y + x[j].z * x[j].z + x[j].w * x[j].w;
            ss = wave_sum(ss);
            if (lane == 0) ((float*)H)[row] = rsqrtf(ss * (1.f / 1024.f) + 1e-6f);
        }
    }
}

constexpr int WT_FIRST = 96 * 16;
constexpr int WT_TOTAL = 2 * 96 * 16 + 2 * 16 * 32 + 36 * 16 + 256 + 32 * 16 + 128 + 256;
__device__ __forceinline__ void wt_jobs(const Params& p, unsigned char* smem, int lo, int hi, int w, int nw) {
    float* tile = (float*)smem;
    const int tid = threadIdx.x, tx = tid & 63;
    constexpr int T_AIN = 96 * 16, T_AOUT = 16 * 32, T_BIN = 36 * 16, T_BOUT = 256, T_CIN = 32 * 16, T_CG = 128, T_COUT = 256;
    for (int it = lo + w; it < hi; it += nw) {
        int r = it;
        if (r < 2 * T_AIN) {
            const int j = r / T_AIN; r -= j * T_AIN;
            const int nt = r >> 4, kt = r & 15, np = permcol(nt * 64 + tx);
            int col;
            const int T = np >> 7, w = np & 127;
            if (T < 32) {
                const int wc = w >> 6, jn = (w >> 4) & 3, i = w & 15;
                col = ((jn < 2) ? 0 : 4096) + 64 * T + 32 * wc + 16 * (jn & 1) + i;
            } else col = 2048 + (np - 4096);
            wt_tile(p.in[8] + (size_t)j * 1024 * 6144 + (size_t)(kt * 64) * 6144 + col, 6144,
                    (bf16_t*)(p.ws + W_A_IN) + (size_t)j * 6144 * 1024 + (size_t)(nt * 64) * 1024 + kt * 64, 1024, tile, tid, p.in[6] + (j == 0 ? 0 : 3) * 1024 + kt * 64);
            continue;
        }
        r -= 2 * T_AIN;
        if (r < 2 * T_AOUT) {
            const int j = r / T_AOUT; r -= j * T_AOUT;
            const int nt = r >> 5, kt = r & 31;
            wt_tile(p.in[13] + (size_t)j * 2048 * 1024 + (size_t)(kt * 64) * 1024 + permcol(nt * 64 + tx), 1024,
                    (bf16_t*)(p.ws + W_A_OUT) + (size_t)j * 1024 * 2048 + (size_t)(nt * 64) * 2048 + kt * 64, 2048, tile, tid);
            continue;
        }
        r -= 2 * T_AOUT;
        if (r < T_BIN) {
            const int nt = r >> 4, kt = r & 15;
            wt_tile(p.in[14] + (size_t)(kt * 64) * 2304 + permcol(nt * 64 + tx), 2304, (bf16_t*)(p.ws + W_B_IN) + (size_t)(nt * 64) * 1024 + kt * 64, 1024, tile, tid, p.in[6] + 1 * 1024 + kt * 64);
            continue;
        }
        r -= T_BIN;
        if (r < T_BOUT) {
            const int nt = r >> 4, kt = r & 15;
            wt_tile(p.in[16] + (size_t)(kt * 64) * 1024 + permcol(nt * 64 + tx), 1024, (bf16_t*)(p.ws + W_B_OUT) + (size_t)(nt * 64) * 1024 + kt * 64, 1024, tile, tid);
            continue;
        }
        r -= T_BOUT;
        if (r < T_CIN) {
            const int nt = r >> 4, kt = r & 15;
            wt_tile(p.in[17] + (size_t)(kt * 64) * 2048 + permcol(nt * 64 + tx), 2048, (bf16_t*)(p.ws + W_C_IN) + (size_t)(nt * 64) * 1024 + kt * 64, 1024, tile, tid, p.in[6] + 2 * 1024 + kt * 64);
            continue;
        }
        r -= T_CIN;
        if (r < T_CG) {
            const int blk = r >> 5, rr = r & 31, nt = rr >> 2, kt = rr & 3;
            const int np = permcol(nt * 64 + tx), j4 = np >> 7, w = np & 127, wc = w >> 6, jn = (w >> 4) & 3, i = w & 15;
            const int dl = 64 * j4 + 32 * wc + 16 * (jn & 1) + i;
            const float* src = ((jn < 2) ? p.in[20] : p.in[22]) + (size_t)blk * 65536;
            wt_tile(src + (size_t)(kt * 64) * 256 + dl, 256, (bf16_t*)(p.ws + W_C_G) + (size_t)blk * 512 * 256 + (size_t)(nt * 64) * 256 + kt * 64, 256, tile, tid);
            continue;
        }
        r -= T_CG;
        {
            const int nt = r >> 4, kt = r & 15;
            wt_tile(p.in[24 + 1] + (size_t)(kt * 64) * 1024 + permcol(nt * 64 + tx), 1024, (bf16_t*)(p.ws + W_C_OUT) + (size_t)(nt * 64) * 1024 + kt * 64, 1024, tile, tid);
        }
    }
}

__device__ __forceinline__ void prep_phase(const Params& p, unsigned char* smem) {
    const int tid = threadIdx.x;
    wt_jobs(p, smem, 0, WT_FIRST, blockIdx.x, gridDim.x);
    const int gt = blockIdx.x * NTHREADS + tid, gn = gridDim.x * NTHREADS;
    {
        bf16_t* wsa = (bf16_t*)(p.ws + W_WS_A);
        const float* src = p.in[11];
        for (int idx = gt; idx < 2 * 4 * 128 * 128 / 2; idx += gn) {
            const int e = idx * 2, t = (e >> 7) & 127, s = e & 127;
            const float a = (s <= t) ? src[e] : 0.f, b = (s + 1 <= t) ? src[e + 1] : 0.f;
            *(unsigned*)(wsa + e) = cvt_pk(a, b);
        }
    }
    if (gt < 1024) ((float*)(p.ws + W_SP))[gt] = log1pf(__expf(-p.in[24][gt]));
    {
        float* rt = (float*)(p.ws + W_ROPE);
        for (int idx = gt; idx < 8193 * 32; idx += gn) {
            const int pos = idx >> 5, i = idx & 31;
            const float ang = (float)pos * exp2f(-(float)i * (13.287712379549449f / 32.0f));
            double s, c;
            sincos_d((double)ang, s, c);
            rt[pos * 64 + i] = (float)c;
            rt[pos * 64 + 32 + i] = (float)s;
        }
    }
    norm_phase(nullptr, nullptr, 0, p.in[0], p.in[1], (bf16_t*)(p.ws + W_XB), true, nullptr, nullptr, p.in[6], (bf16_t*)(p.ws + W_RS));
}

struct EpiUG {
    bf16_t* P;
    int T;
    const float* rs;
    __device__ __forceinline__ void operator()(f32x4 (&acc)[4][4], int m0, int n0, int wr, int wc, int lane) const {
        const int fr = lane & 15, fq = lane >> 4;
#pragma unroll
        for (int i = 0; i < 4; ++i) {
            const int m = m0 + wr * 64 + i * 16 + fr;
            const int ch = 64 * T + 32 * wc + 8 * fq;
            const float sc = rs[m];
            u32x4 w;
            {
                const f32x4 u = acc[i][0] * sc, g = acc[i][2] * sc;
                w.x = cvt_pk(gelu_silu(u.x, g.x), gelu_silu(u.y, g.y));
                w.y = cvt_pk(gelu_silu(u.z, g.z), gelu_silu(u.w, g.w));
            }
            {
                const f32x4 u = acc[i][1] * sc, g = acc[i][3] * sc;
                w.z = cvt_pk(gelu_silu(u.x, g.x), gelu_silu(u.y, g.y));
                w.w = cvt_pk(gelu_silu(u.z, g.z), gelu_silu(u.w, g.w));
            }
            *(u32x4*)(P + (size_t)m * 2048 + ch) = w;
        }
    }
};
struct EpiV {
    bf16_t* GVt;
    float* stats;
    int mt, tv;
    const float* rs;
    __device__ __forceinline__ void operator()(f32x4 (&acc)[4][4], int m0, int n0, int wr, int wc, int lane) const {
        const int fr = lane & 15, fq = lane >> 4;
#pragma unroll
        for (int i = 0; i < 4; ++i) {
            const int sl = wr * 64 + i * 16 + fq * 4;
            f32x4 sum = {0.f, 0.f, 0.f, 0.f}, sq = {0.f, 0.f, 0.f, 0.f};
#pragma unroll
            for (int jn = 0; jn < 4; ++jn) {
                const int ch = 128 * tv + wc * 64 + 32 * (jn >> 1) + perm32(16 * (jn & 1) + fr);
                f32x4 v = acc[i][jn] * *(const f32x4*)(rs + m0 + sl);
                v.x = gelu_f(v.x); v.y = gelu_f(v.y); v.z = gelu_f(v.z); v.w = gelu_f(v.w);
                u32x2 w;
                w.x = cvt_pk(v.x, v.y);
                w.y = cvt_pk(v.z, v.w);
                *(u32x2*)(GVt + ((size_t)mt * 2048 + ch) * 128 + sl) = w;
                sum += v;
                sq += v * v;
            }
            sum.x = row16_sum(sum.x); sum.y = row16_sum(sum.y); sum.z = row16_sum(sum.z); sum.w = row16_sum(sum.w);
            sq.x = row16_sum(sq.x); sq.y = row16_sum(sq.y); sq.z = row16_sum(sq.z); sq.w = row16_sum(sq.w);
            if (fr == 0) {
                float* st = stats + (size_t)(m0 + sl) * 64 + (tv * 2 + wc) * 2;
                st[0] = sum.x; st[1] = sq.x;
                st[64] = sum.y; st[65] = sq.y;
                st[128] = sum.z; st[129] = sq.z;
                st[192] = sum.w; st[193] = sq.w;
            }
        }
    }
};

__device__ __forceinline__ void a_in_phase(const Params& p, int j, bf16_t* smem) {
    const bf16_t* H = (const bf16_t*)(p.ws + W_XB);
    const float* RS = (const float*)(p.ws + W_RS);
    const bf16_t* Wt = (const bf16_t*)(p.ws + W_A_IN) + (size_t)j * 6144 * 1024;
    bf16_t* P = (bf16_t*)(p.ws + W_BUF1);
    bf16_t* GVt = (bf16_t*)(p.ws + W_BUF2);
    float* stats = (float*)(p.ws + W_STATS);
    Stage st;
    bool pre = false;
    for (int t = blockIdx.x; t < 129 * 48; t += gridDim.x) {
        const int mt = t / 48, nt = t % 48;
        const int tn = t + gridDim.x;
        const bool hn = tn < 129 * 48;
        const int m0n = (tn / 48) * 128, n0n = (tn % 48) * 128;
        if (nt < 32) {
            EpiUG e{P, nt, RS};
            gemm_tile<true>(H, 1024, Wt, 1024, 1024, mt * 128, nt * 128, smem, e, st, pre, hn, H, Wt, m0n, n0n);
        } else {
            EpiV e{GVt, stats, mt, nt - 32, RS};
            gemm_tile<false>(H, 1024, Wt, 1024, 1024, mt * 128, nt * 128, smem, e, st, pre, hn, H, Wt, m0n, n0n);
        }
        pre = hn;
    }
    if (j == 0) {
        const int busy = (129 * 48) % gridDim.x, idle = gridDim.x - busy;
        if (idle > 0 && (int)blockIdx.x >= busy) wt_jobs(p, (unsigned char*)smem, WT_FIRST, WT_TOTAL, blockIdx.x - busy, idle);
        else if (idle <= 0) wt_jobs(p, (unsigned char*)smem, WT_FIRST, WT_TOTAL, blockIdx.x, gridDim.x);
    }
}

__device__ __forceinline__ void a_mix_phase(const Params& p, int j, bf16_t* smem) {
    const int tid = threadIdx.x, wid = tid >> 6, lane = tid & 63, wr = wid >> 1, wc = wid & 1, fr = lane & 15, fq = lane >> 4;
    bf16_t* P = (bf16_t*)(p.ws + W_BUF1);
    const bf16_t* GVt = (const bf16_t*)(p.ws + W_BUF2);
    const float* stats = (const float*)(p.ws + W_STATS);
    const bf16_t* wsa = (const bf16_t*)(p.ws + W_WS_A) + (size_t)j * 4 * 128 * 128;
    const float* ln_g = p.in[9] + j * 2048;
    const float* ln_b = p.in[10] + j * 2048;
    const float* b_s = p.in[12] + j * 4 * 128;
    const float* w_s = p.in[11] + (size_t)j * 4 * 128 * 128;
    float* av_out = p.out + O_AV + (size_t)j * 128 * 2048;
    bf16_t* As = smem;
    bf16_t* Bs = smem + 16384;
    float* mu = (float*)(smem + 16384);
    float* rs = mu + 128;
    for (int it = blockIdx.x; it < 129 * 16; it += gridDim.x) {
        const int chunk = it >> 4, g = (it >> 2) & 3, slab = it & 3;
        const bool samp = (chunk == 128);
        f32x4 sv[8];
        {
            const float* stp = stats + (size_t)(chunk * 128 + (tid >> 1)) * 64 + (tid & 1) * 32;
#pragma unroll
            for (int k = 0; k < 8; ++k) sv[k] = *(const f32x4*)(stp + k * 4);
        }
        u32x4 araw[8], braw[8];
        float lg[8], lb[8];
        const float w00 = w_s[g * 16384];
        {
            const bf16_t* wg = wsa + g * 16384;
#pragma unroll
            for (int i = 0; i < 8; ++i) {
                const int c = tid + 256 * i, row = c >> 4, sc = c & 15;
                araw[i] = (u32x4){0u, 0u, 0u, 0u};
                if (!samp) araw[i] = *(const u32x4*)(wg + row * 128 + sc * 8);
                const int ch = g * 512 + slab * 128 + permcol(row);
                braw[i] = *(const u32x4*)(GVt + ((size_t)chunk * 2048 + ch) * 128 + sc * 8);
                lg[i] = ln_g[ch];
                lb[i] = ln_b[ch];
            }
        }
        float s = 0.f, q = 0.f;
#pragma unroll
        for (int k = 0; k < 8; ++k) { s += sv[k].x + sv[k].z; q += sv[k].y + sv[k].w; }
        s += __shfl_xor(s, 1);
        q += __shfl_xor(q, 1);
        const float mean = s * (1.f / 2048.f);
        const float var = fmaxf(q * (1.f / 2048.f) - mean * mean, 0.f);
        __syncthreads();
        if ((tid & 1) == 0) { mu[tid >> 1] = mean; rs[tid >> 1] = rsqrtf(var + 1e-5f); }
        if (samp) {
#pragma unroll
            for (int i = 0; i < 8; ++i) {
                const int c = tid + 256 * i, row = c >> 4, sc = c & 15;
                if ((row >> 3) == sc) {
                    const unsigned lo = cvt_pk(w00, 0.f), hi = cvt_pk(0.f, w00);
                    const int e = row & 7;
                    const unsigned val = (e & 1) ? hi : lo;
                    if ((e >> 1) == 0) araw[i].x = val; else if ((e >> 1) == 1) araw[i].y = val; else if ((e >> 1) == 2) araw[i].z = val; else araw[i].w = val;
                }
            }
        }
#pragma unroll
        for (int i = 0; i < 8; ++i) {
            const int c = tid + 256 * i, row = c >> 4, sc = c & 15;
            *(u32x4*)(As + (sc >> 2) * 4096 + row * 32 + swz(row, sc & 3)) = araw[i];
        }
        __syncthreads();
        float mur[8], rsr[8];
#pragma unroll
        for (int e = 0; e < 8; ++e) { mur[e] = mu[(tid & 15) * 8 + e]; rsr[e] = rs[(tid & 15) * 8 + e]; }
        __syncthreads();
#pragma unroll
        for (int i = 0; i < 8; ++i) {
            const int c = tid + 256 * i, n = c >> 4, sc = c & 15;
            const int ch = g * 512 + slab * 128 + permcol(n);
            const u32x4 v = braw[i];
            float x[8];
            x[0] = bf_lo(v.x); x[1] = bf_hi(v.x); x[2] = bf_lo(v.y); x[3] = bf_hi(v.y);
            x[4] = bf_lo(v.z); x[5] = bf_hi(v.z); x[6] = bf_lo(v.w); x[7] = bf_hi(v.w);
#pragma unroll
            for (int e = 0; e < 8; ++e) x[e] = (x[e] - mur[e]) * rsr[e] * lg[i] + lb[i];
            if (samp) {
#pragma unroll
                for (int e = 0; e < 8; ++e) av_out[(size_t)(sc * 8 + e) * 2048 + ch] = x[e];
            }
            u32x4 o;
            o.x = cvt_pk(x[0], x[1]); o.y = cvt_pk(x[2], x[3]); o.z = cvt_pk(x[4], x[5]); o.w = cvt_pk(x[6], x[7]);
            *(u32x4*)(Bs + (sc >> 2) * 4096 + n * 32 + swz(n, sc & 3)) = o;
        }
        __syncthreads();
        f32x4 acc[4][4];
#pragma unroll
        for (int i = 0; i < 4; ++i)
#pragma unroll
            for (int jn = 0; jn < 4; ++jn) acc[i][jn] = (f32x4){0.f, 0.f, 0.f, 0.f};
        u32x4 pvv[4][2];
#pragma unroll
        for (int i = 0; i < 4; ++i)
#pragma unroll
            for (int g2 = 0; g2 < 2; ++g2)
                pvv[i][g2] = *(const u32x4*)(P + (size_t)(chunk * 128 + wr * 64 + i * 16 + fr) * 2048 + g * 512 + slab * 128 + wc * 64 + 32 * g2 + 8 * fq);
        mma_stage<true>(As, Bs, 4096, 4096, acc, wr, wc, lane);
        mma_stage<true>(As + 8192, Bs + 8192, 4096, 4096, acc, wr, wc, lane);
#pragma unroll
        for (int i = 0; i < 4; ++i) {
            const int t = wr * 64 + i * 16 + fr;
            const float bs = b_s[g * 128 + (samp ? 0 : t)];
            const size_t rowoff = (size_t)(chunk * 128 + t) * 2048 + g * 512 + slab * 128;
#pragma unroll
            for (int g2 = 0; g2 < 2; ++g2) {
                bf16_t* pp = P + rowoff + wc * 64 + 32 * g2 + 8 * fq;
                const u32x4 pv = pvv[i][g2];
                const f32x4 a = acc[i][2 * g2], b = acc[i][2 * g2 + 1];
                u32x4 w;
                w.x = cvt_pk(bf_lo(pv.x) * (a.x + bs), bf_hi(pv.x) * (a.y + bs));
                w.y = cvt_pk(bf_lo(pv.y) * (a.z + bs), bf_hi(pv.y) * (a.w + bs));
                w.z = cvt_pk(bf_lo(pv.z) * (b.x + bs), bf_hi(pv.z) * (b.y + bs));
                w.w = cvt_pk(bf_lo(pv.w) * (b.z + bs), bf_hi(pv.w) * (b.w + bs));
                *(u32x4*)pp = w;
            }
        }
    }
}

struct EpiY {
    bf16_t* Yb;
    float* Yp;
    __device__ __forceinline__ void operator()(f32x4 (&acc)[4][4], int m0, int n0, int wr, int wc, int lane) const {
        const int fr = lane & 15, fq = lane >> 4;
        const bool part = (m0 == M_P);
#pragma unroll
        for (int i = 0; i < 4; ++i) {
            const int m = m0 + wr * 64 + i * 16 + fr;
#pragma unroll
            for (int g2 = 0; g2 < 2; ++g2) {
                const int n = n0 + wc * 64 + 32 * g2 + 8 * fq;
                const f32x4 a = acc[i][2 * g2], b = acc[i][2 * g2 + 1];
                if (part) {
                    float* o = Yp + (size_t)(m - M_P) * 1024 + n;
                    *(f32x4*)o = a;
                    *(f32x4*)(o + 4) = b;
                } else {
                    u32x4 w;
                    w.x = cvt_pk(a.x, a.y); w.y = cvt_pk(a.z, a.w); w.z = cvt_pk(b.x, b.y); w.w = cvt_pk(b.z, b.w);
                    *(u32x4*)(Yb + (size_t)m * 1024 + n) = w;
                }
            }
        }
    }
};
__device__ __forceinline__ void out_gemm_phase(const bf16_t* A, int K, const bf16_t* Wt, float* Y, float* Ypart, bf16_t* smem) {
    const int nsplit = K >> 8;
    const int ntile = 1024 + 8 * nsplit;
    Stage st;
    bool pre = false;
    for (int t = blockIdx.x; t < ntile; t += gridDim.x) {
        const bool full = t < 1024;
        const int u = t - 1024, ks = full ? 0 : (u >> 3);
        const int m0 = full ? (t >> 3) * 128 : M_P, n0 = (full ? (t & 7) : (u & 7)) * 128, Kt = full ? K : 256;
        const int tn = t + gridDim.x;
        const bool hn = tn < ntile, fulln = tn < 1024;
        const int un = tn - 1024, ksn = fulln ? 0 : (un >> 3);
        const int m0n = fulln ? (tn >> 3) * 128 : M_P, n0n = (fulln ? (tn & 7) : (un & 7)) * 128;
        EpiY e{(bf16_t*)Y, Ypart + (size_t)ks * 128 * 1024};
        gemm_tile<true>(A + ks * 256, K, Wt + ks * 256, K, Kt, m0, n0, smem, e, st, pre, hn, A + ksn * 256, Wt + ksn * 256, m0n, n0n);
        pre = hn;
    }
}

struct EpiSilu {
    bf16_t* O;
    int ldo, col0;
    __device__ __forceinline__ void operator()(f32x4 (&acc)[4][4], int m0, int n0, int wr, int wc, int lane) const {
        const int fr = lane & 15, fq = lane >> 4;
#pragma unroll
        for (int i = 0; i < 4; ++i) {
            const int m = m0 + wr * 64 + i * 16 + fr;
#pragma unroll
            for (int jn = 0; jn < 4; ++jn) {
                const f32x4 a = acc[i][jn];
                u32x2 w;
                w.x = cvt_pk(silu_f(a.x), silu_f(a.y));
                w.y = cvt_pk(silu_f(a.z), silu_f(a.w));
                *(u32x2*)(O + (size_t)m * ldo + col0 + wc * 64 + jn * 16 + fq * 4) = w;
            }
        }
    }
};
struct EpiCopy {
    bf16_t* O;
    int ldo, col0;
    __device__ __forceinline__ void operator()(f32x4 (&acc)[4][4], int m0, int n0, int wr, int wc, int lane) const {
        const int fr = lane & 15, fq = lane >> 4;
#pragma unroll
        for (int i = 0; i < 4; ++i) {
            const int m = m0 + wr * 64 + i * 16 + fr;
#pragma unroll
            for (int jn = 0; jn < 4; ++jn) {
                const f32x4 a = acc[i][jn];
                u32x2 w;
                w.x = cvt_pk(a.x, a.y);
                w.y = cvt_pk(a.z, a.w);
                *(u32x2*)(O + (size_t)m * ldo + col0 + wc * 64 + jn * 16 + fq * 4) = w;
            }
        }
    }
};
template <int isk> struct EpiRope {
    bf16_t* O;
    int ldo, col0;
    const float* rope;
    float* out;
    __device__ __forceinline__ void operator()(f32x4 (&acc)[4][4], int m0, int n0, int wr, int wc, int lane) const {
        const int fr = lane & 15, fq = lane >> 4;
#pragma unroll
        for (int i = 0; i < 4; ++i) {
            const int m = m0 + wr * 64 + i * 16 + fr;
            const int pos = (m < M_P) ? (m & (SEQ - 1)) : SEQ;
            const float* rt = rope + (size_t)pos * 64;
            const float scale = isk ? 1.0f : 0.125f;
#pragma unroll
            for (int jn = 0; jn < 2; ++jn) {
                const int d = jn * 16 + fq * 4;
                const f32x4 c = *(const f32x4*)(rt + d), s = *(const f32x4*)(rt + 32 + d);
                const f32x4 x1 = acc[i][jn], x2 = acc[i][jn + 2];
                const f32x4 o1 = (x1 * c - x2 * s) * scale, o2 = (x2 * c + x1 * s) * scale;
                u32x2 w1, w2;
                w1.x = cvt_pk(o1.x, o1.y); w1.y = cvt_pk(o1.z, o1.w);
                w2.x = cvt_pk(o2.x, o2.y); w2.y = cvt_pk(o2.z, o2.w);
                bf16_t* dst = O + (size_t)m * ldo + col0 + wc * 64 + d;
                *(u32x2*)dst = w1;
                *(u32x2*)(dst + 32) = w2;
                if (isk) {
                    if (m < M_P) {
                        const int t = m & (SEQ - 1), b = m >> 13;
                        if (t >= SEQ - 128) {
                            float* o = out + O_BKP + ((size_t)(b * 128 + t - (SEQ - 128)) * 2 + wc) * 64 + d;
                            *(f32x4*)o = o1;
                            *(f32x4*)(o + 32) = o2;
                        }
                    } else {
                        float* o = out + O_BKS + ((size_t)((m - M_P) * 128 + 127) * 2 + wc) * 64 + d;
                        *(f32x4*)o = o1;
                        *(f32x4*)(o + 32) = o2;
                    }
                }
            }
        }
    }
};
struct EpiVt {
    bf16_t* Vt;
    float* out;
    __device__ __forceinline__ void operator()(f32x4 (&acc)[4][4], int m0, int n0, int wr, int wc, int lane) const {
        const int fr = lane & 15, fq = lane >> 4;
#pragma unroll
        for (int i = 0; i < 4; ++i) {
            const int m = m0 + wr * 64 + i * 16 + fq * 4;
#pragma unroll
            for (int jn = 0; jn < 4; ++jn) {
                const int d = jn * 16 + fr;
                const f32x4 a = acc[i][jn];
                if (m < M_P) {
                    const int t = m & (SEQ - 1), b = m >> 13;
                    u32x2 w;
                    w.x = cvt_pk(a.x, a.y);
                    w.y = cvt_pk(a.z, a.w);
                    *(u32x2*)(Vt + ((size_t)(b * 2 + wc) * 64 + d) * SEQ + t) = w;
                    if (t >= SEQ - 128) {
                        float* o = out + O_BVP + ((size_t)(b * 128 + t - (SEQ - 128)) * 2 + wc) * 64 + d;
                        o[0] = a.x; o[128] = a.y; o[256] = a.z; o[384] = a.w;
                    }
                } else {
                    float* o = out + O_BVS + ((size_t)((m - M_P) * 128 + 127) * 2 + wc) * 64 + d;
                    o[0] = a.x; o[16384] = a.y; o[32768] = a.z; o[49152] = a.w;
                }
            }
        }
    }
};

struct EpiB {
    bf16_t *Q, *SG, *KV;
    const float* rope;
    float* out;
    int nt;
    const float* rs;
    __device__ __forceinline__ void operator()(f32x4 (&acc)[4][4], int m0, int n0, int wr, int wc, int lane) const {
        const int fr = lane & 15, fq = lane >> 4;
#pragma unroll
        for (int i = 0; i < 4; ++i) {
            const float sc = rs[m0 + wr * 64 + i * 16 + fr];
#pragma unroll
            for (int jn = 0; jn < 4; ++jn) acc[i][jn] = acc[i][jn] * sc;
        }
        if (nt < 9) {
            const bool isk = (nt == 8);
            const float scale = isk ? 1.0f : 0.125f;
#pragma unroll
            for (int i = 0; i < 4; ++i) {
                const int m = m0 + wr * 64 + i * 16 + fr;
                const int pos = (m < M_P) ? (m & (SEQ - 1)) : SEQ;
                const float* rt = rope + (size_t)pos * 64;
                const int d = 8 * fq;
                f32x4 o1[2], o2[2];
#pragma unroll
                for (int jl = 0; jl < 2; ++jl) {
                    const f32x4 c = *(const f32x4*)(rt + d + 4 * jl), s = *(const f32x4*)(rt + 32 + d + 4 * jl);
                    const f32x4 x1 = acc[i][jl], x2 = acc[i][jl + 2];
                    o1[jl] = (x1 * c - x2 * s) * scale;
                    o2[jl] = (x2 * c + x1 * s) * scale;
                }
                u32x4 w1, w2;
                w1.x = cvt_pk(o1[0].x, o1[0].y); w1.y = cvt_pk(o1[0].z, o1[0].w); w1.z = cvt_pk(o1[1].x, o1[1].y); w1.w = cvt_pk(o1[1].z, o1[1].w);
                w2.x = cvt_pk(o2[0].x, o2[0].y); w2.y = cvt_pk(o2[0].z, o2[0].w); w2.z = cvt_pk(o2[1].x, o2[1].y); w2.w = cvt_pk(o2[1].z, o2[1].w);
                bf16_t* dst = isk ? KV + (size_t)m * 256 + wc * 64 + d : Q + (size_t)m * 1024 + nt * 128 + wc * 64 + d;
                *(u32x4*)dst = w1;
                *(u32x4*)(dst + 32) = w2;
                if (isk) {
                    float* o = nullptr;
                    if (m < M_P) {
                        const int t = m & (SEQ - 1), b = m >> 13;
                        if (t >= SEQ - 128) o = out + O_BKP + ((size_t)(b * 128 + t - (SEQ - 128)) * 2 + wc) * 64 + d;
                    } else o = out + O_BKS + ((size_t)((m - M_P) * 128 + 127) * 2 + wc) * 64 + d;
                    if (o) { *(f32x4*)o = o1[0]; *(f32x4*)(o + 4) = o1[1]; *(f32x4*)(o + 32) = o2[0]; *(f32x4*)(o + 36) = o2[1]; }
                }
            }
        } else if (nt == 9) {
#pragma unroll
            for (int i = 0; i < 4; ++i) {
                const int m = m0 + wr * 64 + i * 16 + fr;
                float* o = nullptr;
                if (m < M_P) {
                    const int t = m & (SEQ - 1), b = m >> 13;
                    if (t >= SEQ - 128) o = out + O_BVP + ((size_t)(b * 128 + t - (SEQ - 128)) * 2 + wc) * 64;
                } else o = out + O_BVS + ((size_t)((m - M_P) * 128 + 127) * 2 + wc) * 64;
#pragma unroll
                for (int g2 = 0; g2 < 2; ++g2) {
                    const int d = 32 * g2 + 8 * fq;
                    const f32x4 a = acc[i][2 * g2], b = acc[i][2 * g2 + 1];
                    u32x4 w;
                    w.x = cvt_pk(a.x, a.y); w.y = cvt_pk(a.z, a.w); w.z = cvt_pk(b.x, b.y); w.w = cvt_pk(b.z, b.w);
                    *(u32x4*)(KV + (size_t)m * 256 + 128 + wc * 64 + d) = w;
                    if (o) { *(f32x4*)(o + d) = a; *(f32x4*)(o + d + 4) = b; }
                }
            }
        } else {
#pragma unroll
            for (int i = 0; i < 4; ++i) {
                const int m = m0 + wr * 64 + i * 16 + fr;
#pragma unroll
                for (int g2 = 0; g2 < 2; ++g2) {
                    const f32x4 a = acc[i][2 * g2], b = acc[i][2 * g2 + 1];
                    u32x4 w;
                    w.x = cvt_pk(silu_f(a.x), silu_f(a.y)); w.y = cvt_pk(silu_f(a.z), silu_f(a.w));
                    w.z = cvt_pk(silu_f(b.x), silu_f(b.y)); w.w = cvt_pk(silu_f(b.z), silu_f(b.w));
                    *(u32x4*)(SG + (size_t)m * 1024 + (nt - 10) * 128 + wc * 64 + 32 * g2 + 8 * fq) = w;
                }
            }
        }
    }
};

__device__ __forceinline__ void b_in_phase(const Params& p, bf16_t* smem) {
    const bf16_t* H = (const bf16_t*)(p.ws + W_XB);
    const float* RS = (const float*)(p.ws + W_RS);
    const bf16_t* Wt = (const bf16_t*)(p.ws + W_B_IN);
    bf16_t* Q = (bf16_t*)(p.ws + W_BUF1);
    bf16_t* SG = Q + (size_t)MT * 1024;
    bf16_t* KV = (bf16_t*)(p.ws + W_KB);
    const float* rope = (const float*)(p.ws + W_ROPE);
    Stage st;
    bool pre = false;
    for (int t = blockIdx.x; t < 129 * 18; t += gridDim.x) {
        const int mt = t < 2064 ? (t >> 4) : ((t - 2064) >> 1), nt = t < 2064 ? (t & 15) : 16 + ((t - 2064) & 1);
        const int tn = t + gridDim.x;
        const bool hn = tn < 129 * 18;
        const int mtn = tn < 2064 ? (tn >> 4) : ((tn - 2064) >> 1), ntn = tn < 2064 ? (tn & 15) : 16 + ((tn - 2064) & 1);
        EpiB e{Q, SG, KV, rope, p.out, nt, RS};
        gemm_tile<true>(H, 1024, Wt, 1024, 1024, mt * 128, nt * 128, smem, e, st, pre, hn, H, Wt, mtn * 128, ntn * 128);
        pre = hn;
    }
}

constexpr int VT_LD = 256;
__device__ __forceinline__ void attn_prompt_item(const Params& p, int item, bf16_t* smem) {
    const int tid = threadIdx.x, w = tid >> 6, lane = tid & 63, fr = lane & 15, fq = lane >> 4;
    const int half = item & 1, kvh = (item >> 1) & 1, nb = (item >> 2) & 63, b = item >> 8;
    const bf16_t* Q = (const bf16_t*)(p.ws + W_BUF1);
    const bf16_t* SG = Q + (size_t)MT * 1024;
    const bf16_t* KV = (const bf16_t*)(p.ws + W_KB);
    bf16_t* Z = (bf16_t*)(p.ws + W_H);
    bf16_t* Ks = smem;
    bf16_t* Vs = smem + 16384;
    const int row0 = b * SEQ + nb * 128;
    u32x4 kraw[8], vraw[8];
#pragma unroll
    for (int i = 0; i < 8; ++i) {
        const int c = tid + 256 * i, key = c >> 3, kc = c & 7;
        kraw[i] = (u32x4){0u, 0u, 0u, 0u};
        vraw[i] = (u32x4){0u, 0u, 0u, 0u};
        if (nb > 0 || key >= 128) {
            const bf16_t* src_row = KV + (size_t)(row0 - 128 + key) * 256 + kvh * 64 + kc * 8;
            kraw[i] = *(const u32x4*)src_row;
            vraw[i] = *(const u32x4*)(src_row + 128);
        }
    }
    __syncthreads();
#pragma unroll
    for (int i = 0; i < 8; ++i) {
        const int c = tid + 256 * i, key = c >> 3, kc = c & 7;
        *(u32x4*)(Ks + (kc >> 2) * 8192 + key * 32 + swz(key, kc & 3)) = kraw[i];
    }
#pragma unroll
    for (int i = 0; i < 8; ++i) {
        const int c = tid + 256 * i, key = c >> 3, dc = c & 7;
        const unsigned wv[4] = {vraw[i].x, vraw[i].y, vraw[i].z, vraw[i].w};
#pragma unroll
        for (int e = 0; e < 8; ++e) {
            const int d = dc * 8 + e;
            const unsigned short hv = (e & 1) ? (unsigned short)(wv[e >> 1] >> 16) : (unsigned short)(wv[e >> 1] & 0xffff);
            Vs[d * VT_LD + (((key >> 3) ^ ((d & 15) << 1)) << 3) + (key & 7)] = hv;
        }
    }
    __syncthreads();
    const int co = swz(fr, fq);
#pragma unroll 1
    for (int gq = half * 8; gq < half * 8 + 8; ++gq) {
        const int g = gq >> 1, qt = gq & 1;
        const int h = kvh * 8 + g;
        const float sink = p.in[15][h];
        const int qi = 32 * w + 16 * qt + fr;
        bf16x8 qf[2];
#pragma unroll
        for (int kk = 0; kk < 2; ++kk)
            qf[kk] = *(const bf16x8*)(Q + (size_t)(row0 + qi) * 1024 + h * 64 + kk * 32 + fq * 8);
        f32x4 s[10];
#pragma unroll
        for (int kt = 0; kt < 10; ++kt) s[kt] = (f32x4){0.f, 0.f, 0.f, 0.f};
#pragma unroll
        for (int kt = 0; kt < 10; ++kt) {
#pragma unroll
            for (int kk = 0; kk < 2; ++kk) {
                const bf16x8 kf = *(const bf16x8*)(Ks + kk * 8192 + (16 * (2 * w + kt) + fr) * 32 + co);
                s[kt] = __builtin_amdgcn_mfma_f32_16x16x32_bf16(kf, qf[kk], s[kt], 0, 0, 0);
            }
            if (kt & 1) __builtin_amdgcn_sched_barrier(0);
        }
        float mx = sink;
#pragma unroll
        for (int kt = 0; kt < 10; ++kt) {
            const int key0 = 16 * (2 * w + kt) + fq * 4;
#pragma unroll
            for (int r = 0; r < 4; ++r) {
                const int key = key0 + r;
                const bool valid = (key >= qi) && (key <= qi + 128) && (nb > 0 || key >= 128);
                const float v = valid ? s[kt][r] : -1e30f;
                s[kt][r] = v;
                mx = fmaxf(mx, v);
            }
        }
        mx = fmaxf(mx, __shfl_xor(mx, 16));
        mx = fmaxf(mx, __shfl_xor(mx, 32));
        float sum = 0.f;
#pragma unroll
        for (int kt = 0; kt < 10; ++kt)
#pragma unroll
            for (int r = 0; r < 4; ++r) {
                const float e = __expf(s[kt][r] - mx);
                s[kt][r] = e;
                sum += e;
            }
        sum += __shfl_xor(sum, 16);
        sum += __shfl_xor(sum, 32);
        const float inv = __builtin_amdgcn_rcpf(sum + __expf(sink - mx));
        u32x2 sgv[4];
#pragma unroll
        for (int dt = 0; dt < 4; ++dt) sgv[dt] = *(const u32x2*)(SG + (size_t)(row0 + qi) * 1024 + h * 64 + 16 * dt + fq * 4);
        f32x4 o[4];
#pragma unroll
        for (int dt = 0; dt < 4; ++dt) o[dt] = (f32x4){0.f, 0.f, 0.f, 0.f};
#pragma unroll
        for (int ks = 0; ks < 5; ++ks) {
            u32x4 pw;
            pw.x = cvt_pk(s[2 * ks][0], s[2 * ks][1]);
            pw.y = cvt_pk(s[2 * ks][2], s[2 * ks][3]);
            pw.z = cvt_pk(s[2 * ks + 1][0], s[2 * ks + 1][1]);
            pw.w = cvt_pk(s[2 * ks + 1][2], s[2 * ks + 1][3]);
            const bf16x8 pf = __builtin_bit_cast(bf16x8, pw);
            const int kc0 = (((2 * w + 2 * ks) ^ fr) << 4) + fq * 4, kc1 = (((2 * w + 2 * ks + 1) ^ fr) << 4) + fq * 4;
#pragma unroll
            for (int dt = 0; dt < 4; ++dt) {
                const bf16_t* vp = Vs + (16 * dt + fr) * VT_LD;
                u32x4 vw;
                const u32x2 v0 = *(const u32x2*)(vp + kc0), v1 = *(const u32x2*)(vp + kc1);
                vw.x = v0.x; vw.y = v0.y; vw.z = v1.x; vw.w = v1.y;
                const bf16x8 vf = __builtin_bit_cast(bf16x8, vw);
                o[dt] = __builtin_amdgcn_mfma_f32_16x16x32_bf16(vf, pf, o[dt], 0, 0, 0);
            }
            __builtin_amdgcn_sched_barrier(0);
        }
        const size_t ro = (size_t)(row0 + qi) * 1024 + h * 64;
#pragma unroll
        for (int dt = 0; dt < 4; ++dt) {
            const int d = 16 * dt + fq * 4;
            const u32x2 sg = sgv[dt];
            const f32x4 ov = o[dt] * inv;
            u32x2 wv;
            wv.x = cvt_pk(ov.x * bf_lo(sg.x), ov.y * bf_hi(sg.x));
            wv.y = cvt_pk(ov.z * bf_lo(sg.y), ov.w * bf_hi(sg.y));
            *(u32x2*)(Z + ro + d) = wv;
        }
    }
}

__device__ __forceinline__ void attn_sample_item(const Params& p, int item, unsigned char* smem_raw) {
    const int tid = threadIdx.x, g = tid >> 5, l = tid & 31;
    const int kvh = item & 1, b = item >> 1;
    const bf16_t* Q = (const bf16_t*)(p.ws + W_BUF1);
    const bf16_t* SG = Q + (size_t)MT * 1024;
    bf16_t* Z = (bf16_t*)(p.ws + W_H);
    float* kv = (float*)smem_raw;
    float* qs = kv + 129 * 65;
    float* ps = qs + 512;
    const float* ck = p.in[2];
    const float* cv = p.in[3];
    float* oks = p.out + O_BKS;
    float* ovs = p.out + O_BVS;
    const int row = M_P + b;
    f32x4 knew = {0.f, 0.f, 0.f, 0.f}, vnew = {0.f, 0.f, 0.f, 0.f};
    if (tid < 16) knew = *(const f32x4*)(oks + ((size_t)(b * 128 + 127) * 2 + kvh) * 64 + tid * 4);
    const float q0 = bf2f(Q[(size_t)row * 1024 + kvh * 512 + tid]), q1 = bf2f(Q[(size_t)row * 1024 + kvh * 512 + 256 + tid]);
    __syncthreads();
#pragma unroll 1
    for (int hb = 0; hb < 2; ++hb) {
        f32x4 kreg[4];
#pragma unroll
        for (int i = 0; i < 4; ++i) {
            const int c = tid + 256 * (hb * 4 + i), key = c >> 4, d4 = (c & 15) * 4;
            kreg[i] = *(const f32x4*)(ck + ((size_t)(b * 128 + key) * 2 + kvh) * 64 + d4);
        }
#pragma unroll
        for (int i = 0; i < 4; ++i) {
            const int c = tid + 256 * (hb * 4 + i), key = c >> 4, d4 = (c & 15) * 4;
            if (key >= 1) *(f32x4*)(oks + ((size_t)(b * 128 + key - 1) * 2 + kvh) * 64 + d4) = kreg[i];
            float* kp = kv + key * 65 + d4;
            kp[0] = kreg[i].x; kp[1] = kreg[i].y; kp[2] = kreg[i].z; kp[3] = kreg[i].w;
        }
    }
    if (tid < 16) { float* kp = kv + 128 * 65 + tid * 4; kp[0] = knew.x; kp[1] = knew.y; kp[2] = knew.z; kp[3] = knew.w; }
    qs[tid] = q0;
    qs[256 + tid] = q1;
    if (tid < 16) vnew = *(const f32x4*)(ovs + ((size_t)(b * 128 + 127) * 2 + kvh) * 64 + tid * 4);
    __syncthreads();
    const int h = kvh * 8 + g;
    const float sink = p.in[15][h];
    float sc[5];
    float mx = sink;
#pragma unroll
    for (int i = 0; i < 5; ++i) {
        const int key = l + 32 * i;
        float a = -1e30f;
        if (key < 129) {
            a = 0.f;
#pragma unroll 8
            for (int d = 0; d < 64; ++d) a += qs[g * 64 + d] * kv[key * 65 + d];
        }
        sc[i] = a;
        mx = fmaxf(mx, a);
    }
#pragma unroll
    for (int o = 1; o < 32; o <<= 1) mx = fmaxf(mx, __shfl_xor(mx, o));
    float sum = 0.f;
#pragma unroll
    for (int i = 0; i < 5; ++i) {
        const int key = l + 32 * i;
        const float e = (key < 129) ? __expf(sc[i] - mx) : 0.f;
        sc[i] = e;
        sum += e;
    }
#pragma unroll
    for (int o = 1; o < 32; o <<= 1) sum += __shfl_xor(sum, o);
    const float inv = __builtin_amdgcn_rcpf(sum + __expf(sink - mx));
#pragma unroll
    for (int i = 0; i < 5; ++i) {
        const int key = l + 32 * i;
        if (key < 129) ps[g * 132 + key] = sc[i] * inv;
    }
    __syncthreads();
#pragma unroll 1
    for (int hb = 0; hb < 2; ++hb) {
        f32x4 vreg[4];
#pragma unroll
        for (int i = 0; i < 4; ++i) {
            const int c = tid + 256 * (hb * 4 + i), key = c >> 4, d4 = (c & 15) * 4;
            vreg[i] = *(const f32x4*)(cv + ((size_t)(b * 128 + key) * 2 + kvh) * 64 + d4);
        }
#pragma unroll
        for (int i = 0; i < 4; ++i) {
            const int c = tid + 256 * (hb * 4 + i), key = c >> 4, d4 = (c & 15) * 4;
            if (key >= 1) *(f32x4*)(ovs + ((size_t)(b * 128 + key - 1) * 2 + kvh) * 64 + d4) = vreg[i];
            float* kp = kv + key * 65 + d4;
            kp[0] = vreg[i].x; kp[1] = vreg[i].y; kp[2] = vreg[i].z; kp[3] = vreg[i].w;
        }
    }
    if (tid < 16) { float* kp = kv + 128 * 65 + tid * 4; kp[0] = vnew.x; kp[1] = vnew.y; kp[2] = vnew.z; kp[3] = vnew.w; }
    __syncthreads();
    float o0 = 0.f, o1 = 0.f;
#pragma unroll 8
    for (int key = 0; key < 129; ++key) {
        const float pv = ps[g * 132 + key];
        o0 += pv * kv[key * 65 + l];
        o1 += pv * kv[key * 65 + l + 32];
    }
    const size_t ro = (size_t)row * 1024 + h * 64;
    Z[ro + l] = (bf16_t)(cvt_pk(o0 * bf2f(SG[ro + l]), 0.f) & 0xffff);
    Z[ro + l + 32] = (bf16_t)(cvt_pk(o1 * bf2f(SG[ro + l + 32]), 0.f) & 0xffff);
}

__device__ __forceinline__ void b_attn_phase(const Params& p, unsigned char* smem_raw) {
    for (int it = blockIdx.x; it < 768; it += gridDim.x) {
        if (it < 512) attn_prompt_item(p, it, (bf16_t*)smem_raw);
        else attn_sample_item(p, it - 512, smem_raw);
    }
}

struct EpiAct {
    bf16_t* XR;
    int ldo, col0, act;
    const float* rs;
    __device__ __forceinline__ void operator()(f32x4 (&acc)[4][4], int m0, int n0, int wr, int wc, int lane) const {
        const int fr = lane & 15, fq = lane >> 4;
        bf16_t* O = act ? XR + (size_t)MT * 1024 - 1024 : XR;
#pragma unroll
        for (int i = 0; i < 4; ++i) {
            const int m = m0 + wr * 64 + i * 16 + fr;
            const float sc = rs[m];
#pragma unroll
            for (int g2 = 0; g2 < 2; ++g2) {
                f32x4 a = acc[i][2 * g2] * sc, b = acc[i][2 * g2 + 1] * sc;
                if (act) {
                    a.x = silu_f(a.x); a.y = silu_f(a.y); a.z = silu_f(a.z); a.w = silu_f(a.w);
                    b.x = silu_f(b.x); b.y = silu_f(b.y); b.z = silu_f(b.z); b.w = silu_f(b.w);
                }
                u32x4 w;
                w.x = cvt_pk(a.x, a.y); w.y = cvt_pk(a.z, a.w); w.z = cvt_pk(b.x, b.y); w.w = cvt_pk(b.z, b.w);
                *(u32x4*)(O + (size_t)m * ldo + col0 + wc * 64 + 32 * g2 + 8 * fq) = w;
            }
        }
    }
};
__device__ __forceinline__ void c_in_phase(const Params& p, bf16_t* smem) {
    const bf16_t* H = (const bf16_t*)(p.ws + W_XB);
    const float* RS = (const float*)(p.ws + W_RS);
    const bf16_t* Wt = (const bf16_t*)(p.ws + W_C_IN);
    bf16_t* XR = (bf16_t*)(p.ws + W_BUF1);
    bf16_t* SG = XR + (size_t)MT * 1024;
    Stage st;
    bool pre = false;
    for (int t = blockIdx.x; t < 129 * 16; t += gridDim.x) {
        const int mt = t >> 4, nt = t & 15;
        const int tn = t + gridDim.x;
        const bool hn = tn < 129 * 16;
        EpiAct e{XR, 1024, nt * 128, nt >= 8, RS};
        gemm_tile<true>(H, 1024, Wt, 1024, 1024, mt * 128, nt * 128, smem, e, st, pre, hn, H, Wt, (tn >> 4) * 128, (tn & 15) * 128);
        pre = hn;
    }
}

__device__ __forceinline__ void unpack8(const u32x4 v, float (&x)[8]) {
    x[0] = bf_lo(v.x); x[1] = bf_hi(v.x); x[2] = bf_lo(v.y); x[3] = bf_hi(v.y);
    x[4] = bf_lo(v.z); x[5] = bf_hi(v.z); x[6] = bf_lo(v.w); x[7] = bf_hi(v.w);
}

__device__ __forceinline__ void c_conv_phase(const Params& p) {
    const bf16_t* XR = (const bf16_t*)(p.ws + W_BUF1);
    bf16_t* XC = (bf16_t*)(p.ws + W_H);
    const float* cw = p.in[18];
    const float* cb = p.in[19];
    const float* st = p.in[4];
    const int gt = blockIdx.x * NTHREADS + threadIdx.x, gn = gridDim.x * NTHREADS;
    const int c0 = (gt & 127) * 8;
    float w0[8], w1[8], w2[8], w3[8], bias[8];
#pragma unroll
    for (int e = 0; e < 8; ++e) {
        w0[e] = cw[c0 + e]; w1[e] = cw[1024 + c0 + e]; w2[e] = cw[2048 + c0 + e]; w3[e] = cw[3072 + c0 + e]; bias[e] = cb[c0 + e];
    }
    for (int run = gt >> 7; run < M_P / 8; run += gn >> 7) {
        const int r0 = run * 8, t0 = r0 & (SEQ - 1), b = r0 >> 13;
        u32x4 raw[11];
#pragma unroll
        for (int q = 0; q < 11; ++q) {
            raw[q] = (u32x4){0u, 0u, 0u, 0u};
            if (q >= 3 || t0 > 0) raw[q] = *(const u32x4*)(XR + (size_t)(r0 - 3 + q) * 1024 + c0);
        }
        float x0[8], x1[8], x2[8], x3[8];
        unpack8(raw[0], x0); unpack8(raw[1], x1); unpack8(raw[2], x2);
#pragma unroll
        for (int q = 0; q < 8; ++q) {
            unpack8(raw[q + 3], x3);
            float acc[8];
#pragma unroll
            for (int e = 0; e < 8; ++e) acc[e] = bias[e] + x0[e] * w0[e] + x1[e] * w1[e] + x2[e] * w2[e] + x3[e] * w3[e];
            u32x4 o;
            o.x = cvt_pk(acc[0], acc[1]); o.y = cvt_pk(acc[2], acc[3]); o.z = cvt_pk(acc[4], acc[5]); o.w = cvt_pk(acc[6], acc[7]);
            *(u32x4*)(XC + (size_t)(r0 + q) * 1024 + c0) = o;
            const int t = t0 + q;
            if (t >= SEQ - 3) {
                float* oo = p.out + O_CCP + ((size_t)b * 3 + (t - (SEQ - 3))) * 1024 + c0;
#pragma unroll
                for (int e = 0; e < 8; ++e) oo[e] = x3[e];
            }
#pragma unroll
            for (int e = 0; e < 8; ++e) { x0[e] = x1[e]; x1[e] = x2[e]; x2[e] = x3[e]; }
        }
    }
    for (int b = gt >> 7; b < M_S; b += gn >> 7) {
        const int row = M_P + b;
        float xv[8], acc[8];
        unpack8(*(const u32x4*)(XR + (size_t)row * 1024 + c0), xv);
#pragma unroll
        for (int e = 0; e < 8; ++e) {
            const float s0 = st[((size_t)b * 3 + 0) * 1024 + c0 + e], s1 = st[((size_t)b * 3 + 1) * 1024 + c0 + e], s2 = st[((size_t)b * 3 + 2) * 1024 + c0 + e];
            acc[e] = bias[e] + s0 * w0[e] + s1 * w1[e] + s2 * w2[e] + xv[e] * w3[e];
            p.out[O_CCS + ((size_t)b * 3 + 0) * 1024 + c0 + e] = s1;
            p.out[O_CCS + ((size_t)b * 3 + 1) * 1024 + c0 + e] = s2;
            p.out[O_CCS + ((size_t)b * 3 + 2) * 1024 + c0 + e] = xv[e];
        }
        u32x4 o;
        o.x = cvt_pk(acc[0], acc[1]); o.y = cvt_pk(acc[2], acc[3]); o.z = cvt_pk(acc[4], acc[5]); o.w = cvt_pk(acc[6], acc[7]);
        *(u32x4*)(XC + (size_t)row * 1024 + c0) = o;
    }
}

struct EpiGate {
    const bf16_t* XC;
    float* Aa;
    bf16_t* Bb;
    const float *b_a, *b_x, *lam;
    int blk, nt;
    float* lds;
    float* carry;
    __device__ __forceinline__ void operator()(f32x4 (&acc)[4][4], int m0, int n0, int wr, int wc, int lane) const {
        const int fr = lane & 15, fq = lane >> 4;
        const bool prompt = (m0 < M_P);
#pragma unroll
        for (int jn = 0; jn < 2; ++jn) {
            const int cl = 32 * wc + 8 * fq + 4 * jn;
            const int d = blk * 256 + 64 * nt + cl;
            const f32x4 ba = *(const f32x4*)(b_a + d), bx = *(const f32x4*)(b_x + d), sp = *(const f32x4*)(lam + d);
#pragma unroll
            for (int i = 0; i < 4; ++i) {
                const int rl = wr * 64 + i * 16 + fr, m = m0 + rl;
                const bool first = (m < M_P) && ((m & (SEQ - 1)) == 0);
                const u32x2 xw = *(const u32x2*)(XC + (size_t)m * 1024 + d);
                const f32x4 xc = {bf_lo(xw.x), bf_hi(xw.x), bf_lo(xw.y), bf_hi(xw.y)};
                const f32x4 ra = acc[i][jn] + ba, ia = acc[i][jn + 2] + bx;
                f32x4 av, bv;
#pragma unroll
                for (int r = 0; r < 4; ++r) {
                    const float rg = sigmoid_f(ra[r]), ig = sigmoid_f(ia[r]);
                    const float la = -8.0f * rg * sp[r];
                    const float a = __expf(la);
                    av[r] = a;
                    const float mult = first ? 1.0f : __builtin_amdgcn_sqrtf(fmaxf(1.0f - a * a, 0.f));
                    bv[r] = mult * (ig * xc[r]);
                }
                u32x2 ow;
                ow.x = cvt_pk(1.0f - av.x, 1.0f - av.y);
                ow.y = cvt_pk(1.0f - av.z, 1.0f - av.w);
                *(u32x2*)((bf16_t*)Aa + (size_t)m * 1024 + d) = ow;
                av = (f32x4){1.0f - bf_lo(ow.x), 1.0f - bf_hi(ow.x), 1.0f - bf_lo(ow.y), 1.0f - bf_hi(ow.y)};
                u32x2 w;
                w.x = cvt_pk(bv.x, bv.y);
                w.y = cvt_pk(bv.z, bv.w);
                *(u32x2*)(Bb + (size_t)m * 1024 + d) = w;
                if (prompt) {
                    *(f32x4*)(lds + rl * 64 + cl) = av;
                    *(f32x4*)(lds + 8192 + rl * 64 + cl) = (f32x4){bf_lo(w.x), bf_hi(w.x), bf_lo(w.y), bf_hi(w.y)};
                }
            }
        }
        __syncthreads();
        if (prompt && threadIdx.x < 64) {
            float A = 1.f, h = 0.f;
#pragma unroll 16
            for (int r = 0; r < 128; ++r) {
                const float a = lds[r * 64 + threadIdx.x], b = lds[8192 + r * 64 + threadIdx.x];
                A *= a;
                h = a * h + b;
            }
            const int chunk = m0 >> 7, d = blk * 256 + 64 * nt + threadIdx.x;
            carry[(size_t)chunk * 2048 + d] = A;
            carry[(size_t)chunk * 2048 + 1024 + d] = h;
        }
    }
};

__device__ __forceinline__ void c_gate_phase(const Params& p, bf16_t* smem) {
    const bf16_t* XC = (const bf16_t*)(p.ws + W_H);
    const bf16_t* Wg = (const bf16_t*)(p.ws + W_C_G);
    float* Aa = (float*)(p.ws + W_BUF2);
    bf16_t* Bb = (bf16_t*)(p.ws + W_BUF1);
    Stage st;
    bool pre = false;
    for (int t = blockIdx.x; t < 129 * 16; t += gridDim.x) {
        const int mt = t >> 4, blk = (t >> 2) & 3, nt = t & 3;
        const int tn = t + gridDim.x, blkn = (tn >> 2) & 3;
        const bool hn = tn < 129 * 16;
        EpiGate e{XC, Aa, Bb, p.in[21], p.in[23], (const float*)(p.ws + W_SP), blk, nt, (float*)smem, (float*)(p.ws + W_CARRY)};
        gemm_tile<true>(XC + blk * 256, 1024, Wg + (size_t)blk * 512 * 256, 256, 256, mt * 128, nt * 128, smem, e, st, pre, hn,
                        XC + blkn * 256, Wg + (size_t)blkn * 512 * 256, (tn >> 4) * 128, (tn & 3) * 128);
        pre = hn;
    }
}

__device__ __forceinline__ void c_scan1_phase(const Params& p) {
    const float* Aa = (const float*)(p.ws + W_BUF2);
    const bf16_t* Bb = (const bf16_t*)(p.ws + W_BUF1);
    float* carry = (float*)(p.ws + W_CARRY);
    for (int it = blockIdx.x; it < 512; it += gridDim.x) {
        const int chunk = it >> 2, d = (it & 3) * 256 + threadIdx.x;
        float A = 1.f, h = 0.f;
        const size_t base = (size_t)chunk * 128 * 1024 + d;
#pragma unroll 8
        for (int r = 0; r < 128; ++r) {
            const float a = 1.0f - bf2f(((const bf16_t*)Aa)[base + (size_t)r * 1024]), b = bf2f(Bb[base + (size_t)r * 1024]);
            A *= a;
            h = a * h + b;
        }
        carry[(size_t)chunk * 2048 + d] = A;
        carry[(size_t)chunk * 2048 + 1024 + d] = h;
    }
}

__device__ __forceinline__ void c_scan2_phase(const Params& p) {
    const float* Aa = (const float*)(p.ws + W_BUF2);
    const bf16_t* Bb = (const bf16_t*)(p.ws + W_BUF1);
    const bf16_t* SG = Bb + (size_t)MT * 1024;
    const float* carry = (const float*)(p.ws + W_CARRY);
    bf16_t* Z = (bf16_t*)(p.ws + W_H);
    for (int it = blockIdx.x; it < 512 + 512; it += gridDim.x) {
        if (it < 512) {
            const int chunk = it >> 2, d = (it & 3) * 256 + threadIdx.x;
            const int b = chunk >> 6, ci = chunk & 63;
            float h = 0.f;
            {
                const float* c0 = carry + (size_t)(b * 64) * 2048 + d;
                int jc = 0;
                for (; jc + 16 <= ci; jc += 16) {
                    float ca[16], ch[16];
#pragma unroll
                    for (int q = 0; q < 16; ++q) { ca[q] = c0[(size_t)(jc + q) * 2048]; ch[q] = c0[(size_t)(jc + q) * 2048 + 1024]; }
#pragma unroll
                    for (int q = 0; q < 16; ++q) h = ca[q] * h + ch[q];
                }
                for (; jc < ci; ++jc) h = c0[(size_t)jc * 2048] * h + c0[(size_t)jc * 2048 + 1024];
            }
            const size_t base = (size_t)chunk * 128 * 1024 + d;
for (int r0 = 0; r0 < 128; r0 += 32) {
                float av[32];
                bf16_t bv[32], sv[32];
#pragma unroll
                for (int q = 0; q < 32; ++q) {
                    const size_t o = base + (size_t)(r0 + q) * 1024;
                    av[q] = 1.0f - bf2f(((const bf16_t*)Aa)[o]); bv[q] = Bb[o]; sv[q] = SG[o];
                }
#pragma unroll
                for (int q = 0; q < 32; ++q) {
                    h = av[q] * h + bf2f(bv[q]);
                    Z[base + (size_t)(r0 + q) * 1024] = (bf16_t)(cvt_pk(h * bf2f(sv[q]), 0.f) & 0xffff);
                }
            }
            if (ci == 63) p.out[O_CHP + (size_t)b * 1024 + d] = h;
        } else {
            const int s = it - 512, d = (s & 3) * 256 + threadIdx.x, b = s >> 2;
            const size_t o = (size_t)(M_P + b) * 1024 + d;
            const float h = (1.0f - bf2f(((const bf16_t*)Aa)[o])) * p.in[5][(size_t)b * 1024 + d] + bf2f(Bb[o]);
            Z[o] = (bf16_t)(cvt_pk(h * bf2f(SG[o]), 0.f) & 0xffff);
            p.out[O_CHS + (size_t)b * 1024 + d] = h;
        }
    }
}

constexpr int N_PHASES = 20;

__device__ __forceinline__ void run_phase(const Params& p, int ph, unsigned char* smem_raw) {
    bf16_t* smem = (bf16_t*)smem_raw;
    float* Y = (float*)(p.ws + W_BUF2);
    float* YP = (float*)(p.ws + W_YPART);
    float* X = p.out + O_X;
    bf16_t* XB = (bf16_t*)(p.ws + W_XB);
    bf16_t* RSB = (bf16_t*)(p.ws + W_RS);
    bf16_t* H = (bf16_t*)(p.ws + W_H);
    switch (ph) {
        case 0: prep_phase(p, smem_raw); break;
        case 1: a_in_phase(p, 0, smem); break;
        case 2: a_mix_phase(p, 0, smem); break;
        case 3: out_gemm_phase((const bf16_t*)(p.ws + W_BUF1), 2048, (const bf16_t*)(p.ws + W_A_OUT), Y, YP, smem); break;
        case 4: norm_phase(Y, YP, 8, p.in[0], p.in[1], XB, true, nullptr, p.in[7] + 0 * 1024, p.in[6] + 1 * 1024, RSB); break;
        case 5: b_in_phase(p, smem); break;
        case 6: b_attn_phase(p, smem_raw); break;
        case 7: out_gemm_phase(H, 1024, (const bf16_t*)(p.ws + W_B_OUT), Y, YP, smem); break;
        case 8: norm_phase(Y, YP, 4, nullptr, nullptr, XB, true, nullptr, p.in[7] + 1 * 1024, p.in[6] + 2 * 1024, RSB); break;
        case 9: c_in_phase(p, smem); break;
        case 10: c_conv_phase(p); break;
        case 11: c_gate_phase(p, smem); break;
        case 12: c_scan1_phase(p); break;
        case 13: c_scan2_phase(p); break;
        case 14: out_gemm_phase(H, 1024, (const bf16_t*)(p.ws + W_C_OUT), Y, YP, smem); break;
        case 15: norm_phase(Y, YP, 4, nullptr, nullptr, XB, true, nullptr, p.in[7] + 2 * 1024, p.in[6] + 3 * 1024, RSB); break;
        case 16: a_in_phase(p, 1, smem); break;
        case 17: a_mix_phase(p, 1, smem); break;
        case 18: out_gemm_phase((const bf16_t*)(p.ws + W_BUF1), 2048, (const bf16_t*)(p.ws + W_A_OUT) + (size_t)1024 * 2048, Y, YP, smem); break;
        case 19: norm_phase(Y, YP, 8, nullptr, nullptr, XB, false, X, p.in[7] + 3 * 1024, nullptr, H); break;
        default: break;
    }
}


#define XB_TMO      128
#define XB_XCNT(j)  (256  + 64 * (j))
#define XB_XSUB(j)  (1280 + 64 * (j))
#define XB_XGEN(j)  (2304 + 64 * (j))
#define XB_TOP      3328
#define XB_TOPGEN   3392
#define XCD_BAR_WORDS 3456
#define XB_SPIN_CAP (1u << 20)
__device__ __forceinline__ unsigned xb_ld(unsigned* p) { return __hip_atomic_load(p, __ATOMIC_RELAXED, __HIP_MEMORY_SCOPE_AGENT); }
__device__ __forceinline__ unsigned xb_add(unsigned* p, unsigned v) { return __hip_atomic_fetch_add(p, v, __ATOMIC_RELAXED, __HIP_MEMORY_SCOPE_AGENT); }
__device__ __forceinline__ unsigned xb_xcc_id() { return (unsigned)__builtin_amdgcn_s_getreg((3 << 11) | 20) & 0xFu; }
#define XB_SPIN(cond, bar) do { unsigned _sp = 0; while (cond) { __builtin_amdgcn_s_sleep(1); \
    if ((++_sp & 255u) == 0u) { if (xb_ld(&(bar)[XB_TMO])) break; if (_sp > XB_SPIN_CAP) { atomicAdd(&(bar)[XB_TMO], 1u); break; } } } } while (0)
struct XcdBarrier { unsigned* bar; unsigned x, nloc, nx; };
__device__ __forceinline__ void xcd_barrier_complete(unsigned* bar, unsigned x, unsigned& nloc, unsigned& nx) {
    const unsigned G = gridDim.x;
    unsigned sum, cnt, mine, sp = 0u;
    for (;;) {
        sum = 0u; cnt = 0u; mine = 0u;
#pragma unroll
        for (unsigned j = 0; j < 16; ++j) { const unsigned c = xb_ld(&bar[XB_XCNT(j)]); sum += c; cnt += (c > 0u) ? 1u : 0u; mine = (j == x) ? c : mine; }
        if (sum == G) break;
        __builtin_amdgcn_s_sleep(1);
        if ((++sp & 255u) == 0u) { if (xb_ld(&bar[XB_TMO])) break; if (sp > XB_SPIN_CAP) { atomicAdd(&bar[XB_TMO], 1u); break; } }
    }
    nloc = mine > 0u ? mine : 1u; nx = cnt > 0u ? cnt : 1u;
}
__device__ __forceinline__ void xcd_barrier(XcdBarrier& b) {
    asm volatile("s_waitcnt vmcnt(0)" ::: "memory");
    __syncthreads();
    if (threadIdx.x == 0) {
        unsigned* bar = b.bar;
        __builtin_amdgcn_s_waitcnt(0);
        if (b.nloc == 0u) xcd_barrier_complete(bar, b.x, b.nloc, b.nx);
        const unsigned nloc = b.nloc, nx = b.nx;
        const unsigned old = xb_add(&bar[XB_XSUB(b.x)], 1u);
        const unsigned gen = old / nloc;
        if (old + 1u == (gen + 1u) * nloc) {
            __builtin_amdgcn_fence(__ATOMIC_RELEASE, "agent");
            asm volatile("s_waitcnt vmcnt(0)" ::: "memory");
            const unsigned og = xb_add(&bar[XB_TOP], 1u);
            const unsigned tg = og / nx;
            if (og + 1u == (tg + 1u) * nx) xb_add(&bar[XB_TOPGEN], 1u);
            else XB_SPIN(xb_ld(&bar[XB_TOPGEN]) == tg, bar);
            __builtin_amdgcn_fence(__ATOMIC_ACQUIRE, "agent");
            xb_add(&bar[XB_XGEN(b.x)], 1u);
            asm volatile("s_waitcnt vmcnt(0)" ::: "memory");
        } else {
            XB_SPIN(xb_ld(&bar[XB_XGEN(b.x)]) == gen, bar);
            __builtin_amdgcn_fence(__ATOMIC_ACQUIRE, "agent");
            asm volatile("s_waitcnt vmcnt(0)" ::: "memory");
        }
    }
    __syncthreads();
}

#ifndef PROBE_K
#define PROBE_K 20
#endif
__device__ __forceinline__ void dump_phase(const Params& p) {
    const unsigned* base = (const unsigned*)(p.ws);
    const size_t nwords = W_END / 4, n = (size_t)MT * D;
    const size_t gt = (size_t)blockIdx.x * NTHREADS + threadIdx.x, gn = (size_t)gridDim.x * NTHREADS;
    for (size_t i = gt; i < n; i += gn) {
        float a = 0.f;
        for (int k = 0; k < 4; ++k) {
            const size_t w = i + (size_t)k * n;
            if (w < nwords) { const unsigned u = base[w]; a += (float)((u * 2654435761u) >> 29); }
        }
        p.out[i] = a;
    }
}
constexpr size_t W_BAR = W_END;
#define PHASE(i) if (p.ph_lo <= (i) && (i) < p.ph_hi) { if ((i) > p.ph_lo) xcd_barrier(xb); run_phase(p, (i), smem_raw); }
__global__ void __launch_bounds__(NTHREADS, 2) mega_kernel(Params p) {
    __shared__ __attribute__((aligned(16))) unsigned char smem_raw[SMEM_BYTES];
    XcdBarrier xb;
    xb.bar = (unsigned*)(p.ws + W_BAR); xb.x = xb_xcc_id(); xb.nloc = 0u; xb.nx = 0u;
    if (threadIdx.x == 0) (void)xb_add(&xb.bar[XB_XCNT(xb.x)], 1u);
    if (p.ph_lo < 0) cg::this_grid().sync();
    PHASE(0) PHASE(1) PHASE(2) PHASE(3) PHASE(4) PHASE(5) PHASE(6) PHASE(7) PHASE(8) PHASE(9)
    PHASE(10) PHASE(11) PHASE(13) PHASE(14) PHASE(15) PHASE(16) PHASE(17) PHASE(18) PHASE(19)
    if (ONE_LAUNCH && p.ph_hi < N_PHASES && p.ph_lo == 0) { xcd_barrier(xb); dump_phase(p); }
    if (!ONE_LAUNCH && p.ph_lo == N_PHASES) dump_phase(p);
}

extern "C" void kernel_launch(void* const* d_in, const int* in_sizes, int n_in, void* d_out, int out_size, void* d_ws, size_t ws_size,
                              hipStream_t stream) {
    static int grid = 0;
    if (grid == 0) {
        if (n_in != 26 || (size_t)out_size != O_END || ws_size < W_END + XCD_BAR_WORDS * 4) {
            fprintf(stderr, "kernel_launch: unexpected shapes n_in=%d out=%d ws=%zu (need %zu)\n", n_in, out_size, ws_size, (size_t)W_END);
            grid = -1;
            return;
        }
        int dev = 0, cus = 0, per_cu = 0;
        (void)hipGetDevice(&dev);
        (void)hipDeviceGetAttribute(&cus, hipDeviceAttributeMultiprocessorCount, dev);
        (void)hipOccupancyMaxActiveBlocksPerMultiprocessor(&per_cu, (const void*)mega_kernel, NTHREADS, 0);
        if (per_cu < 1) per_cu = 1;
        if (per_cu > 2) per_cu = 2;
        grid = cus * per_cu;
    }
    if (grid < 0) return;
    Params p{};
    for (int i = 0; i < 26; ++i) p.in[i] = (const float*)d_in[i];
    p.out = (float*)d_out;
    p.ws = (unsigned char*)d_ws;
#if ONE_LAUNCH
    (void)hipMemsetAsync((unsigned char*)d_ws + W_BAR, 0, XCD_BAR_WORDS * 4, stream);
    p.ph_lo = 0;
    p.ph_hi = PROBE_K;
    void* args[] = {&p};
    hipError_t e = hipLaunchCooperativeKernel((const void*)mega_kernel, dim3(grid), dim3(NTHREADS), args, 0, stream);
    if (e != hipSuccess) fprintf(stderr, "cooperative launch failed: %s (grid %d)\n", hipGetErrorString(e), grid);
#else
    for (int ph = 0; ph < N_PHASES; ++ph) {
        p.ph_lo = ph;
        p.ph_hi = ph + 1;
        hipLaunchKernelGGL(mega_kernel, dim3(grid), dim3(NTHREADS), 0, stream, p);
    }
#endif
}
```

```cpp
#include <hip/hip_runtime.h>
#include <hip/hip_cooperative_groups.h>
#include <stdint.h>
#include <stdio.h>
#include <math.h>
namespace cg = cooperative_groups;

#ifndef ONE_LAUNCH
#define ONE_LAUNCH 1
#endif

typedef unsigned short bf16_t;
typedef short bf16x8 __attribute__((ext_vector_type(8)));
typedef float f32x4 __attribute__((ext_vector_type(4)));
typedef unsigned u32x4 __attribute__((ext_vector_type(4)));
typedef unsigned u32x2 __attribute__((ext_vector_type(2)));

constexpr int M_P = 16384, M_S = 128, MT = 16512, D = 1024, SEQ = 8192;
constexpr int NTHREADS = 256;
constexpr int SMEM_BYTES = 65536;

constexpr size_t O_X = 0;
constexpr size_t O_AV = (size_t)MT * D;
constexpr size_t O_BKP = O_AV + 2 * 128 * 2048;
constexpr size_t O_BVP = O_BKP + 2 * 128 * 128;
constexpr size_t O_BKS = O_BVP + 2 * 128 * 128;
constexpr size_t O_BVS = O_BKS + 128 * 128 * 128;
constexpr size_t O_CCP = O_BVS + 128 * 128 * 128;
constexpr size_t O_CHP = O_CCP + 2 * 3 * 1024;
constexpr size_t O_CCS = O_CHP + 2 * 1024;
constexpr size_t O_CHS = O_CCS + 128 * 3 * 1024;
constexpr size_t O_END = O_CHS + 128 * 1024;

constexpr size_t W_A_IN = 0;
constexpr size_t W_A_OUT = W_A_IN + (size_t)2 * 6144 * 1024 * 2;
constexpr size_t W_B_IN = W_A_OUT + (size_t)2 * 1024 * 2048 * 2;
constexpr size_t W_B_OUT = W_B_IN + (size_t)2304 * 1024 * 2;
constexpr size_t W_C_IN = W_B_OUT + (size_t)1024 * 1024 * 2;
constexpr size_t W_C_G = W_C_IN + (size_t)2048 * 1024 * 2;
constexpr size_t W_C_OUT = W_C_G + (size_t)4 * 512 * 256 * 2;
constexpr size_t W_WS_A = W_C_OUT + (size_t)1024 * 1024 * 2;
constexpr size_t W_ROPE = W_WS_A + (size_t)2 * 4 * 128 * 128 * 2;
constexpr size_t W_H = W_ROPE + (size_t)8193 * 64 * 4;
constexpr size_t W_BUF1 = W_H + (size_t)MT * 1024 * 2;
constexpr size_t W_BUF2 = W_BUF1 + (size_t)MT * 2048 * 2;
constexpr size_t W_KB = W_BUF2 + (size_t)MT * 2048 * 2;
constexpr size_t W_STATS = W_KB;
constexpr size_t W_CARRY = W_KB + (size_t)MT * 256 * 2;
constexpr size_t W_YPART = W_CARRY + (size_t)128 * 1024 * 2 * 4;
constexpr size_t W_XB = W_YPART + (size_t)8 * 128 * 1024 * 4;
constexpr size_t W_SP = W_XB + (size_t)MT * 1024 * 2;
constexpr size_t W_RS = W_SP + 4096;
constexpr size_t W_END = W_RS + (size_t)MT * 4;

struct Params {
    const float* in[26];
    float* out;
    unsigned char* ws;
    int ph_lo, ph_hi;
};

__device__ __forceinline__ unsigned cvt_pk(float lo, float hi) {
    unsigned r;
    asm("v_cvt_pk_bf16_f32 %0, %1, %2" : "=v"(r) : "v"(lo), "v"(hi));
    return r;
}
__device__ __forceinline__ float bf_lo(unsigned u) { return __uint_as_float(u << 16); }
__device__ __forceinline__ float bf_hi(unsigned u) { return __uint_as_float(u & 0xffff0000u); }
__device__ __forceinline__ float bf2f(bf16_t h) { return __uint_as_float(((unsigned)h) << 16); }
__device__ __forceinline__ float sigmoid_f(float x) { return __builtin_amdgcn_rcpf(1.f + __expf(-x)); }
__device__ __forceinline__ float silu_f(float x) { return x * sigmoid_f(x); }
__device__ __forceinline__ float gelu_f(float x) { return x * sigmoid_f(1.5957691216057308f * (x + 0.044715f * x * x * x)); }
__device__ __forceinline__ float gelu_silu(float u, float g) {
    const float eu = __expf(-1.5957691216057308f * (u + 0.044715f * u * u * u)), eg = __expf(-g);
    const float den = (1.f + eu) * (1.f + eg);
    return (u * g) * __builtin_amdgcn_rcpf(den);
}
template <int CTRL> __device__ __forceinline__ float dpp_add(float x) {
    return x + __builtin_bit_cast(float, __builtin_amdgcn_update_dpp(0, __builtin_bit_cast(int, x), CTRL, 0xF, 0xF, true));
}
__device__ __forceinline__ float row16_sum(float x) {
    x = dpp_add<0xB1>(x);
    x = dpp_add<0x4E>(x);
    x = dpp_add<0x141>(x);
    x = dpp_add<0x140>(x);
    return x;
}
__device__ __forceinline__ float wave_sum(float v) {
#pragma unroll
    for (int o = 1; o < 64; o <<= 1) v += __shfl_xor(v, o);
    return v;
}

__device__ __forceinline__ int perm32(int rho) { return 8 * ((rho & 15) >> 2) + 4 * (rho >> 4) + (rho & 3); }
__device__ __forceinline__ int permcol(int c) { return (c & ~31) + perm32(c & 31); }
__device__ __forceinline__ int swz(int row, int chunk) { return (chunk ^ (((row >> 3) & 1) << 1)) * 8; }

template <bool TRANS>
__device__ __forceinline__ void mma_stage(const bf16_t* As, const bf16_t* Bs, int apanel, int bpanel, f32x4 (&acc)[4][4], int wr, int wc, int lane) {
    const int fr = lane & 15, fq = lane >> 4;
    const int co = swz(fr, fq);
#pragma unroll
    for (int kk = 0; kk < 2; ++kk) {
        bf16x8 a[4], b[4];
#pragma unroll
        for (int i = 0; i < 4; ++i) {
            a[i] = *(const bf16x8*)(As + kk * apanel + (wr * 64 + i * 16 + fr) * 32 + co);
            b[i] = *(const bf16x8*)(Bs + kk * bpanel + (wc * 64 + i * 16 + fr) * 32 + co);
        }
#pragma unroll
        for (int i = 0; i < 4; ++i)
#pragma unroll
            for (int j = 0; j < 4; ++j)
                acc[i][j] = TRANS ? __builtin_amdgcn_mfma_f32_16x16x32_bf16(b[j], a[i], acc[i][j], 0, 0, 0)
                                  : __builtin_amdgcn_mfma_f32_16x16x32_bf16(a[i], b[j], acc[i][j], 0, 0, 0);
    }
}

__device__ __forceinline__ void g2r(const bf16_t* __restrict__ g, int ld, int row0, int k0, int tid, u32x4 (&r)[4]) {
    const int rl = 2 * (tid >> 4) + ((tid >> 2) & 1), kc = ((tid >> 3) & 1) * 4 + (tid & 3);
    const unsigned voff = (unsigned)(rl * ld + kc * 8) * 2u;
#pragma unroll
    for (int i = 0; i < 4; ++i) {
        const char* b = (const char*)(g + (size_t)(row0 + 32 * i) * ld + k0);
        r[i] = *(const u32x4*)(b + voff);
    }
}
__device__ __forceinline__ void r2s(bf16_t* s, int tid, const u32x4 (&r)[4]) {
    const int rl = 2 * (tid >> 4) + ((tid >> 2) & 1), kc = ((tid >> 3) & 1) * 4 + (tid & 3);
#pragma unroll
    for (int i = 0; i < 4; ++i) {
        const int row = rl + 32 * i;
        *(u32x4*)(s + (kc >> 2) * 4096 + row * 32 + swz(row, kc & 3)) = r[i];
    }
}

__device__ __forceinline__ void g2r32(const bf16_t* __restrict__ g, int ld, int row0, int k0, int tid, u32x4 (&r)[2]) {
    const unsigned voff = (unsigned)((tid >> 2) * ld + (tid & 3) * 8) * 2u;
#pragma unroll
    for (int i = 0; i < 2; ++i) {
        const char* b = (const char*)(g + (size_t)(row0 + 64 * i) * ld + k0);
        r[i] = *(const u32x4*)(b + voff);
    }
}
__device__ __forceinline__ void r2s32(bf16_t* s, int tid, const u32x4 (&r)[2]) {
#pragma unroll
    for (int i = 0; i < 2; ++i) {
        const int row = (tid >> 2) + 64 * i;
        *(u32x4*)(s + row * 32 + swz(row, tid & 3)) = r[i];
    }
}
__device__ __forceinline__ void ldfrag(const bf16_t* st, bf16x8 (&a)[4], bf16x8 (&b)[4], int wr, int wc, int fr, int co) {
#pragma unroll
    for (int i = 0; i < 4; ++i) {
        a[i] = *(const bf16x8*)(st + (wr * 64 + i * 16 + fr) * 32 + co);
        b[i] = *(const bf16x8*)(st + 4096 + (wc * 64 + i * 16 + fr) * 32 + co);
    }
}
template <bool TRANS>
__device__ __forceinline__ void mma16(const bf16x8 (&a)[4], const bf16x8 (&b)[4], f32x4 (&acc)[4][4]) {
    __builtin_amdgcn_s_setprio(1);
#pragma unroll
    for (int i = 0; i < 4; ++i)
#pragma unroll
        for (int j = 0; j < 4; ++j)
            acc[i][j] = TRANS ? __builtin_amdgcn_mfma_f32_16x16x32_bf16(b[j], a[i], acc[i][j], 0, 0, 0)
                              : __builtin_amdgcn_mfma_f32_16x16x32_bf16(a[i], b[j], acc[i][j], 0, 0, 0);
    __builtin_amdgcn_s_setprio(0);
}

struct Stage { u32x4 ra0[2], rb0[2], ra1[2], rb1[2]; };

template <bool TRANS, class Epi>
__device__ __forceinline__ void gemm_tile(const bf16_t* __restrict__ A, int lda, const bf16_t* __restrict__ Bt, int ldb, int K, int m0, int n0,
                                          bf16_t* smem, const Epi epi, Stage& st, bool pre, bool has_next, const bf16_t* __restrict__ An,
                                          const bf16_t* __restrict__ Bn, int m0n, int n0n) {
    const int tid = threadIdx.x, wid = tid >> 6, lane = tid & 63, wr = wid >> 1, wc = wid & 1, fr = lane & 15, fq = lane >> 4;
    const int co = swz(fr, fq);
    f32x4 acc[4][4];
#pragma unroll
    for (int i = 0; i < 4; ++i)
#pragma unroll
        for (int j = 0; j < 4; ++j) acc[i][j] = (f32x4){0.f, 0.f, 0.f, 0.f};
    const int nk = K >> 5;
    bf16x8 a0[4], b0[4], a1[4], b1[4];
    if (!pre) {
        g2r32(A, lda, m0, 0, tid, st.ra0);
        g2r32(Bt, ldb, n0, 0, tid, st.rb0);
        g2r32(A, lda, m0, 32, tid, st.ra1);
        g2r32(Bt, ldb, n0, 32, tid, st.rb1);
    }
    __syncthreads();
    r2s32(smem, tid, st.ra0);
    r2s32(smem + 4096, tid, st.rb0);
    r2s32(smem + 8192, tid, st.ra1);
    r2s32(smem + 8192 + 4096, tid, st.rb1);
    g2r32(A, lda, m0, 64, tid, st.ra0);
    g2r32(Bt, ldb, n0, 64, tid, st.rb0);
    g2r32(A, lda, m0, 96, tid, st.ra1);
    g2r32(Bt, ldb, n0, 96, tid, st.rb1);
    __syncthreads();
    ldfrag(smem, a0, b0, wr, wc, fr, co);
    for (int kt = 0; kt < nk; kt += 2) {
        {
            bf16_t* w = smem + ((kt + 2) & 3) * 8192;
            r2s32(w, tid, st.ra0);
            r2s32(w + 4096, tid, st.rb0);
            const int kn = (kt + 4 < nk ? kt + 4 : nk - 1) * 32;
            g2r32(A, lda, m0, kn, tid, st.ra0);
            g2r32(Bt, ldb, n0, kn, tid, st.rb0);
            ldfrag(smem + ((kt + 1) & 3) * 8192, a1, b1, wr, wc, fr, co);
            mma16<TRANS>(a0, b0, acc);
            __syncthreads();
        }
        {
            bf16_t* w = smem + ((kt + 3) & 3) * 8192;
            r2s32(w, tid, st.ra1);
            r2s32(w + 4096, tid, st.rb1);
            const int kn = (kt + 5 < nk ? kt + 5 : nk - 1) * 32;
            g2r32(A, lda, m0, kn, tid, st.ra1);
            g2r32(Bt, ldb, n0, kn, tid, st.rb1);
            ldfrag(smem + ((kt + 2) & 3) * 8192, a0, b0, wr, wc, fr, co);
            mma16<TRANS>(a1, b1, acc);
            __syncthreads();
        }
    }
    if (has_next) {
        g2r32(An, lda, m0n, 0, tid, st.ra0);
        g2r32(Bn, ldb, n0n, 0, tid, st.rb0);
        g2r32(An, lda, m0n, 32, tid, st.ra1);
        g2r32(Bn, ldb, n0n, 32, tid, st.rb1);
    }
    epi(acc, m0, n0, wr, wc, lane);
}

__device__ __forceinline__ void wt_tile(const float* colptr, int ldsrc, bf16_t* dst, int ldd, float* tile, int tid, const float* ksc = nullptr) {
    const int tx = tid & 63, ty = tid >> 6;
    float v[16];
#pragma unroll
    for (int q = 0; q < 16; ++q) v[q] = colptr[(size_t)(ty + 4 * q) * ldsrc];
    if (ksc) {
#pragma unroll
        for (int q = 0; q < 16; ++q) v[q] *= ksc[ty + 4 * q];
    }
#pragma unroll
    for (int q = 0; q < 16; ++q) tile[(ty + 4 * q) * 65 + tx] = v[q];
    __syncthreads();
    const int c2 = tid & 31, r0 = tid >> 5;
#pragma unroll
    for (int rr = r0; rr < 64; rr += 8)
        *(unsigned*)(dst + (size_t)rr * ldd + 2 * c2) = cvt_pk(tile[(2 * c2) * 65 + rr], tile[(2 * c2 + 1) * 65 + rr]);
    __syncthreads();
}

__device__ __forceinline__ void sincos_d(double x, double& s, double& c) {
    const double k = rint(x * 0.63661977236758134308);
    double r = fma(-k, 1.57079632673412561417e+00, x);
    r = fma(-k, 6.07710050650619224932e-11, r);
    const double z = r * r;
    const double sp = r + r * z * (-1.66666666666666324348e-01 + z * (8.33333333332248946124e-03 + z * (-1.98412698298579493134e-04 + z * (2.75573137070700676789e-06 + z * (-2.50507602534068634195e-08 + z * 1.58969099521155010221e-10)))));
    const double cp = 1.0 - 0.5 * z + z * z * (4.16666666666666019037e-02 + z * (-1.38888888888741095749e-03 + z * (2.48015872894767294178e-05 + z * (-2.75573143513906633035e-07 + z * (2.08757232129817482790e-09 + z * -1.13596475577881948265e-11)))));
    const int q = ((int)k) & 3;
    s = (q == 0) ? sp : (q == 1) ? cp : (q == 2) ? -sp : -cp;
    c = (q == 0) ? cp : (q == 1) ? -sp : (q == 2) ? -cp : sp;
}

__device__ __forceinline__ void norm_phase(const float* __restrict__ Y, const float* __restrict__ Ypart, int nsplit, const float* xin_p, const float* xin_s,
                                           bf16_t* Xb, bool storeXb, float* Xf, const float* gpost, const float* gpre, bf16_t* H) {
    const int lane = threadIdx.x & 63;
    const int gw = blockIdx.x * 4 + (threadIdx.x >> 6), nw = gridDim.x * 4;
    for (int ri = gw; ri < MT; ri += nw) {
        const int row = ri < M_S ? M_P + ri : ri - M_S;
        f32x4 x[4];
        if (xin_p) {
            const float* xr = row < M_P ? xin_p + (size_t)row * D : xin_s + (size_t)(row - M_P) * D;
#pragma unroll
            for (int j = 0; j < 4; ++j) x[j] = *(const f32x4*)(xr + j * 256 + lane * 4);
        } else {
#pragma unroll
            for (int j = 0; j < 4; ++j) {
                const u32x2 w = *(const u32x2*)(Xb + (size_t)row * D + j * 256 + lane * 4);
                x[j] = (f32x4){bf_lo(w.x), bf_hi(w.x), bf_lo(w.y), bf_hi(w.y)};
            }
        }
        if (Y) {
            f32x4 y[4];
            float ss = 0.f;
            if (row < M_P) {
#pragma unroll
                for (int j = 0; j < 4; ++j) {
                    const u32x2 w = *(const u32x2*)((const bf16_t*)Y + (size_t)row * D + j * 256 + lane * 4);
                    y[j] = (f32x4){bf_lo(w.x), bf_hi(w.x), bf_lo(w.y), bf_hi(w.y)};
                }
            } else {
#pragma unroll
                for (int j = 0; j < 4; ++j) y[j] = (f32x4){0.f, 0.f, 0.f, 0.f};
                for (int s = 0; s < nsplit; s += 4) {
                    f32x4 t[4][4];
#pragma unroll
                    for (int u = 0; u < 4; ++u)
#pragma unroll
                        for (int j = 0; j < 4; ++j) t[u][j] = *(const f32x4*)(Ypart + ((size_t)(s + u) * 128 + (row - M_P)) * D + j * 256 + lane * 4);
#pragma unroll
                    for (int u = 0; u < 4; ++u)
#pragma unroll
                        for (int j = 0; j < 4; ++j) y[j] += t[u][j];
                }
            }
#pragma unroll
            for (int j = 0; j < 4; ++j) ss += y[j].x * y[j].x + y[j].y * y[j].y + y[j].z * y[j].z + y[j].w * y[j].w;
            ss = wave_sum(ss);
            const float rstd = rsqrtf(ss * (1.f / 1024.f) + 1e-6f);
#pragma unroll
            for (int j = 0; j < 4; ++j) {
                const f32x4 g = *(const f32x4*)(gpost + j * 256 + lane * 4);
                x[j] = x[j] + y[j] * rstd * g;
            }
        }
        if (storeXb) {
#pragma unroll
            for (int j = 0; j < 4; ++j) {
                u32x2 w;
                w.x = cvt_pk(x[j].x, x[j].y);
                w.y = cvt_pk(x[j].z, x[j].w);
                *(u32x2*)(Xb + (size_t)row * D + j * 256 + lane * 4) = w;
            }
        }
        if (Xf) {
#pragma unroll
            for (int j = 0; j < 4; ++j) *(f32x4*)(Xf + (size_t)row * D + j * 256 + lane * 4) = x[j];
        }
        if (gpre) {
            float ss = 0.f;
#pragma unroll
            for (int j = 0; j < 4; ++j) ss += x[j].x * x[j].x + x[j].y * x[j].y + x[j].z * x[j].z + x[j].w * x[j].w;
            ss = wave_sum(ss);
            if (lane == 0) ((float*)H)[row] = rsqrtf(ss * (1.f / 1024.f) + 1e-6f);
        }
    }
}

constexpr int WT_FIRST = 96 * 16;
constexpr int WT_TOTAL = 2 * 96 * 16 + 2 * 16 * 32 + 36 * 16 + 256 + 32 * 16 + 128 + 256;
__device__ __forceinline__ void wt_jobs(const Params& p, unsigned char* smem, int lo, int hi, int w, int nw) {
    float* tile = (float*)smem;
    const int tid = threadIdx.x, tx = tid & 63;
    constexpr int T_AIN = 96 * 16, T_AOUT = 16 * 32, T_BIN = 36 * 16, T_BOUT = 256, T_CIN = 32 * 16, T_CG = 128, T_COUT = 256;
    for (int it = lo + w; it < hi; it += nw) {
        int r = it;
        if (r < 2 * T_AIN) {
            const int j = r / T_AIN; r -= j * T_AIN;
            const int nt = r >> 4, kt = r & 15, np = permcol(nt * 64 + tx);
            int col;
            const int T = np >> 7, w = np & 127;
            if (T < 32) {
                const int wc = w >> 6, jn = (w >> 4) & 3, i = w & 15;
                col = ((jn < 2) ? 0 : 4096) + 64 * T + 32 * wc + 16 * (jn & 1) + i;
            } else col = 2048 + (np - 4096);
            wt_tile(p.in[8] + (size_t)j * 1024 * 6144 + (size_t)(kt * 64) * 6144 + col, 6144,
                    (bf16_t*)(p.ws + W_A_IN) + (size_t)j * 6144 * 1024 + (size_t)(nt * 64) * 1024 + kt * 64, 1024, tile, tid, p.in[6] + (j == 0 ? 0 : 3) * 1024 + kt * 64);
            continue;
        }
        r -= 2 * T_AIN;
        if (r < 2 * T_AOUT) {
            const int j = r / T_AOUT; r -= j * T_AOUT;
            const int nt = r >> 5, kt = r & 31;
            wt_tile(p.in[13] + (size_t)j * 2048 * 1024 + (size_t)(kt * 64) * 1024 + permcol(nt * 64 + tx), 1024,
                    (bf16_t*)(p.ws + W_A_OUT) + (size_t)j * 1024 * 2048 + (size_t)(nt * 64) * 2048 + kt * 64, 2048, tile, tid);
            continue;
        }
        r -= 2 * T_AOUT;
        if (r < T_BIN) {
            const int nt = r >> 4, kt = r & 15;
            wt_tile(p.in[14] + (size_t)(kt * 64) * 2304 + permcol(nt * 64 + tx), 2304, (bf16_t*)(p.ws + W_B_IN) + (size_t)(nt * 64) * 1024 + kt * 64, 1024, tile, tid, p.in[6] + 1 * 1024 + kt * 64);
            continue;
        }
        r -= T_BIN;
        if (r < T_BOUT) {
            const int nt = r >> 4, kt = r & 15;
            wt_tile(p.in[16] + (size_t)(kt * 64) * 1024 + permcol(nt * 64 + tx), 1024, (bf16_t*)(p.ws + W_B_OUT) + (size_t)(nt * 64) * 1024 + kt * 64, 1024, tile, tid);
            continue;
        }
        r -= T_BOUT;
        if (r < T_CIN) {
            const int nt = r >> 4, kt = r & 15;
            wt_tile(p.in[17] + (size_t)(kt * 64) * 2048 + permcol(nt * 64 + tx), 2048, (bf16_t*)(p.ws + W_C_IN) + (size_t)(nt * 64) * 1024 + kt * 64, 1024, tile, tid, p.in[6] + 2 * 1024 + kt * 64);
            continue;
        }
        r -= T_CIN;
        if (r < T_CG) {
            const int blk = r >> 5, rr = r & 31, nt = rr >> 2, kt = rr & 3;
            const int np = permcol(nt * 64 + tx), j4 = np >> 7, w = np & 127, wc = w >> 6, jn = (w >> 4) & 3, i = w & 15;
            const int dl = 64 * j4 + 32 * wc + 16 * (jn & 1) + i;
            const float* src = ((jn < 2) ? p.in[20] : p.in[22]) + (size_t)blk * 65536;
            wt_tile(src + (size_t)(kt * 64) * 256 + dl, 256, (bf16_t*)(p.ws + W_C_G) + (size_t)blk * 512 * 256 + (size_t)(nt * 64) * 256 + kt * 64, 256, tile, tid);
            continue;
        }
        r -= T_CG;
        {
            const int nt = r >> 4, kt = r & 15;
            wt_tile(p.in[24 + 1] + (size_t)(kt * 64) * 1024 + permcol(nt * 64 + tx), 1024, (bf16_t*)(p.ws + W_C_OUT) + (size_t)(nt * 64) * 1024 + kt * 64, 1024, tile, tid);
        }
    }
}

__device__ __forceinline__ void prep_phase(const Params& p, unsigned char* smem) {
    const int tid = threadIdx.x;
    wt_jobs(p, smem, 0, WT_FIRST, blockIdx.x, gridDim.x);
    const int gt = blockIdx.x * NTHREADS + tid, gn = gridDim.x * NTHREADS;
    {
        bf16_t* wsa = (bf16_t*)(p.ws + W_WS_A);
        const float* src = p.in[11];
        for (int idx = gt; idx < 2 * 4 * 128 * 128 / 2; idx += gn) {
            const int e = idx * 2, t = (e >> 7) & 127, s = e & 127;
            const float a = (s <= t) ? src[e] : 0.f, b = (s + 1 <= t) ? src[e + 1] : 0.f;
            *(unsigned*)(wsa + e) = cvt_pk(a, b);
        }
    }
    if (gt < 1024) ((float*)(p.ws + W_SP))[gt] = log1pf(__expf(-p.in[24][gt]));
    {
        float* rt = (float*)(p.ws + W_ROPE);
        for (int idx = gt; idx < 8193 * 32; idx += gn) {
            const int pos = idx >> 5, i = idx & 31;
            const float ang = (float)pos * exp2f(-(float)i * (13.287712379549449f / 32.0f));
            double s, c;
            sincos_d((double)ang, s, c);
            rt[pos * 64 + i] = (float)c;
            rt[pos * 64 + 32 + i] = (float)s;
        }
    }
    norm_phase(nullptr, nullptr, 0, p.in[0], p.in[1], (bf16_t*)(p.ws + W_XB), true, nullptr, nullptr, p.in[6], (bf16_t*)(p.ws + W_RS));
}

struct EpiUG {
    bf16_t* P;
    int T;
    const float* rs;
    __device__ __forceinline__ void operator()(f32x4 (&acc)[4][4], int m0, int n0, int wr, int wc, int lane) const {
        const int fr = lane & 15, fq = lane >> 4;
#pragma unroll
        for (int i = 0; i < 4; ++i) {
            const int m = m0 + wr * 64 + i * 16 + fr;
            const int ch = 64 * T + 32 * wc + 8 * fq;
            const float sc = rs[m];
            u32x4 w;
            {
                const f32x4 u = acc[i][0] * sc, g = acc[i][2] * sc;
                w.x = cvt_pk(gelu_silu(u.x, g.x), gelu_silu(u.y, g.y));
                w.y = cvt_pk(gelu_silu(u.z, g.z), gelu_silu(u.w, g.w));
            }
            {
                const f32x4 u = acc[i][1] * sc, g = acc[i][3] * sc;
                w.z = cvt_pk(gelu_silu(u.x, g.x), gelu_silu(u.y, g.y));
                w.w = cvt_pk(gelu_silu(u.z, g.z), gelu_silu(u.w, g.w));
            }
            *(u32x4*)(P + (size_t)m * 2048 + ch) = w;
        }
    }
};
struct EpiV {
    bf16_t* GVt;
    float* stats;
    int mt, tv;
    const float* rs;
    __device__ __forceinline__ void operator()(f32x4 (&acc)[4][4], int m0, int n0, int wr, int wc, int lane) const {
        const int fr = lane & 15, fq = lane >> 4;
#pragma unroll
        for (int i = 0; i < 4; ++i) {
            const int sl = wr * 64 + i * 16 + fq * 4;
            f32x4 sum = {0.f, 0.f, 0.f, 0.f}, sq = {0.f, 0.f, 0.f, 0.f};
#pragma unroll
            for (int jn = 0; jn < 4; ++jn) {
                const int ch = 128 * tv + wc * 64 + 32 * (jn >> 1) + perm32(16 * (jn & 1) + fr);
                f32x4 v = acc[i][jn] * *(const f32x4*)(rs + m0 + sl);
                v.x = gelu_f(v.x); v.y = gelu_f(v.y); v.z = gelu_f(v.z); v.w = gelu_f(v.w);
                u32x2 w;
                w.x = cvt_pk(v.x, v.y);
                w.y = cvt_pk(v.z, v.w);
                *(u32x2*)(GVt + ((size_t)mt * 2048 + ch) * 128 + sl) = w;
                sum += v;
                sq += v * v;
            }
            sum.x = row16_sum(sum.x); sum.y = row16_sum(sum.y); sum.z = row16_sum(sum.z); sum.w = row16_sum(sum.w);
            sq.x = row16_sum(sq.x); sq.y = row16_sum(sq.y); sq.z = row16_sum(sq.z); sq.w = row16_sum(sq.w);
            if (fr == 0) {
                float* st = stats + (size_t)(m0 + sl) * 64 + (tv * 2 + wc) * 2;
                st[0] = sum.x; st[1] = sq.x;
                st[64] = sum.y; st[65] = sq.y;
                st[128] = sum.z; st[129] = sq.z;
                st[192] = sum.w; st[193] = sq.w;
            }
        }
    }
};

__device__ __forceinline__ void a_in_phase(const Params& p, int j, bf16_t* smem) {
    const bf16_t* H = (const bf16_t*)(p.ws + W_XB);
    const float* RS = (const float*)(p.ws + W_RS);
    const bf16_t* Wt = (const bf16_t*)(p.ws + W_A_IN) + (size_t)j * 6144 * 1024;
    bf16_t* P = (bf16_t*)(p.ws + W_BUF1);
    bf16_t* GVt = (bf16_t*)(p.ws + W_BUF2);
    float* stats = (float*)(p.ws + W_STATS);
    Stage st;
    bool pre = false;
    for (int t = blockIdx.x; t < 129 * 48; t += gridDim.x) {
        const int mt = t / 48, nt = t % 48;
        const int tn = t + gridDim.x;
        const bool hn = tn < 129 * 48;
        const int m0n = (tn / 48) * 128, n0n = (tn % 48) * 128;
        if (nt < 32) {
            EpiUG e{P, nt, RS};
            gemm_tile<true>(H, 1024, Wt, 1024, 1024, mt * 128, nt * 128, smem, e, st, pre, hn, H, Wt, m0n, n0n);
        } else {
            EpiV e{GVt, stats, mt, nt - 32, RS};
            gemm_tile<false>(H, 1024, Wt, 1024, 1024, mt * 128, nt * 128, smem, e, st, pre, hn, H, Wt, m0n, n0n);
        }
        pre = hn;
    }
    if (j == 0) {
        const int busy = (129 * 48) % gridDim.x, idle = gridDim.x - busy;
        if (idle > 0 && (int)blockIdx.x >= busy) wt_jobs(p, (unsigned char*)smem, WT_FIRST, WT_TOTAL, blockIdx.x - busy, idle);
        else if (idle <= 0) wt_jobs(p, (unsigned char*)smem, WT_FIRST, WT_TOTAL, blockIdx.x, gridDim.x);
    }
}

__device__ __forceinline__ void a_mix_phase(const Params& p, int j, bf16_t* smem) {
    const int tid = threadIdx.x, wid = tid >> 6, lane = tid & 63, wr = wid >> 1, wc = wid & 1, fr = lane & 15, fq = lane >> 4;
    bf16_t* P = (bf16_t*)(p.ws + W_BUF1);
    const bf16_t* GVt = (const bf16_t*)(p.ws + W_BUF2);
    const float* stats = (const float*)(p.ws + W_STATS);
    const bf16_t* wsa = (const bf16_t*)(p.ws + W_WS_A) + (size_t)j * 4 * 128 * 128;
    const float* ln_g = p.in[9] + j * 2048;
    const float* ln_b = p.in[10] + j * 2048;
    const float* b_s = p.in[12] + j * 4 * 128;
    const float* w_s = p.in[11] + (size_t)j * 4 * 128 * 128;
    float* av_out = p.out + O_AV + (size_t)j * 128 * 2048;
    bf16_t* As = smem;
    bf16_t* Bs = smem + 16384;
    float* mu = (float*)(smem + 16384);
    float* rs = mu + 128;
    for (int it = blockIdx.x; it < 129 * 16; it += gridDim.x) {
        const int chunk = it >> 4, g = (it >> 2) & 3, slab = it & 3;
        const bool samp = (chunk == 128);
        f32x4 sv[8];
        {
            const float* stp = stats + (size_t)(chunk * 128 + (tid >> 1)) * 64 + (tid & 1) * 32;
#pragma unroll
            for (int k = 0; k < 8; ++k) sv[k] = *(const f32x4*)(stp + k * 4);
        }
        u32x4 araw[8], braw[8];
        float lg[8], lb[8];
        const float w00 = w_s[g * 16384];
        {
            const bf16_t* wg = wsa + g * 16384;
#pragma unroll
            for (int i = 0; i < 8; ++i) {
                const int c = tid + 256 * i, row = c >> 4, sc = c & 15;
                araw[i] = (u32x4){0u, 0u, 0u, 0u};
                if (!samp) araw[i] = *(const u32x4*)(wg + row * 128 + sc * 8);
                const int ch = g * 512 + slab * 128 + permcol(row);
                braw[i] = *(const u32x4*)(GVt + ((size_t)chunk * 2048 + ch) * 128 + sc * 8);
                lg[i] = ln_g[ch];
                lb[i] = ln_b[ch];
            }
        }
        float s = 0.f, q = 0.f;
#pragma unroll
        for (int k = 0; k < 8; ++k) { s += sv[k].x + sv[k].z; q += sv[k].y + sv[k].w; }
        s += __shfl_xor(s, 1);
        q += __shfl_xor(q, 1);
        const float mean = s * (1.f / 2048.f);
        const float var = fmaxf(q * (1.f / 2048.f) - mean * mean, 0.f);
        __syncthreads();
        if ((tid & 1) == 0) { mu[tid >> 1] = mean; rs[tid >> 1] = rsqrtf(var + 1e-5f); }
        if (samp) {
#pragma unroll
            for (int i = 0; i < 8; ++i) {
                const int c = tid + 256 * i, row = c >> 4, sc = c & 15;
                if ((row >> 3) == sc) {
                    const unsigned lo = cvt_pk(w00, 0.f), hi = cvt_pk(0.f, w00);
                    const int e = row & 7;
                    const unsigned val = (e & 1) ? hi : lo;
                    if ((e >> 1) == 0) araw[i].x = val; else if ((e >> 1) == 1) araw[i].y = val; else if ((e >> 1) == 2) araw[i].z = val; else araw[i].w = val;
                }
            }
        }
#pragma unroll
        for (int i = 0; i < 8; ++i) {
            const int c = tid + 256 * i, row = c >> 4, sc = c & 15;
            *(u32x4*)(As + (sc >> 2) * 4096 + row * 32 + swz(row, sc & 3)) = araw[i];
        }
        __syncthreads();
        float mur[8], rsr[8];
#pragma unroll
        for (int e = 0; e < 8; ++e) { mur[e] = mu[(tid & 15) * 8 + e]; rsr[e] = rs[(tid & 15) * 8 + e]; }
        __syncthreads();
#pragma unroll
        for (int i = 0; i < 8; ++i) {
            const int c = tid + 256 * i, n = c >> 4, sc = c & 15;
            const int ch = g * 512 + slab * 128 + permcol(n);
            const u32x4 v = braw[i];
            float x[8];
            x[0] = bf_lo(v.x); x[1] = bf_hi(v.x); x[2] = bf_lo(v.y); x[3] = bf_hi(v.y);
            x[4] = bf_lo(v.z); x[5] = bf_hi(v.z); x[6] = bf_lo(v.w); x[7] = bf_hi(v.w);
#pragma unroll
            for (int e = 0; e < 8; ++e) x[e] = (x[e] - mur[e]) * rsr[e] * lg[i] + lb[i];
            if (samp) {
#pragma unroll
                for (int e = 0; e < 8; ++e) av_out[(size_t)(sc * 8 + e) * 2048 + ch] = x[e];
            }
            u32x4 o;
            o.x = cvt_pk(x[0], x[1]); o.y = cvt_pk(x[2], x[3]); o.z = cvt_pk(x[4], x[5]); o.w = cvt_pk(x[6], x[7]);
            *(u32x4*)(Bs + (sc >> 2) * 4096 + n * 32 + swz(n, sc & 3)) = o;
        }
        __syncthreads();
        f32x4 acc[4][4];
#pragma unroll
        for (int i = 0; i < 4; ++i)
#pragma unroll
            for (int jn = 0; jn < 4; ++jn) acc[i][jn] = (f32x4){0.f, 0.f, 0.f, 0.f};
        u32x4 pvv[4][2];
#pragma unroll
        for (int i = 0; i < 4; ++i)
#pragma unroll
            for (int g2 = 0; g2 < 2; ++g2)
                pvv[i][g2] = *(const u32x4*)(P + (size_t)(chunk * 128 + wr * 64 + i * 16 + fr) * 2048 + g * 512 + slab * 128 + wc * 64 + 32 * g2 + 8 * fq);
        mma_stage<true>(As, Bs, 4096, 4096, acc, wr, wc, lane);
        mma_stage<true>(As + 8192, Bs + 8192, 4096, 4096, acc, wr, wc, lane);
#pragma unroll
        for (int i = 0; i < 4; ++i) {
            const int t = wr * 64 + i * 16 + fr;
            const float bs = b_s[g * 128 + (samp ? 0 : t)];
            const size_t rowoff = (size_t)(chunk * 128 + t) * 2048 + g * 512 + slab * 128;
#pragma unroll
            for (int g2 = 0; g2 < 2; ++g2) {
                bf16_t* pp = P + rowoff + wc * 64 + 32 * g2 + 8 * fq;
                const u32x4 pv = pvv[i][g2];
                const f32x4 a = acc[i][2 * g2], b = acc[i][2 * g2 + 1];
                u32x4 w;
                w.x = cvt_pk(bf_lo(pv.x) * (a.x + bs), bf_hi(pv.x) * (a.y + bs));
                w.y = cvt_pk(bf_lo(pv.y) * (a.z + bs), bf_hi(pv.y) * (a.w + bs));
                w.z = cvt_pk(bf_lo(pv.z) * (b.x + bs), bf_hi(pv.z) * (b.y + bs));
                w.w = cvt_pk(bf_lo(pv.w) * (b.z + bs), bf_hi(pv.w) * (b.w + bs));
                *(u32x4*)pp = w;
            }
        }
    }
}

struct EpiY {
    bf16_t* Yb;
    float* Yp;
    __device__ __forceinline__ void operator()(f32x4 (&acc)[4][4], int m0, int n0, int wr, int wc, int lane) const {
        const int fr = lane & 15, fq = lane >> 4;
        const bool part = (m0 == M_P);
#pragma unroll
        for (int i = 0; i < 4; ++i) {
            const int m = m0 + wr * 64 + i * 16 + fr;
#pragma unroll
            for (int g2 = 0; g2 < 2; ++g2) {
                const int n = n0 + wc * 64 + 32 * g2 + 8 * fq;
                const f32x4 a = acc[i][2 * g2], b = acc[i][2 * g2 + 1];
                if (part) {
                    float* o = Yp + (size_t)(m - M_P) * 1024 + n;
                    *(f32x4*)o = a;
                    *(f32x4*)(o + 4) = b;
                } else {
                    u32x4 w;
                    w.x = cvt_pk(a.x, a.y); w.y = cvt_pk(a.z, a.w); w.z = cvt_pk(b.x, b.y); w.w = cvt_pk(b.z, b.w);
                    *(u32x4*)(Yb + (size_t)m * 1024 + n) = w;
                }
            }
        }
    }
};
__device__ __forceinline__ void out_gemm_phase(const bf16_t* A, int K, const bf16_t* Wt, float* Y, float* Ypart, bf16_t* smem) {
    const int nsplit = K >> 8;
    const int ntile = 1024 + 8 * nsplit;
    Stage st;
    bool pre = false;
    for (int t = blockIdx.x; t < ntile; t += gridDim.x) {
        const bool full = t < 1024;
        const int u = t - 1024, ks = full ? 0 : (u >> 3);
        const int m0 = full ? (t >> 3) * 128 : M_P, n0 = (full ? (t & 7) : (u & 7)) * 128, Kt = full ? K : 256;
        const int tn = t + gridDim.x;
        const bool hn = tn < ntile, fulln = tn < 1024;
        const int un = tn - 1024, ksn = fulln ? 0 : (un >> 3);
        const int m0n = fulln ? (tn >> 3) * 128 : M_P, n0n = (fulln ? (tn & 7) : (un & 7)) * 128;
        EpiY e{(bf16_t*)Y, Ypart + (size_t)ks * 128 * 1024};
        gemm_tile<true>(A + ks * 256, K, Wt + ks * 256, K, Kt, m0, n0, smem, e, st, pre, hn, A + ksn * 256, Wt + ksn * 256, m0n, n0n);
        pre = hn;
    }
}

struct EpiSilu {
    bf16_t* O;
    int ldo, col0;
    __device__ __forceinline__ void operator()(f32x4 (&acc)[4][4], int m0, int n0, int wr, int wc, int lane) const {
        const int fr = lane & 15, fq = lane >> 4;
#pragma unroll
        for (int i = 0; i < 4; ++i) {
            const int m = m0 + wr * 64 + i * 16 + fr;
#pragma unroll
            for (int jn = 0; jn < 4; ++jn) {
                const f32x4 a = acc[i][jn];
                u32x2 w;
                w.x = cvt_pk(silu_f(a.x), silu_f(a.y));
                w.y = cvt_pk(silu_f(a.z), silu_f(a.w));
                *(u32x2*)(O + (size_t)m * ldo + col0 + wc * 64 + jn * 16 + fq * 4) = w;
            }
        }
    }
};
struct EpiCopy {
    bf16_t* O;
    int ldo, col0;
    __device__ __forceinline__ void operator()(f32x4 (&acc)[4][4], int m0, int n0, int wr, int wc, int lane) const {
        const int fr = lane & 15, fq = lane >> 4;
#pragma unroll
        for (int i = 0; i < 4; ++i) {
            const int m = m0 + wr * 64 + i * 16 + fr;
#pragma unroll
            for (int jn = 0; jn < 4; ++jn) {
                const f32x4 a = acc[i][jn];
                u32x2 w;
                w.x = cvt_pk(a.x, a.y);
                w.y = cvt_pk(a.z, a.w);
                *(u32x2*)(O + (size_t)m * ldo + col0 + wc * 64 + jn * 16 + fq * 4) = w;
            }
        }
    }
};
template <int isk> struct EpiRope {
    bf16_t* O;
    int ldo, col0;
    const float* rope;
    float* out;
    __device__ __forceinline__ void operator()(f32x4 (&acc)[4][4], int m0, int n0, int wr, int wc, int lane) const {
        const int fr = lane & 15, fq = lane >> 4;
#pragma unroll
        for (int i = 0; i < 4; ++i) {
            const int m = m0 + wr * 64 + i * 16 + fr;
            const int pos = (m < M_P) ? (m & (SEQ - 1)) : SEQ;
            const float* rt = rope + (size_t)pos * 64;
            const float scale = isk ? 1.0f : 0.125f;
#pragma unroll
            for (int jn = 0; jn < 2; ++jn) {
                const int d = jn * 16 + fq * 4;
                const f32x4 c = *(const f32x4*)(rt + d), s = *(const f32x4*)(rt + 32 + d);
                const f32x4 x1 = acc[i][jn], x2 = acc[i][jn + 2];
                const f32x4 o1 = (x1 * c - x2 * s) * scale, o2 = (x2 * c + x1 * s) * scale;
                u32x2 w1, w2;
                w1.x = cvt_pk(o1.x, o1.y); w1.y = cvt_pk(o1.z, o1.w);
                w2.x = cvt_pk(o2.x, o2.y); w2.y = cvt_pk(o2.z, o2.w);
                bf16_t* dst = O + (size_t)m * ldo + col0 + wc * 64 + d;
                *(u32x2*)dst = w1;
                *(u32x2*)(dst + 32) = w2;
                if (isk) {
                    if (m < M_P) {
                        const int t = m & (SEQ - 1), b = m >> 13;
                        if (t >= SEQ - 128) {
                            float* o = out + O_BKP + ((size_t)(b * 128 + t - (SEQ - 128)) * 2 + wc) * 64 + d;
                            *(f32x4*)o = o1;
                            *(f32x4*)(o + 32) = o2;
                        }
                    } else {
                        float* o = out + O_BKS + ((size_t)((m - M_P) * 128 + 127) * 2 + wc) * 64 + d;
                        *(f32x4*)o = o1;
                        *(f32x4*)(o + 32) = o2;
                    }
                }
            }
        }
    }
};
struct EpiVt {
    bf16_t* Vt;
    float* out;
    __device__ __forceinline__ void operator()(f32x4 (&acc)[4][4], int m0, int n0, int wr, int wc, int lane) const {
        const int fr = lane & 15, fq = lane >> 4;
#pragma unroll
        for (int i = 0; i < 4; ++i) {
            const int m = m0 + wr * 64 + i * 16 + fq * 4;
#pragma unroll
            for (int jn = 0; jn < 4; ++jn) {
                const int d = jn * 16 + fr;
                const f32x4 a = acc[i][jn];
                if (m < M_P) {
                    const int t = m & (SEQ - 1), b = m >> 13;
                    u32x2 w;
                    w.x = cvt_pk(a.x, a.y);
                    w.y = cvt_pk(a.z, a.w);
                    *(u32x2*)(Vt + ((size_t)(b * 2 + wc) * 64 + d) * SEQ + t) = w;
                    if (t >= SEQ - 128) {
                        float* o = out + O_BVP + ((size_t)(b * 128 + t - (SEQ - 128)) * 2 + wc) * 64 + d;
                        o[0] = a.x; o[128] = a.y; o[256] = a.z; o[384] = a.w;
                    }
                } else {
                    float* o = out + O_BVS + ((size_t)((m - M_P) * 128 + 127) * 2 + wc) * 64 + d;
                    o[0] = a.x; o[16384] = a.y; o[32768] = a.z; o[49152] = a.w;
                }
            }
        }
    }
};

struct EpiB {
    bf16_t *Q, *SG, *KV;
    const float* rope;
    float* out;
    int nt;
    const float* rs;
    __device__ __forceinline__ void operator()(f32x4 (&acc)[4][4], int m0, int n0, int wr, int wc, int lane) const {
        const int fr = lane & 15, fq = lane >> 4;
#pragma unroll
        for (int i = 0; i < 4; ++i) {
            const float sc = rs[m0 + wr * 64 + i * 16 + fr];
#pragma unroll
            for (int jn = 0; jn < 4; ++jn) acc[i][jn] = acc[i][jn] * sc;
        }
        if (nt < 9) {
            const bool isk = (nt == 8);
            const float scale = isk ? 1.0f : 0.125f;
#pragma unroll
            for (int i = 0; i < 4; ++i) {
                const int m = m0 + wr * 64 + i * 16 + fr;
                const int pos = (m < M_P) ? (m & (SEQ - 1)) : SEQ;
                const float* rt = rope + (size_t)pos * 64;
                const int d = 8 * fq;
                f32x4 o1[2], o2[2];
#pragma unroll
                for (int jl = 0; jl < 2; ++jl) {
                    const f32x4 c = *(const f32x4*)(rt + d + 4 * jl), s = *(const f32x4*)(rt + 32 + d + 4 * jl);
                    const f32x4 x1 = acc[i][jl], x2 = acc[i][jl + 2];
                    o1[jl] = (x1 * c - x2 * s) * scale;
                    o2[jl] = (x2 * c + x1 * s) * scale;
                }
                u32x4 w1, w2;
                w1.x = cvt_pk(o1[0].x, o1[0].y); w1.y = cvt_pk(o1[0].z, o1[0].w); w1.z = cvt_pk(o1[1].x, o1[1].y); w1.w = cvt_pk(o1[1].z, o1[1].w);
                w2.x = cvt_pk(o2[0].x, o2[0].y); w2.y = cvt_pk(o2[0].z, o2[0].w); w2.z = cvt_pk(o2[1].x, o2[1].y); w2.w = cvt_pk(o2[1].z, o2[1].w);
                bf16_t* dst = isk ? KV + (size_t)m * 256 + wc * 64 + d : Q + (size_t)m * 1024 + nt * 128 + wc * 64 + d;
                *(u32x4*)dst = w1;
                *(u32x4*)(dst + 32) = w2;
                if (isk) {
                    float* o = nullptr;
                    if (m < M_P) {
                        const int t = m & (SEQ - 1), b = m >> 13;
                        if (t >= SEQ - 128) o = out + O_BKP + ((size_t)(b * 128 + t - (SEQ - 128)) * 2 + wc) * 64 + d;
                    } else o = out + O_BKS + ((size_t)((m - M_P) * 128 + 127) * 2 + wc) * 64 + d;
                    if (o) { *(f32x4*)o = o1[0]; *(f32x4*)(o + 4) = o1[1]; *(f32x4*)(o + 32) = o2[0]; *(f32x4*)(o + 36) = o2[1]; }
                }
            }
        } else if (nt == 9) {
#pragma unroll
            for (int i = 0; i < 4; ++i) {
                const int m = m0 + wr * 64 + i * 16 + fr;
                float* o = nullptr;
                if (m < M_P) {
                    const int t = m & (SEQ - 1), b = m >> 13;
                    if (t >= SEQ - 128) o = out + O_BVP + ((size_t)(b * 128 + t - (SEQ - 128)) * 2 + wc) * 64;
                } else o = out + O_BVS + ((size_t)((m - M_P) * 128 + 127) * 2 + wc) * 64;
#pragma unroll
                for (int g2 = 0; g2 < 2; ++g2) {
                    const int d = 32 * g2 + 8 * fq;
                    const f32x4 a = acc[i][2 * g2], b = acc[i][2 * g2 + 1];
                    u32x4 w;
                    w.x = cvt_pk(a.x, a.y); w.y = cvt_pk(a.z, a.w); w.z = cvt_pk(b.x, b.y); w.w = cvt_pk(b.z, b.w);
                    *(u32x4*)(KV + (size_t)m * 256 + 128 + wc * 64 + d) = w;
                    if (o) { *(f32x4*)(o + d) = a; *(f32x4*)(o + d + 4) = b; }
                }
            }
        } else {
#pragma unroll
            for (int i = 0; i < 4; ++i) {
                const int m = m0 + wr * 64 + i * 16 + fr;
#pragma unroll
                for (int g2 = 0; g2 < 2; ++g2) {
                    const f32x4 a = acc[i][2 * g2], b = acc[i][2 * g2 + 1];
                    u32x4 w;
                    w.x = cvt_pk(silu_f(a.x), silu_f(a.y)); w.y = cvt_pk(silu_f(a.z), silu_f(a.w));
                    w.z = cvt_pk(silu_f(b.x), silu_f(b.y)); w.w = cvt_pk(silu_f(b.z), silu_f(b.w));
                    *(u32x4*)(SG + (size_t)m * 1024 + (nt - 10) * 128 + wc * 64 + 32 * g2 + 8 * fq) = w;
                }
            }
        }
    }
};

__device__ __forceinline__ void b_in_phase(const Params& p, bf16_t* smem) {
    const bf16_t* H = (const bf16_t*)(p.ws + W_XB);
    const float* RS = (const float*)(p.ws + W_RS);
    const bf16_t* Wt = (const bf16_t*)(p.ws + W_B_IN);
    bf16_t* Q = (bf16_t*)(p.ws + W_BUF1);
    bf16_t* SG = Q + (size_t)MT * 1024;
    bf16_t* KV = (bf16_t*)(p.ws + W_KB);
    const float* rope = (const float*)(p.ws + W_ROPE);
    Stage st;
    bool pre = false;
    for (int t = blockIdx.x; t < 129 * 18; t += gridDim.x) {
        const int mt = t < 2064 ? (t >> 4) : ((t - 2064) >> 1), nt = t < 2064 ? (t & 15) : 16 + ((t - 2064) & 1);
        const int tn = t + gridDim.x;
        const bool hn = tn < 129 * 18;
        const int mtn = tn < 2064 ? (tn >> 4) : ((tn - 2064) >> 1), ntn = tn < 2064 ? (tn & 15) : 16 + ((tn - 2064) & 1);
        EpiB e{Q, SG, KV, rope, p.out, nt, RS};
        gemm_tile<true>(H, 1024, Wt, 1024, 1024, mt * 128, nt * 128, smem, e, st, pre, hn, H, Wt, mtn * 128, ntn * 128);
        pre = hn;
    }
}

constexpr int VT_LD = 256;
__device__ __forceinline__ void attn_prompt_item(const Params& p, int item, bf16_t* smem) {
    const int tid = threadIdx.x, w = tid >> 6, lane = tid & 63, fr = lane & 15, fq = lane >> 4;
    const int half = item & 1, kvh = (item >> 1) & 1, nb = (item >> 2) & 63, b = item >> 8;
    const bf16_t* Q = (const bf16_t*)(p.ws + W_BUF1);
    const bf16_t* SG = Q + (size_t)MT * 1024;
    const bf16_t* KV = (const bf16_t*)(p.ws + W_KB);
    bf16_t* Z = (bf16_t*)(p.ws + W_H);
    bf16_t* Ks = smem;
    bf16_t* Vs = smem + 16384;
    const int row0 = b * SEQ + nb * 128;
    u32x4 kraw[8], vraw[8];
#pragma unroll
    for (int i = 0; i < 8; ++i) {
        const int c = tid + 256 * i, key = c >> 3, kc = c & 7;
        kraw[i] = (u32x4){0u, 0u, 0u, 0u};
        vraw[i] = (u32x4){0u, 0u, 0u, 0u};
        if (nb > 0 || key >= 128) {
            const bf16_t* src_row = KV + (size_t)(row0 - 128 + key) * 256 + kvh * 64 + kc * 8;
            kraw[i] = *(const u32x4*)src_row;
            vraw[i] = *(const u32x4*)(src_row + 128);
        }
    }
    __syncthreads();
#pragma unroll
    for (int i = 0; i < 8; ++i) {
        const int c = tid + 256 * i, key = c >> 3, kc = c & 7;
        *(u32x4*)(Ks + (kc >> 2) * 8192 + key * 32 + swz(key, kc & 3)) = kraw[i];
    }
#pragma unroll
    for (int i = 0; i < 8; ++i) {
        const int c = tid + 256 * i, key = c >> 3, dc = c & 7;
        const unsigned wv[4] = {vraw[i].x, vraw[i].y, vraw[i].z, vraw[i].w};
#pragma unroll
        for (int e = 0; e < 8; ++e) {
            const int d = dc * 8 + e;
            const unsigned short hv = (e & 1) ? (unsigned short)(wv[e >> 1] >> 16) : (unsigned short)(wv[e >> 1] & 0xffff);
            Vs[d * VT_LD + (((key >> 3) ^ ((d & 15) << 1)) << 3) + (key & 7)] = hv;
        }
    }
    __syncthreads();
    const int co = swz(fr, fq);
#pragma unroll 1
    for (int gq = half * 8; gq < half * 8 + 8; ++gq) {
        const int g = gq >> 1, qt = gq & 1;
        const int h = kvh * 8 + g;
        const float sink = p.in[15][h];
        const int qi = 32 * w + 16 * qt + fr;
        bf16x8 qf[2];
#pragma unroll
        for (int kk = 0; kk < 2; ++kk)
            qf[kk] = *(const bf16x8*)(Q + (size_t)(row0 + qi) * 1024 + h * 64 + kk * 32 + fq * 8);
        f32x4 s[10];
#pragma unroll
        for (int kt = 0; kt < 10; ++kt) s[kt] = (f32x4){0.f, 0.f, 0.f, 0.f};
#pragma unroll
        for (int kt = 0; kt < 10; ++kt) {
#pragma unroll
            for (int kk = 0; kk < 2; ++kk) {
                const bf16x8 kf = *(const bf16x8*)(Ks + kk * 8192 + (16 * (2 * w + kt) + fr) * 32 + co);
                s[kt] = __builtin_amdgcn_mfma_f32_16x16x32_bf16(kf, qf[kk], s[kt], 0, 0, 0);
            }
            if (kt & 1) __builtin_amdgcn_sched_barrier(0);
        }
        float mx = sink;
#pragma unroll
        for (int kt = 0; kt < 10; ++kt) {
            const int key0 = 16 * (2 * w + kt) + fq * 4;
#pragma unroll
            for (int r = 0; r < 4; ++r) {
                const int key = key0 + r;
                const bool valid = (key >= qi) && (key <= qi + 128) && (nb > 0 || key >= 128);
                const float v = valid ? s[kt][r] : -1e30f;
                s[kt][r] = v;
                mx = fmaxf(mx, v);
            }
        }
        mx = fmaxf(mx, __shfl_xor(mx, 16));
        mx = fmaxf(mx, __shfl_xor(mx, 32));
        float sum = 0.f;
#pragma unroll
        for (int kt = 0; kt < 10; ++kt)
#pragma unroll
            for (int r = 0; r < 4; ++r) {
                const float e = __expf(s[kt][r] - mx);
                s[kt][r] = e;
                sum += e;
            }
        sum += __shfl_xor(sum, 16);
        sum += __shfl_xor(sum, 32);
        const float inv = __builtin_amdgcn_rcpf(sum + __expf(sink - mx));
        u32x2 sgv[4];
#pragma unroll
        for (int dt = 0; dt < 4; ++dt) sgv[dt] = *(const u32x2*)(SG + (size_t)(row0 + qi) * 1024 + h * 64 + 16 * dt + fq * 4);
        f32x4 o[4];
#pragma unroll
        for (int dt = 0; dt < 4; ++dt) o[dt] = (f32x4){0.f, 0.f, 0.f, 0.f};
#pragma unroll
        for (int ks = 0; ks < 5; ++ks) {
            u32x4 pw;
            pw.x = cvt_pk(s[2 * ks][0], s[2 * ks][1]);
            pw.y = cvt_pk(s[2 * ks][2], s[2 * ks][3]);
            pw.z = cvt_pk(s[2 * ks + 1][0], s[2 * ks + 1][1]);
            pw.w = cvt_pk(s[2 * ks + 1][2], s[2 * ks + 1][3]);
            const bf16x8 pf = __builtin_bit_cast(bf16x8, pw);
            const int kc0 = (((2 * w + 2 * ks) ^ fr) << 4) + fq * 4, kc1 = (((2 * w + 2 * ks + 1) ^ fr) << 4) + fq * 4;
#pragma unroll
            for (int dt = 0; dt < 4; ++dt) {
                const bf16_t* vp = Vs + (16 * dt + fr) * VT_LD;
                u32x4 vw;
                const u32x2 v0 = *(const u32x2*)(vp + kc0), v1 = *(const u32x2*)(vp + kc1);
                vw.x = v0.x; vw.y = v0.y; vw.z = v1.x; vw.w = v1.y;
                const bf16x8 vf = __builtin_bit_cast(bf16x8, vw);
                o[dt] = __builtin_amdgcn_mfma_f32_16x16x32_bf16(vf, pf, o[dt], 0, 0, 0);
            }
            __builtin_amdgcn_sched_barrier(0);
        }
        const size_t ro = (size_t)(row0 + qi) * 1024 + h * 64;
#pragma unroll
        for (int dt = 0; dt < 4; ++dt) {
            const int d = 16 * dt + fq * 4;
            const u32x2 sg = sgv[dt];
            const f32x4 ov = o[dt] * inv;
            u32x2 wv;
            wv.x = cvt_pk(ov.x * bf_lo(sg.x), ov.y * bf_hi(sg.x));
            wv.y = cvt_pk(ov.z * bf_lo(sg.y), ov.w * bf_hi(sg.y));
            *(u32x2*)(Z + ro + d) = wv;
        }
    }
}

__device__ __forceinline__ void attn_sample_item(const Params& p, int item, unsigned char* smem_raw) {
    const int tid = threadIdx.x, g = tid >> 5, l = tid & 31;
    const int kvh = item & 1, b = item >> 1;
    const bf16_t* Q = (const bf16_t*)(p.ws + W_BUF1);
    const bf16_t* SG = Q + (size_t)MT * 1024;
    bf16_t* Z = (bf16_t*)(p.ws + W_H);
    float* kv = (float*)smem_raw;
    float* qs = kv + 129 * 65;
    float* ps = qs + 512;
    const float* ck = p.in[2];
    const float* cv = p.in[3];
    float* oks = p.out + O_BKS;
    float* ovs = p.out + O_BVS;
    const int row = M_P + b;
    f32x4 knew = {0.f, 0.f, 0.f, 0.f}, vnew = {0.f, 0.f, 0.f, 0.f};
    if (tid < 16) knew = *(const f32x4*)(oks + ((size_t)(b * 128 + 127) * 2 + kvh) * 64 + tid * 4);
    const float q0 = bf2f(Q[(size_t)row * 1024 + kvh * 512 + tid]), q1 = bf2f(Q[(size_t)row * 1024 + kvh * 512 + 256 + tid]);
    __syncthreads();
    f32x4 kreg[8];
#pragma unroll
    for (int i = 0; i < 8; ++i) {
        const int c = tid + 256 * i, key = c >> 4, d4 = (c & 15) * 4;
        kreg[i] = *(const f32x4*)(ck + ((size_t)(b * 128 + key) * 2 + kvh) * 64 + d4);
    }
#pragma unroll
    for (int i = 0; i < 8; ++i) {
        const int c = tid + 256 * i, key = c >> 4, d4 = (c & 15) * 4;
        if (key >= 1) *(f32x4*)(oks + ((size_t)(b * 128 + key - 1) * 2 + kvh) * 64 + d4) = kreg[i];
        float* kp = kv + key * 65 + d4;
        kp[0] = kreg[i].x; kp[1] = kreg[i].y; kp[2] = kreg[i].z; kp[3] = kreg[i].w;
    }
    if (tid < 16) { float* kp = kv + 128 * 65 + tid * 4; kp[0] = knew.x; kp[1] = knew.y; kp[2] = knew.z; kp[3] = knew.w; }
    qs[tid] = q0;
    qs[256 + tid] = q1;
    if (tid < 16) vnew = *(const f32x4*)(ovs + ((size_t)(b * 128 + 127) * 2 + kvh) * 64 + tid * 4);
    f32x4 vreg[8];
#pragma unroll
    for (int i = 0; i < 8; ++i) {
        const int c = tid + 256 * i, key = c >> 4, d4 = (c & 15) * 4;
        vreg[i] = *(const f32x4*)(cv + ((size_t)(b * 128 + key) * 2 + kvh) * 64 + d4);
    }
    __syncthreads();
    const int h = kvh * 8 + g;
    const float sink = p.in[15][h];
    float sc[5] = {0.f, 0.f, 0.f, 0.f, 0.f};
    float mx = sink;
#pragma unroll 2
    for (int d0 = 0; d0 < 64; d0 += 8) {
        float qv[8];
#pragma unroll
        for (int e = 0; e < 8; ++e) qv[e] = qs[g * 64 + d0 + e];
#pragma unroll
        for (int i = 0; i < 5; ++i) {
            const float* kp = kv + (l + 32 * i) * 65 + d0;
#pragma unroll
            for (int e = 0; e < 8; ++e) sc[i] += qv[e] * kp[e];
        }
    }
#pragma unroll
    for (int i = 0; i < 5; ++i) {
        if (l + 32 * i >= 129) sc[i] = -1e30f;
        mx = fmaxf(mx, sc[i]);
    }
#pragma unroll
    for (int o = 1; o < 32; o <<= 1) mx = fmaxf(mx, __shfl_xor(mx, o));
    float sum = 0.f;
#pragma unroll
    for (int i = 0; i < 5; ++i) {
        const int key = l + 32 * i;
        const float e = (key < 129) ? __expf(sc[i] - mx) : 0.f;
        sc[i] = e;
        sum += e;
    }
#pragma unroll
    for (int o = 1; o < 32; o <<= 1) sum += __shfl_xor(sum, o);
    const float inv = __builtin_amdgcn_rcpf(sum + __expf(sink - mx));
#pragma unroll
    for (int i = 0; i < 5; ++i) {
        const int key = l + 32 * i;
        if (key < 129) ps[g * 132 + key] = sc[i] * inv;
    }
    __syncthreads();
#pragma unroll
    for (int i = 0; i < 8; ++i) {
        const int c = tid + 256 * i, key = c >> 4, d4 = (c & 15) * 4;
        if (key >= 1) *(f32x4*)(ovs + ((size_t)(b * 128 + key - 1) * 2 + kvh) * 64 + d4) = vreg[i];
        float* kp = kv + key * 65 + d4;
        kp[0] = vreg[i].x; kp[1] = vreg[i].y; kp[2] = vreg[i].z; kp[3] = vreg[i].w;
    }
    if (tid < 16) { float* kp = kv + 128 * 65 + tid * 4; kp[0] = vnew.x; kp[1] = vnew.y; kp[2] = vnew.z; kp[3] = vnew.w; }
    __syncthreads();
    float o0 = 0.f, o1 = 0.f;
#pragma unroll 8
    for (int key = 0; key < 129; ++key) {
        const float pv = ps[g * 132 + key];
        o0 += pv * kv[key * 65 + l];
        o1 += pv * kv[key * 65 + l + 32];
    }
    const size_t ro = (size_t)row * 1024 + h * 64;
    Z[ro + l] = (bf16_t)(cvt_pk(o0 * bf2f(SG[ro + l]), 0.f) & 0xffff);
    Z[ro + l + 32] = (bf16_t)(cvt_pk(o1 * bf2f(SG[ro + l + 32]), 0.f) & 0xffff);
}

__device__ __forceinline__ void b_attn_phase(const Params& p, unsigned char* smem_raw) {
    for (int it = blockIdx.x; it < 512; it += gridDim.x) attn_prompt_item(p, it, (bf16_t*)smem_raw);
    for (int it = blockIdx.x; it < 256; it += gridDim.x) attn_sample_item(p, it, smem_raw);
}

struct EpiAct {
    bf16_t* XR;
    int ldo, col0, act;
    const float* rs;
    __device__ __forceinline__ void operator()(f32x4 (&acc)[4][4], int m0, int n0, int wr, int wc, int lane) const {
        const int fr = lane & 15, fq = lane >> 4;
        bf16_t* O = act ? XR + (size_t)MT * 1024 - 1024 : XR;
#pragma unroll
        for (int i = 0; i < 4; ++i) {
            const int m = m0 + wr * 64 + i * 16 + fr;
            const float sc = rs[m];
#pragma unroll
            for (int g2 = 0; g2 < 2; ++g2) {
                f32x4 a = acc[i][2 * g2] * sc, b = acc[i][2 * g2 + 1] * sc;
                if (act) {
                    a.x = silu_f(a.x); a.y = silu_f(a.y); a.z = silu_f(a.z); a.w = silu_f(a.w);
                    b.x = silu_f(b.x); b.y = silu_f(b.y); b.z = silu_f(b.z); b.w = silu_f(b.w);
                }
                u32x4 w;
                w.x = cvt_pk(a.x, a.y); w.y = cvt_pk(a.z, a.w); w.z = cvt_pk(b.x, b.y); w.w = cvt_pk(b.z, b.w);
                *(u32x4*)(O + (size_t)m * ldo + col0 + wc * 64 + 32 * g2 + 8 * fq) = w;
            }
        }
    }
};
__device__ __forceinline__ void c_in_phase(const Params& p, bf16_t* smem) {
    const bf16_t* H = (const bf16_t*)(p.ws + W_XB);
    const float* RS = (const float*)(p.ws + W_RS);
    const bf16_t* Wt = (const bf16_t*)(p.ws + W_C_IN);
    bf16_t* XR = (bf16_t*)(p.ws + W_BUF1);
    bf16_t* SG = XR + (size_t)MT * 1024;
    Stage st;
    bool pre = false;
    for (int t = blockIdx.x; t < 129 * 16; t += gridDim.x) {
        const int mt = t >> 4, nt = t & 15;
        const int tn = t + gridDim.x;
        const bool hn = tn < 129 * 16;
        EpiAct e{XR, 1024, nt * 128, nt >= 8, RS};
        gemm_tile<true>(H, 1024, Wt, 1024, 1024, mt * 128, nt * 128, smem, e, st, pre, hn, H, Wt, (tn >> 4) * 128, (tn & 15) * 128);
        pre = hn;
    }
}

__device__ __forceinline__ void unpack8(const u32x4 v, float (&x)[8]) {
    x[0] = bf_lo(v.x); x[1] = bf_hi(v.x); x[2] = bf_lo(v.y); x[3] = bf_hi(v.y);
    x[4] = bf_lo(v.z); x[5] = bf_hi(v.z); x[6] = bf_lo(v.w); x[7] = bf_hi(v.w);
}

__device__ __forceinline__ void c_conv_phase(const Params& p) {
    const bf16_t* XR = (const bf16_t*)(p.ws + W_BUF1);
    bf16_t* XC = (bf16_t*)(p.ws + W_H);
    const float* cw = p.in[18];
    const float* cb = p.in[19];
    const float* st = p.in[4];
    const int gt = blockIdx.x * NTHREADS + threadIdx.x, gn = gridDim.x * NTHREADS;
    const int c0 = (gt & 127) * 8;
    float w0[8], w1[8], w2[8], w3[8], bias[8];
#pragma unroll
    for (int e = 0; e < 8; ++e) {
        w0[e] = cw[c0 + e]; w1[e] = cw[1024 + c0 + e]; w2[e] = cw[2048 + c0 + e]; w3[e] = cw[3072 + c0 + e]; bias[e] = cb[c0 + e];
    }
    for (int run = gt >> 7; run < M_P / 8; run += gn >> 7) {
        const int r0 = run * 8, t0 = r0 & (SEQ - 1), b = r0 >> 13;
        u32x4 raw[11];
#pragma unroll
        for (int q = 0; q < 11; ++q) {
            raw[q] = (u32x4){0u, 0u, 0u, 0u};
            if (q >= 3 || t0 > 0) raw[q] = *(const u32x4*)(XR + (size_t)(r0 - 3 + q) * 1024 + c0);
        }
        float x0[8], x1[8], x2[8], x3[8];
        unpack8(raw[0], x0); unpack8(raw[1], x1); unpack8(raw[2], x2);
#pragma unroll
        for (int q = 0; q < 8; ++q) {
            unpack8(raw[q + 3], x3);
            float acc[8];
#pragma unroll
            for (int e = 0; e < 8; ++e) acc[e] = bias[e] + x0[e] * w0[e] + x1[e] * w1[e] + x2[e] * w2[e] + x3[e] * w3[e];
            u32x4 o;
            o.x = cvt_pk(acc[0], acc[1]); o.y = cvt_pk(acc[2], acc[3]); o.z = cvt_pk(acc[4], acc[5]); o.w = cvt_pk(acc[6], acc[7]);
            *(u32x4*)(XC + (size_t)(r0 + q) * 1024 + c0) = o;
            const int t = t0 + q;
            if (t >= SEQ - 3) {
                float* oo = p.out + O_CCP + ((size_t)b * 3 + (t - (SEQ - 3))) * 1024 + c0;
#pragma unroll
                for (int e = 0; e < 8; ++e) oo[e] = x3[e];
            }
#pragma unroll
            for (int e = 0; e < 8; ++e) { x0[e] = x1[e]; x1[e] = x2[e]; x2[e] = x3[e]; }
        }
    }
    for (int b = gt >> 7; b < M_S; b += gn >> 7) {
        const int row = M_P + b;
        float xv[8], acc[8];
        unpack8(*(const u32x4*)(XR + (size_t)row * 1024 + c0), xv);
#pragma unroll
        for (int e = 0; e < 8; ++e) {
            const float s0 = st[((size_t)b * 3 + 0) * 1024 + c0 + e], s1 = st[((size_t)b * 3 + 1) * 1024 + c0 + e], s2 = st[((size_t)b * 3 + 2) * 1024 + c0 + e];
            acc[e] = bias[e] + s0 * w0[e] + s1 * w1[e] + s2 * w2[e] + xv[e] * w3[e];
            p.out[O_CCS + ((size_t)b * 3 + 0) * 1024 + c0 + e] = s1;
            p.out[O_CCS + ((size_t)b * 3 + 1) * 1024 + c0 + e] = s2;
            p.out[O_CCS + ((size_t)b * 3 + 2) * 1024 + c0 + e] = xv[e];
        }
        u32x4 o;
        o.x = cvt_pk(acc[0], acc[1]); o.y = cvt_pk(acc[2], acc[3]); o.z = cvt_pk(acc[4], acc[5]); o.w = cvt_pk(acc[6], acc[7]);
        *(u32x4*)(XC + (size_t)row * 1024 + c0) = o;
    }
}

struct EpiGate {
    const bf16_t* XC;
    float* Aa;
    bf16_t* Bb;
    const float *b_a, *b_x, *lam;
    int blk, nt;
    float* lds;
    float* carry;
    __device__ __forceinline__ void operator()(f32x4 (&acc)[4][4], int m0, int n0, int wr, int wc, int lane) const {
        const int fr = lane & 15, fq = lane >> 4;
        const bool prompt = (m0 < M_P);
#pragma unroll
        for (int jn = 0; jn < 2; ++jn) {
            const int cl = 32 * wc + 8 * fq + 4 * jn;
            const int d = blk * 256 + 64 * nt + cl;
            const f32x4 ba = *(const f32x4*)(b_a + d), bx = *(const f32x4*)(b_x + d), sp = *(const f32x4*)(lam + d);
#pragma unroll
            for (int i = 0; i < 4; ++i) {
                const int rl = wr * 64 + i * 16 + fr, m = m0 + rl;
                const bool first = (m < M_P) && ((m & (SEQ - 1)) == 0);
                const u32x2 xw = *(const u32x2*)(XC + (size_t)m * 1024 + d);
                const f32x4 xc = {bf_lo(xw.x), bf_hi(xw.x), bf_lo(xw.y), bf_hi(xw.y)};
                const f32x4 ra = acc[i][jn] + ba, ia = acc[i][jn + 2] + bx;
                f32x4 av, bv;
#pragma unroll
                for (int r = 0; r < 4; ++r) {
                    const float rg = sigmoid_f(ra[r]), ig = sigmoid_f(ia[r]);
                    const float la = -8.0f * rg * sp[r];
                    const float a = __expf(la);
                    av[r] = a;
                    const float mult = first ? 1.0f : __builtin_amdgcn_sqrtf(fmaxf(1.0f - a * a, 0.f));
                    bv[r] = mult * (ig * xc[r]);
                }
                u32x2 ow;
                ow.x = cvt_pk(1.0f - av.x, 1.0f - av.y);
                ow.y = cvt_pk(1.0f - av.z, 1.0f - av.w);
                *(u32x2*)((bf16_t*)Aa + (size_t)m * 1024 + d) = ow;
                av = (f32x4){1.0f - bf_lo(ow.x), 1.0f - bf_hi(ow.x), 1.0f - bf_lo(ow.y), 1.0f - bf_hi(ow.y)};
                u32x2 w;
                w.x = cvt_pk(bv.x, bv.y);
                w.y = cvt_pk(bv.z, bv.w);
                *(u32x2*)(Bb + (size_t)m * 1024 + d) = w;
                if (prompt) {
                    *(f32x4*)(lds + rl * 64 + cl) = av;
                    *(f32x4*)(lds + 8192 + rl * 64 + cl) = (f32x4){bf_lo(w.x), bf_hi(w.x), bf_lo(w.y), bf_hi(w.y)};
                }
            }
        }
        __syncthreads();
        if (prompt && threadIdx.x < 64) {
            float A = 1.f, h = 0.f;
#pragma unroll 16
            for (int r = 0; r < 128; ++r) {
                const float a = lds[r * 64 + threadIdx.x], b = lds[8192 + r * 64 + threadIdx.x];
                A *= a;
                h = a * h + b;
            }
            const int chunk = m0 >> 7, d = blk * 256 + 64 * nt + threadIdx.x;
            carry[(size_t)chunk * 2048 + d] = A;
            carry[(size_t)chunk * 2048 + 1024 + d] = h;
        }
    }
};

__device__ __forceinline__ void c_gate_phase(const Params& p, bf16_t* smem) {
    const bf16_t* XC = (const bf16_t*)(p.ws + W_H);
    const bf16_t* Wg = (const bf16_t*)(p.ws + W_C_G);
    float* Aa = (float*)(p.ws + W_BUF2);
    bf16_t* Bb = (bf16_t*)(p.ws + W_BUF1);
    Stage st;
    bool pre = false;
    for (int t = blockIdx.x; t < 129 * 16; t += gridDim.x) {
        const int mt = t >> 4, blk = (t >> 2) & 3, nt = t & 3;
        const int tn = t + gridDim.x, blkn = (tn >> 2) & 3;
        const bool hn = tn < 129 * 16;
        EpiGate e{XC, Aa, Bb, p.in[21], p.in[23], (const float*)(p.ws + W_SP), blk, nt, (float*)smem, (float*)(p.ws + W_CARRY)};
        gemm_tile<true>(XC + blk * 256, 1024, Wg + (size_t)blk * 512 * 256, 256, 256, mt * 128, nt * 128, smem, e, st, pre, hn,
                        XC + blkn * 256, Wg + (size_t)blkn * 512 * 256, (tn >> 4) * 128, (tn & 3) * 128);
        pre = hn;
    }
}

__device__ __forceinline__ void c_scan1_phase(const Params& p) {
    const float* Aa = (const float*)(p.ws + W_BUF2);
    const bf16_t* Bb = (const bf16_t*)(p.ws + W_BUF1);
    float* carry = (float*)(p.ws + W_CARRY);
    for (int it = blockIdx.x; it < 512; it += gridDim.x) {
        const int chunk = it >> 2, d = (it & 3) * 256 + threadIdx.x;
        float A = 1.f, h = 0.f;
        const size_t base = (size_t)chunk * 128 * 1024 + d;
#pragma unroll 8
        for (int r = 0; r < 128; ++r) {
            const float a = 1.0f - bf2f(((const bf16_t*)Aa)[base + (size_t)r * 1024]), b = bf2f(Bb[base + (size_t)r * 1024]);
            A *= a;
            h = a * h + b;
        }
        carry[(size_t)chunk * 2048 + d] = A;
        carry[(size_t)chunk * 2048 + 1024 + d] = h;
    }
}

__device__ __forceinline__ void c_scan2_phase(const Params& p) {
    const float* Aa = (const float*)(p.ws + W_BUF2);
    const bf16_t* Bb = (const bf16_t*)(p.ws + W_BUF1);
    const bf16_t* SG = Bb + (size_t)MT * 1024;
    const float* carry = (const float*)(p.ws + W_CARRY);
    bf16_t* Z = (bf16_t*)(p.ws + W_H);
    for (int it = blockIdx.x; it < 512 + 512; it += gridDim.x) {
        if (it < 512) {
            const int chunk = it >> 2, d = (it & 3) * 256 + threadIdx.x;
            const int b = chunk >> 6, ci = chunk & 63;
            float h = 0.f;
            {
                const float* c0 = carry + (size_t)(b * 64) * 2048 + d;
                int jc = 0;
                for (; jc + 16 <= ci; jc += 16) {
                    float ca[16], ch[16];
#pragma unroll
                    for (int q = 0; q < 16; ++q) { ca[q] = c0[(size_t)(jc + q) * 2048]; ch[q] = c0[(size_t)(jc + q) * 2048 + 1024]; }
#pragma unroll
                    for (int q = 0; q < 16; ++q) h = ca[q] * h + ch[q];
                }
                for (; jc < ci; ++jc) h = c0[(size_t)jc * 2048] * h + c0[(size_t)jc * 2048 + 1024];
            }
            const size_t base = (size_t)chunk * 128 * 1024 + d;
for (int r0 = 0; r0 < 128; r0 += 32) {
                float av[32];
                bf16_t bv[32], sv[32];
#pragma unroll
                for (int q = 0; q < 32; ++q) {
                    const size_t o = base + (size_t)(r0 + q) * 1024;
                    av[q] = 1.0f - bf2f(((const bf16_t*)Aa)[o]); bv[q] = Bb[o]; sv[q] = SG[o];
                }
#pragma unroll
                for (int q = 0; q < 32; ++q) {
                    h = av[q] * h + bf2f(bv[q]);
                    Z[base + (size_t)(r0 + q) * 1024] = (bf16_t)(cvt_pk(h * bf2f(sv[q]), 0.f) & 0xffff);
                }
            }
            if (ci == 63) p.out[O_CHP + (size_t)b * 1024 + d] = h;
        } else {
            const int s = it - 512, d = (s & 3) * 256 + threadIdx.x, b = s >> 2;
            const size_t o = (size_t)(M_P + b) * 1024 + d;
            const float h = (1.0f - bf2f(((const bf16_t*)Aa)[o])) * p.in[5][(size_t)b * 1024 + d] + bf2f(Bb[o]);
            Z[o] = (bf16_t)(cvt_pk(h * bf2f(SG[o]), 0.f) & 0xffff);
            p.out[O_CHS + (size_t)b * 1024 + d] = h;
        }
    }
}

constexpr int N_PHASES = 20;

__device__ __forceinline__ void run_phase(const Params& p, int ph, unsigned char* smem_raw) {
    bf16_t* smem = (bf16_t*)smem_raw;
    float* Y = (float*)(p.ws + W_BUF2);
    float* YP = (float*)(p.ws + W_YPART);
    float* X = p.out + O_X;
    bf16_t* XB = (bf16_t*)(p.ws + W_XB);
    bf16_t* RSB = (bf16_t*)(p.ws + W_RS);
    bf16_t* H = (bf16_t*)(p.ws + W_H);
    switch (ph) {
        case 0: prep_phase(p, smem_raw); break;
        case 1: a_in_phase(p, 0, smem); break;
        case 2: a_mix_phase(p, 0, smem); break;
        case 3: out_gemm_phase((const bf16_t*)(p.ws + W_BUF1), 2048, (const bf16_t*)(p.ws + W_A_OUT), Y, YP, smem); break;
        case 4: norm_phase(Y, YP, 8, p.in[0], p.in[1], XB, true, nullptr, p.in[7] + 0 * 1024, p.in[6] + 1 * 1024, RSB); break;
        case 5: b_in_phase(p, smem); break;
        case 6: b_attn_phase(p, smem_raw); break;
        case 7: out_gemm_phase(H, 1024, (const bf16_t*)(p.ws + W_B_OUT), Y, YP, smem); break;
        case 8: norm_phase(Y, YP, 4, nullptr, nullptr, XB, true, nullptr, p.in[7] + 1 * 1024, p.in[6] + 2 * 1024, RSB); break;
        case 9: c_in_phase(p, smem); break;
        case 10: c_conv_phase(p); break;
        case 11: c_gate_phase(p, smem); break;
        case 12: c_scan1_phase(p); break;
        case 13: c_scan2_phase(p); break;
        case 14: out_gemm_phase(H, 1024, (const bf16_t*)(p.ws + W_C_OUT), Y, YP, smem); break;
        case 15: norm_phase(Y, YP, 4, nullptr, nullptr, XB, true, nullptr, p.in[7] + 2 * 1024, p.in[6] + 3 * 1024, RSB); break;
        case 16: a_in_phase(p, 1, smem); break;
        case 17: a_mix_phase(p, 1, smem); break;
        case 18: out_gemm_phase((const bf16_t*)(p.ws + W_BUF1), 2048, (const bf16_t*)(p.ws + W_A_OUT) + (size_t)1024 * 2048, Y, YP, smem); break;
        case 19: norm_phase(Y, YP, 8, nullptr, nullptr, XB, false, X, p.in[7] + 3 * 1024, nullptr, H); break;
        default: break;
    }
}


#define XB_TMO      128
#define XB_XCNT(j)  (256  + 64 * (j))
#define XB_XSUB(j)  (1280 + 64 * (j))
#define XB_XGEN(j)  (2304 + 64 * (j))
#define XB_TOP      3328
#define XB_TOPGEN   3392
#define XCD_BAR_WORDS 3456
#define XB_SPIN_CAP (1u << 20)
__device__ __forceinline__ unsigned xb_ld(unsigned* p) { return __hip_atomic_load(p, __ATOMIC_RELAXED, __HIP_MEMORY_SCOPE_AGENT); }
__device__ __forceinline__ unsigned xb_add(unsigned* p, unsigned v) { return __hip_atomic_fetch_add(p, v, __ATOMIC_RELAXED, __HIP_MEMORY_SCOPE_AGENT); }
__device__ __forceinline__ unsigned xb_xcc_id() { return (unsigned)__builtin_amdgcn_s_getreg((3 << 11) | 20) & 0xFu; }
#define XB_SPIN(cond, bar) do { unsigned _sp = 0; while (cond) { __builtin_amdgcn_s_sleep(1); \
    if ((++_sp & 255u) == 0u) { if (xb_ld(&(bar)[XB_TMO])) break; if (_sp > XB_SPIN_CAP) { atomicAdd(&(bar)[XB_TMO], 1u); break; } } } } while (0)
struct XcdBarrier { unsigned* bar; unsigned x, nloc, nx; };
__device__ __forceinline__ void xcd_barrier_complete(unsigned* bar, unsigned x, unsigned& nloc, unsigned& nx) {
    const unsigned G = gridDim.x;
    unsigned sum, cnt, mine, sp = 0u;
    for (;;) {
        sum = 0u; cnt = 0u; mine = 0u;
#pragma unroll
        for (unsigned j = 0; j < 16; ++j) { const unsigned c = xb_ld(&bar[XB_XCNT(j)]); sum += c; cnt += (c > 0u) ? 1u : 0u; mine = (j == x) ? c : mine; }
        if (sum == G) break;
        __builtin_amdgcn_s_sleep(1);
        if ((++sp & 255u) == 0u) { if (xb_ld(&bar[XB_TMO])) break; if (sp > XB_SPIN_CAP) { atomicAdd(&bar[XB_TMO], 1u); break; } }
    }
    nloc = mine > 0u ? mine : 1u; nx = cnt > 0u ? cnt : 1u;
}
__device__ __forceinline__ void xcd_barrier(XcdBarrier& b) {
    asm volatile("s_waitcnt vmcnt(0)" ::: "memory");
    __syncthreads();
    if (threadIdx.x == 0) {
        unsigned* bar = b.bar;
        __builtin_amdgcn_s_waitcnt(0);
        if (b.nloc == 0u) xcd_barrier_complete(bar, b.x, b.nloc, b.nx);
        const unsigned nloc = b.nloc, nx = b.nx;
        const unsigned old = xb_add(&bar[XB_XSUB(b.x)], 1u);
        const unsigned gen = old / nloc;
        if (old + 1u == (gen + 1u) * nloc) {
            __builtin_amdgcn_fence(__ATOMIC_RELEASE, "agent");
            asm volatile("s_waitcnt vmcnt(0)" ::: "memory");
            const unsigned og = xb_add(&bar[XB_TOP], 1u);
            const unsigned tg = og / nx;
            if (og + 1u == (tg + 1u) * nx) xb_add(&bar[XB_TOPGEN], 1u);
            else XB_SPIN(xb_ld(&bar[XB_TOPGEN]) == tg, bar);
            __builtin_amdgcn_fence(__ATOMIC_ACQUIRE, "agent");
            xb_add(&bar[XB_XGEN(b.x)], 1u);
            asm volatile("s_waitcnt vmcnt(0)" ::: "memory");
        } else {
            XB_SPIN(xb_ld(&bar[XB_XGEN(b.x)]) == gen, bar);
            __builtin_amdgcn_fence(__ATOMIC_ACQUIRE, "agent");
            asm volatile("s_waitcnt vmcnt(0)" ::: "memory");
        }
    }
    __syncthreads();
}

#ifndef PROBE_K
#define PROBE_K 20
#endif
__device__ __forceinline__ void dump_phase(const Params& p) {
    const unsigned* base = (const unsigned*)(p.ws);
    const size_t nwords = W_END / 4, n = (size_t)MT * D;
    const size_t gt = (size_t)blockIdx.x * NTHREADS + threadIdx.x, gn = (size_t)gridDim.x * NTHREADS;
    for (size_t i = gt; i < n; i += gn) {
        float a = 0.f;
        for (int k = 0; k < 4; ++k) {
            const size_t w = i + (size_t)k * n;
            if (w < nwords) { const unsigned u = base[w]; a += (float)((u * 2654435761u) >> 29); }
        }
        p.out[i] = a;
    }
}
constexpr size_t W_BAR = W_END;
#define PHASE(i) if (p.ph_lo <= (i) && (i) < p.ph_hi) { if ((i) > p.ph_lo) xcd_barrier(xb); run_phase(p, (i), smem_raw); }
__global__ void __launch_bounds__(NTHREADS, 2) mega_kernel(Params p) {
    __shared__ __attribute__((aligned(16))) unsigned char smem_raw[SMEM_BYTES];
    XcdBarrier xb;
    xb.bar = (unsigned*)(p.ws + W_BAR); xb.x = xb_xcc_id(); xb.nloc = 0u; xb.nx = 0u;
    if (threadIdx.x == 0) (void)xb_add(&xb.bar[XB_XCNT(xb.x)], 1u);
    if (p.ph_lo < 0) cg::this_grid().sync();
    PHASE(0) PHASE(1) PHASE(2) PHASE(3) PHASE(4) PHASE(5) PHASE(6) PHASE(7) PHASE(8) PHASE(9)
    PHASE(10) PHASE(11) PHASE(13) PHASE(14) PHASE(15) PHASE(16) PHASE(17) PHASE(18) PHASE(19)
    if (ONE_LAUNCH && p.ph_hi < N_PHASES && p.ph_lo == 0) { xcd_barrier(xb); dump_phase(p); }
    if (!ONE_LAUNCH && p.ph_lo == N_PHASES) dump_phase(p);
}

extern "C" void kernel_launch(void* const* d_in, const int* in_sizes, int n_in, void* d_out, int out_size, void* d_ws, size_t ws_size,
                              hipStream_t stream) {
    static int grid = 0;
    if (grid == 0) {
        if (n_in != 26 || (size_t)out_size != O_END || ws_size < W_END + XCD_BAR_WORDS * 4) {
            fprintf(stderr, "kernel_launch: unexpected shapes n_in=%d out=%d ws=%zu (need %zu)\n", n_in, out_size, ws_size, (size_t)W_END);
            grid = -1;
            return;
        }
        int dev = 0, cus = 0, per_cu = 0;
        (void)hipGetDevice(&dev);
        (void)hipDeviceGetAttribute(&cus, hipDeviceAttributeMultiprocessorCount, dev);
        (void)hipOccupancyMaxActiveBlocksPerMultiprocessor(&per_cu, (const void*)mega_kernel, NTHREADS, 0);
        if (per_cu < 1) per_cu = 1;
        if (per_cu > 2) per_cu = 2;
        grid = cus * per_cu;
    }
    if (grid < 0) return;
    Params p{};
    for (int i = 0; i < 26; ++i) p.in[i] = (const float*)d_in[i];
    p.out = (float*)d_out;
    p.ws = (unsigned char*)d_ws;
#if ONE_LAUNCH
    (void)hipMemsetAsync((unsigned char*)d_ws + W_BAR, 0, XCD_BAR_WORDS * 4, stream);
    p.ph_lo = 0;
    p.ph_hi = PROBE_K;
    void* args[] = {&p};
    hipError_t e = hipLaunchCooperativeKernel((const void*)mega_kernel, dim3(grid), dim3(NTHREADS), args, 0, stream);
    if (e != hipSuccess) fprintf(stderr, "cooperative launch failed: %s (grid %d)\n", hipGetErrorString(e), grid);
#else
    for (int ph = 0; ph < N_PHASES; ++ph) {
        p.ph_lo = ph;
        p.ph_hi = ph + 1;
        hipLaunchKernelGGL(mega_kernel, dim3(grid), dim3(NTHREADS), 0, stream, p);
    }
#endif
}
```

```cpp
#include <hip/hip_runtime.h>
#include <hip/hip_cooperative_groups.h>
#include <stdint.h>
#include <stdio.h>
#include <math.h>
namespace cg = cooperative_groups;

#ifndef ONE_LAUNCH
#define ONE_LAUNCH 1
#endif

typedef unsigned short bf16_t;
typedef short bf16x8 __attribute__((ext_vector_type(8)));
typedef float f32x4 __attribute__((ext_vector_type(4)));
typedef unsigned u32x4 __attribute__((ext_vector_type(4)));
typedef unsigned u32x2 __attribute__((ext_vector_type(2)));

constexpr int M_P = 16384, M_S = 128, MT = 16512, D = 1024, SEQ = 8192;
constexpr int NTHREADS = 256;
constexpr int SMEM_BYTES = 65536;

constexpr size_t O_X = 0;
constexpr size_t O_AV = (size_t)MT * D;
constexpr size_t O_BKP = O_AV + 2 * 128 * 2048;
constexpr size_t O_BVP = O_BKP + 2 * 128 * 128;
constexpr size_t O_BKS = O_BVP + 2 * 128 * 128;
constexpr size_t O_BVS = O_BKS + 128 * 128 * 128;
constexpr size_t O_CCP = O_BVS + 128 * 128 * 128;
constexpr size_t O_CHP = O_CCP + 2 * 3 * 1024;
constexpr size_t O_CCS = O_CHP + 2 * 1024;
constexpr size_t O_CHS = O_CCS + 128 * 3 * 1024;
constexpr size_t O_END = O_CHS + 128 * 1024;

constexpr size_t W_A_IN = 0;
constexpr size_t W_A_OUT = W_A_IN + (size_t)2 * 6144 * 1024 * 2;
constexpr size_t W_B_IN = W_A_OUT + (size_t)2 * 1024 * 2048 * 2;
constexpr size_t W_B_OUT = W_B_IN + (size_t)2304 * 1024 * 2;
constexpr size_t W_C_IN = W_B_OUT + (size_t)1024 * 1024 * 2;
constexpr size_t W_C_G = W_C_IN + (size_t)2048 * 1024 * 2;
constexpr size_t W_C_OUT = W_C_G + (size_t)4 * 512 * 256 * 2;
constexpr size_t W_WS_A = W_C_OUT + (size_t)1024 * 1024 * 2;
constexpr size_t W_ROPE = W_WS_A + (size_t)2 * 4 * 128 * 128 * 2;
constexpr size_t W_H = W_ROPE + (size_t)8193 * 64 * 4;
constexpr size_t W_BUF1 = W_H + (size_t)MT * 1024 * 2;
constexpr size_t W_BUF2 = W_BUF1 + (size_t)MT * 2048 * 2;
constexpr size_t W_KB = W_BUF2 + (size_t)MT * 2048 * 2;
constexpr size_t W_STATS = W_KB;
constexpr size_t W_CARRY = W_KB + (size_t)MT * 256 * 2;
constexpr size_t W_YPART = W_CARRY + (size_t)128 * 1024 * 2 * 4;
constexpr size_t W_XB = W_YPART + (size_t)8 * 128 * 1024 * 4;
constexpr size_t W_SP = W_XB + (size_t)MT * 1024 * 2;
constexpr size_t W_RS = W_SP + 4096;
constexpr size_t W_END = W_RS + (size_t)MT * 4;

struct Params {
    const float* in[26];
    float* out;
    unsigned char* ws;
    int ph_lo, ph_hi;
};

__device__ __forceinline__ unsigned cvt_pk(float lo, float hi) {
    unsigned r;
    asm("v_cvt_pk_bf16_f32 %0, %1, %2" : "=v"(r) : "v"(lo), "v"(hi));
    return r;
}
__device__ __forceinline__ float bf_lo(unsigned u) { return __uint_as_float(u << 16); }
__device__ __forceinline__ float bf_hi(unsigned u) { return __uint_as_float(u & 0xffff0000u); }
__device__ __forceinline__ float bf2f(bf16_t h) { return __uint_as_float(((unsigned)h) << 16); }
__device__ __forceinline__ float sigmoid_f(float x) { return __builtin_amdgcn_rcpf(1.f + __expf(-x)); }
__device__ __forceinline__ float silu_f(float x) { return x * sigmoid_f(x); }
__device__ __forceinline__ float gelu_f(float x) { return x * sigmoid_f(1.5957691216057308f * (x + 0.044715f * x * x * x)); }
__device__ __forceinline__ float gelu_silu(float u, float g) {
    const float eu = __expf(-1.5957691216057308f * (u + 0.044715f * u * u * u)), eg = __expf(-g);
    const float den = (1.f + eu) * (1.f + eg);
    return (u * g) * __builtin_amdgcn_rcpf(den);
}
template <int CTRL> __device__ __forceinline__ float dpp_add(float x) {
    return x + __builtin_bit_cast(float, __builtin_amdgcn_update_dpp(0, __builtin_bit_cast(int, x), CTRL, 0xF, 0xF, true));
}
__device__ __forceinline__ float row16_sum(float x) {
    x = dpp_add<0xB1>(x);
    x = dpp_add<0x4E>(x);
    x = dpp_add<0x141>(x);
    x = dpp_add<0x140>(x);
    return x;
}
__device__ __forceinline__ float wave_sum(float v) {
#pragma unroll
    for (int o = 1; o < 64; o <<= 1) v += __shfl_xor(v, o);
    return v;
}

__device__ __forceinline__ int perm32(int rho) { return 8 * ((rho & 15) >> 2) + 4 * (rho >> 4) + (rho & 3); }
__device__ __forceinline__ int permcol(int c) { return (c & ~31) + perm32(c & 31); }
__device__ __forceinline__ int swz(int row, int chunk) { return (chunk ^ (((row >> 3) & 1) << 1)) * 8; }

template <bool TRANS>
__device__ __forceinline__ void mma_stage(const bf16_t* As, const bf16_t* Bs, int apanel, int bpanel, f32x4 (&acc)[4][4], int wr, int wc, int lane) {
    const int fr = lane & 15, fq = lane >> 4;
    const int co = swz(fr, fq);
#pragma unroll
    for (int kk = 0; kk < 2; ++kk) {
        bf16x8 a[4], b[4];
#pragma unroll
        for (int i = 0; i < 4; ++i) {
            a[i] = *(const bf16x8*)(As + kk * apanel + (wr * 64 + i * 16 + fr) * 32 + co);
            b[i] = *(const bf16x8*)(Bs + kk * bpanel + (wc * 64 + i * 16 + fr) * 32 + co);
        }
#pragma unroll
        for (int i = 0; i < 4; ++i)
#pragma unroll
            for (int j = 0; j < 4; ++j)
                acc[i][j] = TRANS ? __builtin_amdgcn_mfma_f32_16x16x32_bf16(b[j], a[i], acc[i][j], 0, 0, 0)
                                  : __builtin_amdgcn_mfma_f32_16x16x32_bf16(a[i], b[j], acc[i][j], 0, 0, 0);
    }
}

__device__ __forceinline__ void g2r(const bf16_t* __restrict__ g, int ld, int row0, int k0, int tid, u32x4 (&r)[4]) {
    const int rl = 2 * (tid >> 4) + ((tid >> 2) & 1), kc = ((tid >> 3) & 1) * 4 + (tid & 3);
    const unsigned voff = (unsigned)(rl * ld + kc * 8) * 2u;
#pragma unroll
    for (int i = 0; i < 4; ++i) {
        const char* b = (const char*)(g + (size_t)(row0 + 32 * i) * ld + k0);
        r[i] = *(const u32x4*)(b + voff);
    }
}
__device__ __forceinline__ void r2s(bf16_t* s, int tid, const u32x4 (&r)[4]) {
    const int rl = 2 * (tid >> 4) + ((tid >> 2) & 1), kc = ((tid >> 3) & 1) * 4 + (tid & 3);
#pragma unroll
    for (int i = 0; i < 4; ++i) {
        const int row = rl + 32 * i;
        *(u32x4*)(s + (kc >> 2) * 4096 + row * 32 + swz(row, kc & 3)) = r[i];
    }
}

__device__ __forceinline__ void g2r32(const bf16_t* __restrict__ g, int ld, int row0, int k0, int tid, u32x4 (&r)[2]) {
    const unsigned voff = (unsigned)((tid >> 2) * ld + (tid & 3) * 8) * 2u;
#pragma unroll
    for (int i = 0; i < 2; ++i) {
        const char* b = (const char*)(g + (size_t)(row0 + 64 * i) * ld + k0);
        r[i] = *(const u32x4*)(b + voff);
    }
}
__device__ __forceinline__ void r2s32(bf16_t* s, int tid, const u32x4 (&r)[2]) {
#pragma unroll
    for (int i = 0; i < 2; ++i) {
        const int row = (tid >> 2) + 64 * i;
        *(u32x4*)(s + row * 32 + swz(row, tid & 3)) = r[i];
    }
}
__device__ __forceinline__ void ldfrag(const bf16_t* st, bf16x8 (&a)[4], bf16x8 (&b)[4], int wr, int wc, int fr, int co) {
#pragma unroll
    for (int i = 0; i < 4; ++i) {
        a[i] = *(const bf16x8*)(st + (wr * 64 + i * 16 + fr) * 32 + co);
        b[i] = *(const bf16x8*)(st + 4096 + (wc * 64 + i * 16 + fr) * 32 + co);
    }
}
template <bool TRANS>
__device__ __forceinline__ void mma16(const bf16x8 (&a)[4], const bf16x8 (&b)[4], f32x4 (&acc)[4][4]) {
    __builtin_amdgcn_s_setprio(1);
#pragma unroll
    for (int i = 0; i < 4; ++i)
#pragma unroll
        for (int j = 0; j < 4; ++j)
            acc[i][j] = TRANS ? __builtin_amdgcn_mfma_f32_16x16x32_bf16(b[j], a[i], acc[i][j], 0, 0, 0)
                              : __builtin_amdgcn_mfma_f32_16x16x32_bf16(a[i], b[j], acc[i][j], 0, 0, 0);
    __builtin_amdgcn_s_setprio(0);
}

struct Stage { u32x4 ra0[2], rb0[2], ra1[2], rb1[2]; };

template <bool TRANS, class Epi>
__device__ __forceinline__ void gemm_tile(const bf16_t* __restrict__ A, int lda, const bf16_t* __restrict__ Bt, int ldb, int K, int m0, int n0,
                                          bf16_t* smem, const Epi epi, Stage& st, bool pre, bool has_next, const bf16_t* __restrict__ An,
                                          const bf16_t* __restrict__ Bn, int m0n, int n0n) {
    const int tid = threadIdx.x, wid = tid >> 6, lane = tid & 63, wr = wid >> 1, wc = wid & 1, fr = lane & 15, fq = lane >> 4;
    const int co = swz(fr, fq);
    f32x4 acc[4][4];
#pragma unroll
    for (int i = 0; i < 4; ++i)
#pragma unroll
        for (int j = 0; j < 4; ++j) acc[i][j] = (f32x4){0.f, 0.f, 0.f, 0.f};
    const int nk = K >> 5;
    bf16x8 a0[4], b0[4], a1[4], b1[4];
    if (!pre) {
        g2r32(A, lda, m0, 0, tid, st.ra0);
        g2r32(Bt, ldb, n0, 0, tid, st.rb0);
        g2r32(A, lda, m0, 32, tid, st.ra1);
        g2r32(Bt, ldb, n0, 32, tid, st.rb1);
    }
    __syncthreads();
    r2s32(smem, tid, st.ra0);
    r2s32(smem + 4096, tid, st.rb0);
    r2s32(smem + 8192, tid, st.ra1);
    r2s32(smem + 8192 + 4096, tid, st.rb1);
    g2r32(A, lda, m0, 64, tid, st.ra0);
    g2r32(Bt, ldb, n0, 64, tid, st.rb0);
    g2r32(A, lda, m0, 96, tid, st.ra1);
    g2r32(Bt, ldb, n0, 96, tid, st.rb1);
    __syncthreads();
    ldfrag(smem, a0, b0, wr, wc, fr, co);
    for (int kt = 0; kt < nk; kt += 2) {
        {
            bf16_t* w = smem + ((kt + 2) & 3) * 8192;
            r2s32(w, tid, st.ra0);
            r2s32(w + 4096, tid, st.rb0);
            const int kn = (kt + 4 < nk ? kt + 4 : nk - 1) * 32;
            g2r32(A, lda, m0, kn, tid, st.ra0);
            g2r32(Bt, ldb, n0, kn, tid, st.rb0);
            ldfrag(smem + ((kt + 1) & 3) * 8192, a1, b1, wr, wc, fr, co);
            mma16<TRANS>(a0, b0, acc);
            __syncthreads();
        }
        {
            bf16_t* w = smem + ((kt + 3) & 3) * 8192;
            r2s32(w, tid, st.ra1);
            r2s32(w + 4096, tid, st.rb1);
            const int kn = (kt + 5 < nk ? kt + 5 : nk - 1) * 32;
            g2r32(A, lda, m0, kn, tid, st.ra1);
            g2r32(Bt, ldb, n0, kn, tid, st.rb1);
            ldfrag(smem + ((kt + 2) & 3) * 8192, a0, b0, wr, wc, fr, co);
            mma16<TRANS>(a1, b1, acc);
            __syncthreads();
        }
    }
    if (has_next) {
        g2r32(An, lda, m0n, 0, tid, st.ra0);
        g2r32(Bn, ldb, n0n, 0, tid, st.rb0);
        g2r32(An, lda, m0n, 32, tid, st.ra1);
        g2r32(Bn, ldb, n0n, 32, tid, st.rb1);
    }
    epi(acc, m0, n0, wr, wc, lane);
}

__device__ __forceinline__ void wt_tile(const float* colptr, int ldsrc, bf16_t* dst, int ldd, float* tile, int tid, const float* ksc = nullptr) {
    const int tx = tid & 63, ty = tid >> 6;
    float v[16];
#pragma unroll
    for (int q = 0; q < 16; ++q) v[q] = colptr[(size_t)(ty + 4 * q) * ldsrc];
    if (ksc) {
#pragma unroll
        for (int q = 0; q < 16; ++q) v[q] *= ksc[ty + 4 * q];
    }
#pragma unroll
    for (int q = 0; q < 16; ++q) tile[(ty + 4 * q) * 65 + tx] = v[q];
    __syncthreads();
    const int c2 = tid & 31, r0 = tid >> 5;
#pragma unroll
    for (int rr = r0; rr < 64; rr += 8)
        *(unsigned*)(dst + (size_t)rr * ldd + 2 * c2) = cvt_pk(tile[(2 * c2) * 65 + rr], tile[(2 * c2 + 1) * 65 + rr]);
    __syncthreads();
}

__device__ __forceinline__ void sincos_d(double x, double& s, double& c) {
    const double k = rint(x * 0.63661977236758134308);
    double r = fma(-k, 1.57079632673412561417e+00, x);
    r = fma(-k, 6.07710050650619224932e-11, r);
    const double z = r * r;
    const double sp = r + r * z * (-1.66666666666666324348e-01 + z * (8.33333333332248946124e-03 + z * (-1.98412698298579493134e-04 + z * (2.75573137070700676789e-06 + z * (-2.50507602534068634195e-08 + z * 1.58969099521155010221e-10)))));
    const double cp = 1.0 - 0.5 * z + z * z * (4.16666666666666019037e-02 + z * (-1.38888888888741095749e-03 + z * (2.48015872894767294178e-05 + z * (-2.75573143513906633035e-07 + z * (2.08757232129817482790e-09 + z * -1.13596475577881948265e-11)))));
    const int q = ((int)k) & 3;
    s = (q == 0) ? sp : (q == 1) ? cp : (q == 2) ? -sp : -cp;
    c = (q == 0) ? cp : (q == 1) ? -sp : (q == 2) ? -cp : sp;
}

__device__ __forceinline__ void norm_phase(const float* __restrict__ Y, const float* __restrict__ Ypart, int nsplit, const float* xin_p, const float* xin_s,
                                           bf16_t* Xb, bool storeXb, float* Xf, const float* gpost, const float* gpre, bf16_t* H) {
    const int lane = threadIdx.x & 63;
    const int gw = blockIdx.x * 4 + (threadIdx.x >> 6), nw = gridDim.x * 4;
    for (int ri = gw; ri < MT; ri += nw) {
        const int row = ri < M_S ? M_P + ri : ri - M_S;
        f32x4 x[4];
        if (xin_p) {
            const float* xr = row < M_P ? xin_p + (size_t)row * D : xin_s + (size_t)(row - M_P) * D;
#pragma unroll
            for (int j = 0; j < 4; ++j) x[j] = *(const f32x4*)(xr + j * 256 + lane * 4);
        } else {
#pragma unroll
            for (int j = 0; j < 4; ++j) {
                const u32x2 w = *(const u32x2*)(Xb + (size_t)row * D + j * 256 + lane * 4);
                x[j] = (f32x4){bf_lo(w.x), bf_hi(w.x), bf_lo(w.y), bf_hi(w.y)};
            }
        }
        if (Y) {
            f32x4 y[4];
            float ss = 0.f;
            if (row < M_P) {
#pragma unroll
                for (int j = 0; j < 4; ++j) {
                    const u32x2 w = *(const u32x2*)((const bf16_t*)Y + (size_t)row * D + j * 256 + lane * 4);
                    y[j] = (f32x4){bf_lo(w.x), bf_hi(w.x), bf_lo(w.y), bf_hi(w.y)};
                }
            } else {
#pragma unroll
                for (int j = 0; j < 4; ++j) y[j] = (f32x4){0.f, 0.f, 0.f, 0.f};
                for (int s = 0; s < nsplit; s += 4) {
                    f32x4 t[4][4];
#pragma unroll
                    for (int u = 0; u < 4; ++u)
#pragma unroll
                        for (int j = 0; j < 4; ++j) t[u][j] = *(const f32x4*)(Ypart + ((size_t)(s + u) * 128 + (row - M_P)) * D + j * 256 + lane * 4);
#pragma unroll
                    for (int u = 0; u < 4; ++u)
#pragma unroll
                        for (int j = 0; j < 4; ++j) y[j] += t[u][j];
                }
            }
#pragma unroll
            for (int j = 0; j < 4; ++j) ss += y[j].x * y[j].x + y[j].y * y[j].y + y[j].z * y[j].z + y[j].w * y[j].w;
            ss = wave_sum(ss);
            const float rstd = rsqrtf(ss * (1.f / 1024.f) + 1e-6f);
#pragma unroll
            for (int j = 0; j < 4; ++j) {
                const f32x4 g = *(const f32x4*)(gpost + j * 256 + lane * 4);
                x[j] = x[j] + y[j] * rstd * g;
            }
        }
        if (storeXb) {
#pragma unroll
            for (int j = 0; j < 4; ++j) {
                u32x2 w;
                w.x = cvt_pk(x[j].x, x[j].y);
                w.y = cvt_pk(x[j].z, x[j].w);
                *(u32x2*)(Xb + (size_t)row * D + j * 256 + lane * 4) = w;
            }
        }
        if (Xf) {
#pragma unroll
            for (int j = 0; j < 4; ++j) *(f32x4*)(Xf + (size_t)row * D + j * 256 + lane * 4) = x[j];
        }
        if (gpre) {
            float ss = 0.f;
#pragma unroll
            for (int j = 0; j < 4; ++j) ss += x[j].x * x[j].x + x[j].y * x[j].y + x[j].z * x[j].z + x[j].w * x[j].w;
            ss = wave_sum(ss);
            if (lane == 0) ((float*)H)[row] = rsqrtf(ss * (1.f / 1024.f) + 1e-6f);
        }
    }
}

constexpr int WT_FIRST = 96 * 16;
constexpr int WT_TOTAL = 2 * 96 * 16 + 2 * 16 * 32 + 36 * 16 + 256 + 32 * 16 + 128 + 256;
__device__ __forceinline__ void wt_jobs(const Params& p, unsigned char* smem, int lo, int hi, int w, int nw) {
    float* tile = (float*)smem;
    const int tid = threadIdx.x, tx = tid & 63;
    constexpr int T_AIN = 96 * 16, T_AOUT = 16 * 32, T_BIN = 36 * 16, T_BOUT = 256, T_CIN = 32 * 16, T_CG = 128, T_COUT = 256;
    for (int it = lo + w; it < hi; it += nw) {
        int r = it;
        if (r < 2 * T_AIN) {
            const int j = r / T_AIN; r -= j * T_AIN;
            const int nt = r >> 4, kt = r & 15, np = permcol(nt * 64 + tx);
            int col;
            const int T = np >> 7, w = np & 127;
            if (T < 32) {
                const int wc = w >> 6, jn = (w >> 4) & 3, i = w & 15;
                col = ((jn < 2) ? 0 : 4096) + 64 * T + 32 * wc + 16 * (jn & 1) + i;
            } else col = 2048 + (np - 4096);
            wt_tile(p.in[8] + (size_t)j * 1024 * 6144 + (size_t)(kt * 64) * 6144 + col, 6144,
                    (bf16_t*)(p.ws + W_A_IN) + (size_t)j * 6144 * 1024 + (size_t)(nt * 64) * 1024 + kt * 64, 1024, tile, tid, p.in[6] + (j == 0 ? 0 : 3) * 1024 + kt * 64);
            continue;
        }
        r -= 2 * T_AIN;
        if (r < 2 * T_AOUT) {
            const int j = r / T_AOUT; r -= j * T_AOUT;
            const int nt = r >> 5, kt = r & 31;
            wt_tile(p.in[13] + (size_t)j * 2048 * 1024 + (size_t)(kt * 64) * 1024 + permcol(nt * 64 + tx), 1024,
                    (bf16_t*)(p.ws + W_A_OUT) + (size_t)j * 1024 * 2048 + (size_t)(nt * 64) * 2048 + kt * 64, 2048, tile, tid);
            continue;
        }
        r -= 2 * T_AOUT;
        if (r < T_BIN) {
            const int nt = r >> 4, kt = r & 15;
            wt_tile(p.in[14] + (size_t)(kt * 64) * 2304 + permcol(nt * 64 + tx), 2304, (bf16_t*)(p.ws + W_B_IN) + (size_t)(nt * 64) * 1024 + kt * 64, 1024, tile, tid, p.in[6] + 1 * 1024 + kt * 64);
            continue;
        }
        r -= T_BIN;
        if (r < T_BOUT) {
            const int nt = r >> 4, kt = r & 15;
            wt_tile(p.in[16] + (size_t)(kt * 64) * 1024 + permcol(nt * 64 + tx), 1024, (bf16_t*)(p.ws + W_B_OUT) + (size_t)(nt * 64) * 1024 + kt * 64, 1024, tile, tid);
            continue;
        }
        r -= T_BOUT;
        if (r < T_CIN) {
            const int nt = r >> 4, kt = r & 15;
            wt_tile(p.in[17] + (size_t)(kt * 64) * 2048 + permcol(nt * 64 + tx), 2048, (bf16_t*)(p.ws + W_C_IN) + (size_t)(nt * 64) * 1024 + kt * 64, 1024, tile, tid, p.in[6] + 2 * 1024 + kt * 64);
            continue;
        }
        r -= T_CIN;
        if (r < T_CG) {
            const int blk = r >> 5, rr = r & 31, nt = rr >> 2, kt = rr & 3;
            const int np = permcol(nt * 64 + tx), j4 = np >> 7, w = np & 127, wc = w >> 6, jn = (w >> 4) & 3, i = w & 15;
            const int dl = 64 * j4 + 32 * wc + 16 * (jn & 1) + i;
            const float* src = ((jn < 2) ? p.in[20] : p.in[22]) + (size_t)blk * 65536;
            wt_tile(src + (size_t)(kt * 64) * 256 + dl, 256, (bf16_t*)(p.ws + W_C_G) + (size_t)blk * 512 * 256 + (size_t)(nt * 64) * 256 + kt * 64, 256, tile, tid);
            continue;
        }
        r -= T_CG;
        {
            const int nt = r >> 4, kt = r & 15;
            wt_tile(p.in[24 + 1] + (size_t)(kt * 64) * 1024 + permcol(nt * 64 + tx), 1024, (bf16_t*)(p.ws + W_C_OUT) + (size_t)(nt * 64) * 1024 + kt * 64, 1024, tile, tid);
        }
    }
}

__device__ __forceinline__ void prep_phase(const Params& p, unsigned char* smem) {
    const int tid = threadIdx.x;
    wt_jobs(p, smem, 0, WT_FIRST, blockIdx.x, gridDim.x);
    const int gt = blockIdx.x * NTHREADS + tid, gn = gridDim.x * NTHREADS;
    {
        bf16_t* wsa = (bf16_t*)(p.ws + W_WS_A);
        const float* src = p.in[11];
        for (int idx = gt; idx < 2 * 4 * 128 * 128 / 2; idx += gn) {
            const int e = idx * 2, t = (e >> 7) & 127, s = e & 127;
            const float a = (s <= t) ? src[e] : 0.f, b = (s + 1 <= t) ? src[e + 1] : 0.f;
            *(unsigned*)(wsa + e) = cvt_pk(a, b);
        }
    }
    if (gt < 1024) ((float*)(p.ws + W_SP))[gt] = log1pf(__expf(-p.in[24][gt]));
    {
        float* rt = (float*)(p.ws + W_ROPE);
        for (int idx = gt; idx < 8193 * 32; idx += gn) {
            const int pos = idx >> 5, i = idx & 31;
            const float ang = (float)pos * exp2f(-(float)i * (13.287712379549449f / 32.0f));
            double s, c;
            sincos_d((double)ang, s, c);
            rt[pos * 64 + i] = (float)c;
            rt[pos * 64 + 32 + i] = (float)s;
        }
    }
    norm_phase(nullptr, nullptr, 0, p.in[0], p.in[1], (bf16_t*)(p.ws + W_XB), true, nullptr, nullptr, p.in[6], (bf16_t*)(p.ws + W_RS));
}

struct EpiUG {
    bf16_t* P;
    int T;
    const float* rs;
    __device__ __forceinline__ void operator()(f32x4 (&acc)[4][4], int m0, int n0, int wr, int wc, int lane) const {
        const int fr = lane & 15, fq = lane >> 4;
#pragma unroll
        for (int i = 0; i < 4; ++i) {
            const int m = m0 + wr * 64 + i * 16 + fr;
            const int ch = 64 * T + 32 * wc + 8 * fq;
            const float sc = rs[m];
            u32x4 w;
            {
                const f32x4 u = acc[i][0] * sc, g = acc[i][2] * sc;
                w.x = cvt_pk(gelu_silu(u.x, g.x), gelu_silu(u.y, g.y));
                w.y = cvt_pk(gelu_silu(u.z, g.z), gelu_silu(u.w, g.w));
            }
            {
                const f32x4 u = acc[i][1] * sc, g = acc[i][3] * sc;
                w.z = cvt_pk(gelu_silu(u.x, g.x), gelu_silu(u.y, g.y));
                w.w = cvt_pk(gelu_silu(u.z, g.z), gelu_silu(u.w, g.w));
            }
            *(u32x4*)(P + (size_t)m * 2048 + ch) = w;
        }
    }
};
struct EpiV {
    bf16_t* GVt;
    float* stats;
    int mt, tv;
    const float* rs;
    __device__ __forceinline__ void operator()(f32x4 (&acc)[4][4], int m0, int n0, int wr, int wc, int lane) const {
        const int fr = lane & 15, fq = lane >> 4;
#pragma unroll
        for (int i = 0; i < 4; ++i) {
            const int sl = wr * 64 + i * 16 + fq * 4;
            f32x4 sum = {0.f, 0.f, 0.f, 0.f}, sq = {0.f, 0.f, 0.f, 0.f};
#pragma unroll
            for (int jn = 0; jn < 4; ++jn) {
                const int ch = 128 * tv + wc * 64 + 32 * (jn >> 1) + perm32(16 * (jn & 1) + fr);
                f32x4 v = acc[i][jn] * *(const f32x4*)(rs + m0 + sl);
                v.x = gelu_f(v.x); v.y = gelu_f(v.y); v.z = gelu_f(v.z); v.w = gelu_f(v.w);
                u32x2 w;
                w.x = cvt_pk(v.x, v.y);
                w.y = cvt_pk(v.z, v.w);
                *(u32x2*)(GVt + ((size_t)mt * 2048 + ch) * 128 + sl) = w;
                sum += v;
                sq += v * v;
            }
            sum.x = row16_sum(sum.x); sum.y = row16_sum(sum.y); sum.z = row16_sum(sum.z); sum.w = row16_sum(sum.w);
            sq.x = row16_sum(sq.x); sq.y = row16_sum(sq.y); sq.z = row16_sum(sq.z); sq.w = row16_sum(sq.w);
            if (fr == 0) {
                float* st = stats + (size_t)(m0 + sl) * 64 + (tv * 2 + wc) * 2;
                st[0] = sum.x; st[1] = sq.x;
                st[64] = sum.y; st[65] = sq.y;
                st[128] = sum.z; st[129] = sq.z;
                st[192] = sum.w; st[193] = sq.w;
            }
        }
    }
};

__device__ __forceinline__ void a_in_phase(const Params& p, int j, bf16_t* smem) {
    const bf16_t* H = (const bf16_t*)(p.ws + W_XB);
    const float* RS = (const float*)(p.ws + W_RS);
    const bf16_t* Wt = (const bf16_t*)(p.ws + W_A_IN) + (size_t)j * 6144 * 1024;
    bf16_t* P = (bf16_t*)(p.ws + W_BUF1);
    bf16_t* GVt = (bf16_t*)(p.ws + W_BUF2);
    float* stats = (float*)(p.ws + W_STATS);
    Stage st;
    bool pre = false;
    for (int t = blockIdx.x; t < 129 * 48; t += gridDim.x) {
        const int mt = t / 48, nt = t % 48;
        const int tn = t + gridDim.x;
        const bool hn = tn < 129 * 48;
        const int m0n = (tn / 48) * 128, n0n = (tn % 48) * 128;
        if (nt < 32) {
            EpiUG e{P, nt, RS};
            gemm_tile<true>(H, 1024, Wt, 1024, 1024, mt * 128, nt * 128, smem, e, st, pre, hn, H, Wt, m0n, n0n);
        } else {
            EpiV e{GVt, stats, mt, nt - 32, RS};
            gemm_tile<false>(H, 1024, Wt, 1024, 1024, mt * 128, nt * 128, smem, e, st, pre, hn, H, Wt, m0n, n0n);
        }
        pre = hn;
    }
    if (j == 0) {
        const int busy = (129 * 48) % gridDim.x, idle = gridDim.x - busy;
        if (idle > 0 && (int)blockIdx.x >= busy) wt_jobs(p, (unsigned char*)smem, WT_FIRST, WT_TOTAL, blockIdx.x - busy, idle);
        else if (idle <= 0) wt_jobs(p, (unsigned char*)smem, WT_FIRST, WT_TOTAL, blockIdx.x, gridDim.x);
    }
}

__device__ __forceinline__ void a_mix_phase(const Params& p, int j, bf16_t* smem) {
    const int tid = threadIdx.x, wid = tid >> 6, lane = tid & 63, wr = wid >> 1, wc = wid & 1, fr = lane & 15, fq = lane >> 4;
    bf16_t* P = (bf16_t*)(p.ws + W_BUF1);
    const bf16_t* GVt = (const bf16_t*)(p.ws + W_BUF2);
    const float* stats = (const float*)(p.ws + W_STATS);
    const bf16_t* wsa = (const bf16_t*)(p.ws + W_WS_A) + (size_t)j * 4 * 128 * 128;
    const float* ln_g = p.in[9] + j * 2048;
    const float* ln_b = p.in[10] + j * 2048;
    const float* b_s = p.in[12] + j * 4 * 128;
    const float* w_s = p.in[11] + (size_t)j * 4 * 128 * 128;
    float* av_out = p.out + O_AV + (size_t)j * 128 * 2048;
    bf16_t* As = smem;
    bf16_t* Bs = smem + 16384;
    float* mu = (float*)(smem + 16384);
    float* rs = mu + 128;
    for (int it = blockIdx.x; it < 129 * 16; it += gridDim.x) {
        const int chunk = it >> 4, g = (it >> 2) & 3, slab = it & 3;
        const bool samp = (chunk == 128);
        f32x4 sv[8];
        {
            const float* stp = stats + (size_t)(chunk * 128 + (tid >> 1)) * 64 + (tid & 1) * 32;
#pragma unroll
            for (int k = 0; k < 8; ++k) sv[k] = *(const f32x4*)(stp + k * 4);
        }
        u32x4 araw[8], braw[8];
        float lg[8], lb[8];
        const float w00 = w_s[g * 16384];
        {
            const bf16_t* wg = wsa + g * 16384;
#pragma unroll
            for (int i = 0; i < 8; ++i) {
                const int c = tid + 256 * i, row = c >> 4, sc = c & 15;
                araw[i] = (u32x4){0u, 0u, 0u, 0u};
                if (!samp) araw[i] = *(const u32x4*)(wg + row * 128 + sc * 8);
                const int ch = g * 512 + slab * 128 + permcol(row);
                braw[i] = *(const u32x4*)(GVt + ((size_t)chunk * 2048 + ch) * 128 + sc * 8);
                lg[i] = ln_g[ch];
                lb[i] = ln_b[ch];
            }
        }
        float s = 0.f, q = 0.f;
#pragma unroll
        for (int k = 0; k < 8; ++k) { s += sv[k].x + sv[k].z; q += sv[k].y + sv[k].w; }
        s += __shfl_xor(s, 1);
        q += __shfl_xor(q, 1);
        const float mean = s * (1.f / 2048.f);
        const float var = fmaxf(q * (1.f / 2048.f) - mean * mean, 0.f);
        __syncthreads();
        if ((tid & 1) == 0) { mu[tid >> 1] = mean; rs[tid >> 1] = rsqrtf(var + 1e-5f); }
        if (samp) {
#pragma unroll
            for (int i = 0; i < 8; ++i) {
                const int c = tid + 256 * i, row = c >> 4, sc = c & 15;
                if ((row >> 3) == sc) {
                    const unsigned lo = cvt_pk(w00, 0.f), hi = cvt_pk(0.f, w00);
                    const int e = row & 7;
                    const unsigned val = (e & 1) ? hi : lo;
                    if ((e >> 1) == 0) araw[i].x = val; else if ((e >> 1) == 1) araw[i].y = val; else if ((e >> 1) == 2) araw[i].z = val; else araw[i].w = val;
                }
            }
        }
#pragma unroll
        for (int i = 0; i < 8; ++i) {
            const int c = tid + 256 * i, row = c >> 4, sc = c & 15;
            *(u32x4*)(As + (sc >> 2) * 4096 + row * 32 + swz(row, sc & 3)) = araw[i];
        }
        __syncthreads();
        float mur[8], rsr[8];
#pragma unroll
        for (int e = 0; e < 8; ++e) { mur[e] = mu[(tid & 15) * 8 + e]; rsr[e] = rs[(tid & 15) * 8 + e]; }
        __syncthreads();
#pragma unroll
        for (int i = 0; i < 8; ++i) {
            const int c = tid + 256 * i, n = c >> 4, sc = c & 15;
            const int ch = g * 512 + slab * 128 + permcol(n);
            const u32x4 v = braw[i];
            float x[8];
            x[0] = bf_lo(v.x); x[1] = bf_hi(v.x); x[2] = bf_lo(v.y); x[3] = bf_hi(v.y);
            x[4] = bf_lo(v.z); x[5] = bf_hi(v.z); x[6] = bf_lo(v.w); x[7] = bf_hi(v.w);
#pragma unroll
            for (int e = 0; e < 8; ++e) x[e] = (x[e] - mur[e]) * rsr[e] * lg[i] + lb[i];
            if (samp) {
#pragma unroll
                for (int e = 0; e < 8; ++e) av_out[(size_t)(sc * 8 + e) * 2048 + ch] = x[e];
            }
            u32x4 o;
            o.x = cvt_pk(x[0], x[1]); o.y = cvt_pk(x[2], x[3]); o.z = cvt_pk(x[4], x[5]); o.w = cvt_pk(x[6], x[7]);
            *(u32x4*)(Bs + (sc >> 2) * 4096 + n * 32 + swz(n, sc & 3)) = o;
        }
        __syncthreads();
        f32x4 acc[4][4];
#pragma unroll
        for (int i = 0; i < 4; ++i)
#pragma unroll
            for (int jn = 0; jn < 4; ++jn) acc[i][jn] = (f32x4){0.f, 0.f, 0.f, 0.f};
        u32x4 pvv[4][2];
#pragma unroll
        for (int i = 0; i < 4; ++i)
#pragma unroll
            for (int g2 = 0; g2 < 2; ++g2)
                pvv[i][g2] = *(const u32x4*)(P + (size_t)(chunk * 128 + wr * 64 + i * 16 + fr) * 2048 + g * 512 + slab * 128 + wc * 64 + 32 * g2 + 8 * fq);
        mma_stage<true>(As, Bs, 4096, 4096, acc, wr, wc, lane);
        mma_stage<true>(As + 8192, Bs + 8192, 4096, 4096, acc, wr, wc, lane);
#pragma unroll
        for (int i = 0; i < 4; ++i) {
            const int t = wr * 64 + i * 16 + fr;
            const float bs = b_s[g * 128 + (samp ? 0 : t)];
            const size_t rowoff = (size_t)(chunk * 128 + t) * 2048 + g * 512 + slab * 128;
#pragma unroll
            for (int g2 = 0; g2 < 2; ++g2) {
                bf16_t* pp = P + rowoff + wc * 64 + 32 * g2 + 8 * fq;
                const u32x4 pv = pvv[i][g2];
                const f32x4 a = acc[i][2 * g2], b = acc[i][2 * g2 + 1];
                u32x4 w;
                w.x = cvt_pk(bf_lo(pv.x) * (a.x + bs), bf_hi(pv.x) * (a.y + bs));
                w.y = cvt_pk(bf_lo(pv.y) * (a.z + bs), bf_hi(pv.y) * (a.w + bs));
                w.z = cvt_pk(bf_lo(pv.z) * (b.x + bs), bf_hi(pv.z) * (b.y + bs));
                w.w = cvt_pk(bf_lo(pv.w) * (b.z + bs), bf_hi(pv.w) * (b.w + bs));
                *(u32x4*)pp = w;
            }
        }
    }
}

struct EpiY {
    bf16_t* Yb;
    float* Yp;
    __device__ __forceinline__ void operator()(f32x4 (&acc)[4][4], int m0, int n0, int wr, int wc, int lane) const {
        const int fr = lane & 15, fq = lane >> 4;
        const bool part = (m0 == M_P);
#pragma unroll
        for (int i = 0; i < 4; ++i) {
            const int m = m0 + wr * 64 + i * 16 + fr;
#pragma unroll
            for (int g2 = 0; g2 < 2; ++g2) {
                const int n = n0 + wc * 64 + 32 * g2 + 8 * fq;
                const f32x4 a = acc[i][2 * g2], b = acc[i][2 * g2 + 1];
                if (part) {
                    float* o = Yp + (size_t)(m - M_P) * 1024 + n;
                    *(f32x4*)o = a;
                    *(f32x4*)(o + 4) = b;
                } else {
                    u32x4 w;
                    w.x = cvt_pk(a.x, a.y); w.y = cvt_pk(a.z, a.w); w.z = cvt_pk(b.x, b.y); w.w = cvt_pk(b.z, b.w);
                    *(u32x4*)(Yb + (size_t)m * 1024 + n) = w;
                }
            }
        }
    }
};
__device__ __forceinline__ void out_gemm_phase(const bf16_t* A, int K, const bf16_t* Wt, float* Y, float* Ypart, bf16_t* smem) {
    const int nsplit = K >> 8;
    const int ntile = 1024 + 8 * nsplit;
    Stage st;
    bool pre = false;
    for (int t = blockIdx.x; t < ntile; t += gridDim.x) {
        const bool full = t < 1024;
        const int u = t - 1024, ks = full ? 0 : (u >> 3);
        const int m0 = full ? (t >> 3) * 128 : M_P, n0 = (full ? (t & 7) : (u & 7)) * 128, Kt = full ? K : 256;
        const int tn = t + gridDim.x;
        const bool hn = tn < ntile, fulln = tn < 1024;
        const int un = tn - 1024, ksn = fulln ? 0 : (un >> 3);
        const int m0n = fulln ? (tn >> 3) * 128 : M_P, n0n = (fulln ? (tn & 7) : (un & 7)) * 128;
        EpiY e{(bf16_t*)Y, Ypart + (size_t)ks * 128 * 1024};
        gemm_tile<true>(A + ks * 256, K, Wt + ks * 256, K, Kt, m0, n0, smem, e, st, pre, hn, A + ksn * 256, Wt + ksn * 256, m0n, n0n);
        pre = hn;
    }
}

struct EpiSilu {
    bf16_t* O;
    int ldo, col0;
    __device__ __forceinline__ void operator()(f32x4 (&acc)[4][4], int m0, int n0, int wr, int wc, int lane) const {
        const int fr = lane & 15, fq = lane >> 4;
#pragma unroll
        for (int i = 0; i < 4; ++i) {
            const int m = m0 + wr * 64 + i * 16 + fr;
#pragma unroll
            for (int jn = 0; jn < 4; ++jn) {
                const f32x4 a = acc[i][jn];
                u32x2 w;
                w.x = cvt_pk(silu_f(a.x), silu_f(a.y));
                w.y = cvt_pk(silu_f(a.z), silu_f(a.w));
                *(u32x2*)(O + (size_t)m * ldo + col0 + wc * 64 + jn * 16 + fq * 4) = w;
            }
        }
    }
};
struct EpiCopy {
    bf16_t* O;
    int ldo, col0;
    __device__ __forceinline__ void operator()(f32x4 (&acc)[4][4], int m0, int n0, int wr, int wc, int lane) const {
        const int fr = lane & 15, fq = lane >> 4;
#pragma unroll
        for (int i = 0; i < 4; ++i) {
            const int m = m0 + wr * 64 + i * 16 + fr;
#pragma unroll
            for (int jn = 0; jn < 4; ++jn) {
                const f32x4 a = acc[i][jn];
                u32x2 w;
                w.x = cvt_pk(a.x, a.y);
                w.y = cvt_pk(a.z, a.w);
                *(u32x2*)(O + (size_t)m * ldo + col0 + wc * 64 + jn * 16 + fq * 4) = w;
            }
        }
    }
};
template <int isk> struct EpiRope {
    bf16_t* O;
    int ldo, col0;
    const float* rope;
    float* out;
    __device__ __forceinline__ void operator()(f32x4 (&acc)[4][4], int m0, int n0, int wr, int wc, int lane) const {
        const int fr = lane & 15, fq = lane >> 4;
#pragma unroll
        for (int i = 0; i < 4; ++i) {
            const int m = m0 + wr * 64 + i * 16 + fr;
            const int pos = (m < M_P) ? (m & (SEQ - 1)) : SEQ;
            const float* rt = rope + (size_t)pos * 64;
            const float scale = isk ? 1.0f : 0.125f;
#pragma unroll
            for (int jn = 0; jn < 2; ++jn) {
                const int d = jn * 16 + fq * 4;
                const f32x4 c = *(const f32x4*)(rt + d), s = *(const f32x4*)(rt + 32 + d);
                const f32x4 x1 = acc[i][jn], x2 = acc[i][jn + 2];
                const f32x4 o1 = (x1 * c - x2 * s) * scale, o2 = (x2 * c + x1 * s) * scale;
                u32x2 w1, w2;
                w1.x = cvt_pk(o1.x, o1.y); w1.y = cvt_pk(o1.z, o1.w);
                w2.x = cvt_pk(o2.x, o2.y); w2.y = cvt_pk(o2.z, o2.w);
                bf16_t* dst = O + (size_t)m * ldo + col0 + wc * 64 + d;
                *(u32x2*)dst = w1;
                *(u32x2*)(dst + 32) = w2;
                if (isk) {
                    if (m < M_P) {
                        const int t = m & (SEQ - 1), b = m >> 13;
                        if (t >= SEQ - 128) {
                            float* o = out + O_BKP + ((size_t)(b * 128 + t - (SEQ - 128)) * 2 + wc) * 64 + d;
                            *(f32x4*)o = o1;
                            *(f32x4*)(o + 32) = o2;
                        }
                    } else {
                        float* o = out + O_BKS + ((size_t)((m - M_P) * 128 + 127) * 2 + wc) * 64 + d;
                        *(f32x4*)o = o1;
                        *(f32x4*)(o + 32) = o2;
                    }
                }
            }
        }
    }
};
struct EpiVt {
    bf16_t* Vt;
    float* out;
    __device__ __forceinline__ void operator()(f32x4 (&acc)[4][4], int m0, int n0, int wr, int wc, int lane) const {
        const int fr = lane & 15, fq = lane >> 4;
#pragma unroll
        for (int i = 0; i < 4; ++i) {
            const int m = m0 + wr * 64 + i * 16 + fq * 4;
#pragma unroll
            for (int jn = 0; jn < 4; ++jn) {
                const int d = jn * 16 + fr;
                const f32x4 a = acc[i][jn];
                if (m < M_P) {
                    const int t = m & (SEQ - 1), b = m >> 13;
                    u32x2 w;
                    w.x = cvt_pk(a.x, a.y);
                    w.y = cvt_pk(a.z, a.w);
                    *(u32x2*)(Vt + ((size_t)(b * 2 + wc) * 64 + d) * SEQ + t) = w;
                    if (t >= SEQ - 128) {
                        float* o = out + O_BVP + ((size_t)(b * 128 + t - (SEQ - 128)) * 2 + wc) * 64 + d;
                        o[0] = a.x; o[128] = a.y; o[256] = a.z; o[384] = a.w;
                    }
                } else {
                    float* o = out + O_BVS + ((size_t)((m - M_P) * 128 + 127) * 2 + wc) * 64 + d;
                    o[0] = a.x; o[16384] = a.y; o[32768] = a.z; o[49152] = a.w;
                }
            }
        }
    }
};

struct EpiB {
    bf16_t *Q, *SG, *KV;
    const float* rope;
    float* out;
    int nt;
    const float* rs;
    __device__ __forceinline__ void operator()(f32x4 (&acc)[4][4], int m0, int n0, int wr, int wc, int lane) const {
        const int fr = lane & 15, fq = lane >> 4;
#pragma unroll
        for (int i = 0; i < 4; ++i) {
            const float sc = rs[m0 + wr * 64 + i * 16 + fr];
#pragma unroll
            for (int jn = 0; jn < 4; ++jn) acc[i][jn] = acc[i][jn] * sc;
        }
        if (nt < 9) {
            const bool isk = (nt == 8);
            const float scale = isk ? 1.0f : 0.125f;
#pragma unroll
            for (int i = 0; i < 4; ++i) {
                const int m = m0 + wr * 64 + i * 16 + fr;
                const int pos = (m < M_P) ? (m & (SEQ - 1)) : SEQ;
                const float* rt = rope + (size_t)pos * 64;
                const int d = 8 * fq;
                f32x4 o1[2], o2[2];
#pragma unroll
                for (int jl = 0; jl < 2; ++jl) {
                    const f32x4 c = *(const f32x4*)(rt + d + 4 * jl), s = *(const f32x4*)(rt + 32 + d + 4 * jl);
                    const f32x4 x1 = acc[i][jl], x2 = acc[i][jl + 2];
                    o1[jl] = (x1 * c - x2 * s) * scale;
                    o2[jl] = (x2 * c + x1 * s) * scale;
                }
                u32x4 w1, w2;
                w1.x = cvt_pk(o1[0].x, o1[0].y); w1.y = cvt_pk(o1[0].z, o1[0].w); w1.z = cvt_pk(o1[1].x, o1[1].y); w1.w = cvt_pk(o1[1].z, o1[1].w);
                w2.x = cvt_pk(o2[0].x, o2[0].y); w2.y = cvt_pk(o2[0].z, o2[0].w); w2.z = cvt_pk(o2[1].x, o2[1].y); w2.w = cvt_pk(o2[1].z, o2[1].w);
                bf16_t* dst = isk ? KV + (size_t)m * 256 + wc * 64 + d : Q + (size_t)m * 1024 + nt * 128 + wc * 64 + d;
                *(u32x4*)dst = w1;
                *(u32x4*)(dst + 32) = w2;
                if (isk) {
                    float* o = nullptr;
                    if (m < M_P) {
                        const int t = m & (SEQ - 1), b = m >> 13;
                        if (t >= SEQ - 128) o = out + O_BKP + ((size_t)(b * 128 + t - (SEQ - 128)) * 2 + wc) * 64 + d;
                    } else o = out + O_BKS + ((size_t)((m - M_P) * 128 + 127) * 2 + wc) * 64 + d;
                    if (o) { *(f32x4*)o = o1[0]; *(f32x4*)(o + 4) = o1[1]; *(f32x4*)(o + 32) = o2[0]; *(f32x4*)(o + 36) = o2[1]; }
                }
            }
        } else if (nt == 9) {
#pragma unroll
            for (int i = 0; i < 4; ++i) {
                const int m = m0 + wr * 64 + i * 16 + fr;
                float* o = nullptr;
                if (m < M_P) {
                    const int t = m & (SEQ - 1), b = m >> 13;
                    if (t >= SEQ - 128) o = out + O_BVP + ((size_t)(b * 128 + t - (SEQ - 128)) * 2 + wc) * 64;
                } else o = out + O_BVS + ((size_t)((m - M_P) * 128 + 127) * 2 + wc) * 64;
#pragma unroll
                for (int g2 = 0; g2 < 2; ++g2) {
                    const int d = 32 * g2 + 8 * fq;
                    const f32x4 a = acc[i][2 * g2], b = acc[i][2 * g2 + 1];
                    u32x4 w;
                    w.x = cvt_pk(a.x, a.y); w.y = cvt_pk(a.z, a.w); w.z = cvt_pk(b.x, b.y); w.w = cvt_pk(b.z, b.w);
                    *(u32x4*)(KV + (size_t)m * 256 + 128 + wc * 64 + d) = w;
                    if (o) { *(f32x4*)(o + d) = a; *(f32x4*)(o + d + 4) = b; }
                }
            }
        } else {
#pragma unroll
            for (int i = 0; i < 4; ++i) {
                const int m = m0 + wr * 64 + i * 16 + fr;
#pragma unroll
                for (int g2 = 0; g2 < 2; ++g2) {
                    const f32x4 a = acc[i][2 * g2], b = acc[i][2 * g2 + 1];
                    u32x4 w;
                    w.x = cvt_pk(silu_f(a.x), silu_f(a.y)); w.y = cvt_pk(silu_f(a.z), silu_f(a.w));
                    w.z = cvt_pk(silu_f(b.x), silu_f(b.y)); w.w = cvt_pk(silu_f(b.z), silu_f(b.w));
                    *(u32x4*)(SG + (size_t)m * 1024 + (nt - 10) * 128 + wc * 64 + 32 * g2 + 8 * fq) = w;
                }
            }
        }
    }
};

__device__ __forceinline__ void b_in_phase(const Params& p, bf16_t* smem) {
    const bf16_t* H = (const bf16_t*)(p.ws + W_XB);
    const float* RS = (const float*)(p.ws + W_RS);
    const bf16_t* Wt = (const bf16_t*)(p.ws + W_B_IN);
    bf16_t* Q = (bf16_t*)(p.ws + W_BUF1);
    bf16_t* SG = Q + (size_t)MT * 1024;
    bf16_t* KV = (bf16_t*)(p.ws + W_KB);
    const float* rope = (const float*)(p.ws + W_ROPE);
    Stage st;
    bool pre = false;
    for (int t = blockIdx.x; t < 129 * 18; t += gridDim.x) {
        const int mt = t < 2064 ? (t >> 4) : ((t - 2064) >> 1), nt = t < 2064 ? (t & 15) : 16 + ((t - 2064) & 1);
        const int tn = t + gridDim.x;
        const bool hn = tn < 129 * 18;
        const int mtn = tn < 2064 ? (tn >> 4) : ((tn - 2064) >> 1), ntn = tn < 2064 ? (tn & 15) : 16 + ((tn - 2064) & 1);
        EpiB e{Q, SG, KV, rope, p.out, nt, RS};
        gemm_tile<true>(H, 1024, Wt, 1024, 1024, mt * 128, nt * 128, smem, e, st, pre, hn, H, Wt, mtn * 128, ntn * 128);
        pre = hn;
    }
}

constexpr int VT_LD = 256;
__device__ __forceinline__ void attn_prompt_item(const Params& p, int item, bf16_t* smem) {
    const int tid = threadIdx.x, w = tid >> 6, lane = tid & 63, fr = lane & 15, fq = lane >> 4;
    const int half = item & 1, kvh = (item >> 1) & 1, nb = (item >> 2) & 63, b = item >> 8;
    const bf16_t* Q = (const bf16_t*)(p.ws + W_BUF1);
    const bf16_t* SG = Q + (size_t)MT * 1024;
    const bf16_t* KV = (const bf16_t*)(p.ws + W_KB);
    bf16_t* Z = (bf16_t*)(p.ws + W_H);
    bf16_t* Ks = smem;
    bf16_t* Vs = smem + 16384;
    const int row0 = b * SEQ + nb * 128;
    u32x4 kraw[8], vraw[8];
#pragma unroll
    for (int i = 0; i < 8; ++i) {
        const int c = tid + 256 * i, key = c >> 3, kc = c & 7;
        kraw[i] = (u32x4){0u, 0u, 0u, 0u};
        vraw[i] = (u32x4){0u, 0u, 0u, 0u};
        if (nb > 0 || key >= 128) {
            const bf16_t* src_row = KV + (size_t)(row0 - 128 + key) * 256 + kvh * 64 + kc * 8;
            kraw[i] = *(const u32x4*)src_row;
            vraw[i] = *(const u32x4*)(src_row + 128);
        }
    }
    __syncthreads();
#pragma unroll
    for (int i = 0; i < 8; ++i) {
        const int c = tid + 256 * i, key = c >> 3, kc = c & 7;
        *(u32x4*)(Ks + (kc >> 2) * 8192 + key * 32 + swz(key, kc & 3)) = kraw[i];
    }
#pragma unroll
    for (int i = 0; i < 8; ++i) {
        const int c = tid + 256 * i, key = c >> 3, dc = c & 7;
        const unsigned wv[4] = {vraw[i].x, vraw[i].y, vraw[i].z, vraw[i].w};
#pragma unroll
        for (int e = 0; e < 8; ++e) {
            const int d = dc * 8 + e;
            const unsigned short hv = (e & 1) ? (unsigned short)(wv[e >> 1] >> 16) : (unsigned short)(wv[e >> 1] & 0xffff);
            Vs[d * VT_LD + (((key >> 3) ^ ((d & 15) << 1)) << 3) + (key & 7)] = hv;
        }
    }
    __syncthreads();
    const int co = swz(fr, fq);
    bf16x8 qf[2];
    {
        const int gq = half * 8, h = kvh * 8 + (gq >> 1), qi = 32 * w + 16 * (gq & 1) + fr;
#pragma unroll
        for (int kk = 0; kk < 2; ++kk) qf[kk] = *(const bf16x8*)(Q + (size_t)(row0 + qi) * 1024 + h * 64 + kk * 32 + fq * 8);
    }
#pragma unroll 1
    for (int gq = half * 8; gq < half * 8 + 8; ++gq) {
        const int g = gq >> 1, qt = gq & 1;
        const int h = kvh * 8 + g;
        const float sink = p.in[15][h];
        const int qi = 32 * w + 16 * qt + fr;
        f32x4 s[10];
#pragma unroll
        for (int kt = 0; kt < 10; ++kt) s[kt] = (f32x4){0.f, 0.f, 0.f, 0.f};
#pragma unroll
        for (int kt = 0; kt < 10; ++kt) {
#pragma unroll
            for (int kk = 0; kk < 2; ++kk) {
                const bf16x8 kf = *(const bf16x8*)(Ks + kk * 8192 + (16 * (2 * w + kt) + fr) * 32 + co);
                s[kt] = __builtin_amdgcn_mfma_f32_16x16x32_bf16(kf, qf[kk], s[kt], 0, 0, 0);
            }
            if (kt & 1) __builtin_amdgcn_sched_barrier(0);
        }
        {
            const int gn = (gq + 1 < half * 8 + 8) ? gq + 1 : gq, hn = kvh * 8 + (gn >> 1), qn = 32 * w + 16 * (gn & 1) + fr;
#pragma unroll
            for (int kk = 0; kk < 2; ++kk) qf[kk] = *(const bf16x8*)(Q + (size_t)(row0 + qn) * 1024 + hn * 64 + kk * 32 + fq * 8);
        }
        float mx = sink;
#pragma unroll
        for (int kt = 0; kt < 10; ++kt) {
            const int key0 = 16 * (2 * w + kt) + fq * 4;
#pragma unroll
            for (int r = 0; r < 4; ++r) {
                const int key = key0 + r;
                const bool valid = (key >= qi) && (key <= qi + 128) && (nb > 0 || key >= 128);
                const float v = valid ? s[kt][r] : -1e30f;
                s[kt][r] = v;
                mx = fmaxf(mx, v);
            }
        }
        mx = fmaxf(mx, __shfl_xor(mx, 16));
        mx = fmaxf(mx, __shfl_xor(mx, 32));
        float sum = 0.f;
#pragma unroll
        for (int kt = 0; kt < 10; ++kt)
#pragma unroll
            for (int r = 0; r < 4; ++r) {
                const float e = __expf(s[kt][r] - mx);
                s[kt][r] = e;
                sum += e;
            }
        sum += __shfl_xor(sum, 16);
        sum += __shfl_xor(sum, 32);
        const float inv = __builtin_amdgcn_rcpf(sum + __expf(sink - mx));
        u32x2 sgv[4];
#pragma unroll
        for (int dt = 0; dt < 4; ++dt) sgv[dt] = *(const u32x2*)(SG + (size_t)(row0 + qi) * 1024 + h * 64 + 16 * dt + fq * 4);
        f32x4 o[4];
#pragma unroll
        for (int dt = 0; dt < 4; ++dt) o[dt] = (f32x4){0.f, 0.f, 0.f, 0.f};
#pragma unroll
        for (int ks = 0; ks < 5; ++ks) {
            u32x4 pw;
            pw.x = cvt_pk(s[2 * ks][0], s[2 * ks][1]);
            pw.y = cvt_pk(s[2 * ks][2], s[2 * ks][3]);
            pw.z = cvt_pk(s[2 * ks + 1][0], s[2 * ks + 1][1]);
            pw.w = cvt_pk(s[2 * ks + 1][2], s[2 * ks + 1][3]);
            const bf16x8 pf = __builtin_bit_cast(bf16x8, pw);
            const int kc0 = (((2 * w + 2 * ks) ^ fr) << 4) + fq * 4, kc1 = (((2 * w + 2 * ks + 1) ^ fr) << 4) + fq * 4;
#pragma unroll
            for (int dt = 0; dt < 4; ++dt) {
                const bf16_t* vp = Vs + (16 * dt + fr) * VT_LD;
                u32x4 vw;
                const u32x2 v0 = *(const u32x2*)(vp + kc0), v1 = *(const u32x2*)(vp + kc1);
                vw.x = v0.x; vw.y = v0.y; vw.z = v1.x; vw.w = v1.y;
                const bf16x8 vf = __builtin_bit_cast(bf16x8, vw);
                o[dt] = __builtin_amdgcn_mfma_f32_16x16x32_bf16(vf, pf, o[dt], 0, 0, 0);
            }
            __builtin_amdgcn_sched_barrier(0);
        }
        const size_t ro = (size_t)(row0 + qi) * 1024 + h * 64;
#pragma unroll
        for (int dt = 0; dt < 4; ++dt) {
            const int d = 16 * dt + fq * 4;
            const u32x2 sg = sgv[dt];
            const f32x4 ov = o[dt] * inv;
            u32x2 wv;
            wv.x = cvt_pk(ov.x * bf_lo(sg.x), ov.y * bf_hi(sg.x));
            wv.y = cvt_pk(ov.z * bf_lo(sg.y), ov.w * bf_hi(sg.y));
            *(u32x2*)(Z + ro + d) = wv;
        }
    }
}

__device__ __forceinline__ void attn_sample_item(const Params& p, int item, unsigned char* smem_raw) {
    const int tid = threadIdx.x, g = tid >> 5, l = tid & 31;
    const int kvh = item & 1, b = item >> 1;
    const bf16_t* Q = (const bf16_t*)(p.ws + W_BUF1);
    const bf16_t* SG = Q + (size_t)MT * 1024;
    bf16_t* Z = (bf16_t*)(p.ws + W_H);
    float* kv = (float*)smem_raw;
    float* qs = kv + 129 * 65;
    float* ps = qs + 512;
    const float* ck = p.in[2];
    const float* cv = p.in[3];
    float* oks = p.out + O_BKS;
    float* ovs = p.out + O_BVS;
    const int row = M_P + b;
    f32x4 knew = {0.f, 0.f, 0.f, 0.f}, vnew = {0.f, 0.f, 0.f, 0.f};
    if (tid < 16) knew = *(const f32x4*)(oks + ((size_t)(b * 128 + 127) * 2 + kvh) * 64 + tid * 4);
    const float q0 = bf2f(Q[(size_t)row * 1024 + kvh * 512 + tid]), q1 = bf2f(Q[(size_t)row * 1024 + kvh * 512 + 256 + tid]);
    __syncthreads();
    f32x4 kreg[8];
#pragma unroll
    for (int i = 0; i < 8; ++i) {
        const int c = tid + 256 * i, key = c >> 4, d4 = (c & 15) * 4;
        kreg[i] = *(const f32x4*)(ck + ((size_t)(b * 128 + key) * 2 + kvh) * 64 + d4);
    }
#pragma unroll
    for (int i = 0; i < 8; ++i) {
        const int c = tid + 256 * i, key = c >> 4, d4 = (c & 15) * 4;
        if (key >= 1) *(f32x4*)(oks + ((size_t)(b * 128 + key - 1) * 2 + kvh) * 64 + d4) = kreg[i];
        float* kp = kv + key * 65 + d4;
        kp[0] = kreg[i].x; kp[1] = kreg[i].y; kp[2] = kreg[i].z; kp[3] = kreg[i].w;
    }
    if (tid < 16) { float* kp = kv + 128 * 65 + tid * 4; kp[0] = knew.x; kp[1] = knew.y; kp[2] = knew.z; kp[3] = knew.w; }
    qs[tid] = q0;
    qs[256 + tid] = q1;
    if (tid < 16) vnew = *(const f32x4*)(ovs + ((size_t)(b * 128 + 127) * 2 + kvh) * 64 + tid * 4);
    f32x4 vreg[8];
#pragma unroll
    for (int i = 0; i < 8; ++i) {
        const int c = tid + 256 * i, key = c >> 4, d4 = (c & 15) * 4;
        vreg[i] = *(const f32x4*)(cv + ((size_t)(b * 128 + key) * 2 + kvh) * 64 + d4);
    }
    __syncthreads();
    const int h = kvh * 8 + g;
    const float sink = p.in[15][h];
    float sc[5] = {0.f, 0.f, 0.f, 0.f, 0.f};
    float mx = sink;
#pragma unroll 2
    for (int d0 = 0; d0 < 64; d0 += 8) {
        float qv[8];
#pragma unroll
        for (int e = 0; e < 8; ++e) qv[e] = qs[g * 64 + d0 + e];
#pragma unroll
        for (int i = 0; i < 5; ++i) {
            const float* kp = kv + (l + 32 * i) * 65 + d0;
#pragma unroll
            for (int e = 0; e < 8; ++e) sc[i] += qv[e] * kp[e];
        }
    }
#pragma unroll
    for (int i = 0; i < 5; ++i) {
        if (l + 32 * i >= 129) sc[i] = -1e30f;
        mx = fmaxf(mx, sc[i]);
    }
#pragma unroll
    for (int o = 1; o < 32; o <<= 1) mx = fmaxf(mx, __shfl_xor(mx, o));
    float sum = 0.f;
#pragma unroll
    for (int i = 0; i < 5; ++i) {
        const int key = l + 32 * i;
        const float e = (key < 129) ? __expf(sc[i] - mx) : 0.f;
        sc[i] = e;
        sum += e;
    }
#pragma unroll
    for (int o = 1; o < 32; o <<= 1) sum += __shfl_xor(sum, o);
    const float inv = __builtin_amdgcn_rcpf(sum + __expf(sink - mx));
#pragma unroll
    for (int i = 0; i < 5; ++i) {
        const int key = l + 32 * i;
        if (key < 129) ps[g * 132 + key] = sc[i] * inv;
    }
    __syncthreads();
#pragma unroll
    for (int i = 0; i < 8; ++i) {
        const int c = tid + 256 * i, key = c >> 4, d4 = (c & 15) * 4;
        if (key >= 1) *(f32x4*)(ovs + ((size_t)(b * 128 + key - 1) * 2 + kvh) * 64 + d4) = vreg[i];
        float* kp = kv + key * 65 + d4;
        kp[0] = vreg[i].x; kp[1] = vreg[i].y; kp[2] = vreg[i].z; kp[3] = vreg[i].w;
    }
    if (tid < 16) { float* kp = kv + 128 * 65 + tid * 4; kp[0] = vnew.x; kp[1] = vnew.y; kp[2] = vnew.z; kp[3] = vnew.w; }
    __syncthreads();
    float o0 = 0.f, o1 = 0.f;
#pragma unroll 8
    for (int key = 0; key < 129; ++key) {
        const float pv = ps[g * 132 + key];
        o0 += pv * kv[key * 65 + l];
        o1 += pv * kv[key * 65 + l + 32];
    }
    const size_t ro = (size_t)row * 1024 + h * 64;
    Z[ro + l] = (bf16_t)(cvt_pk(o0 * bf2f(SG[ro + l]), 0.f) & 0xffff);
    Z[ro + l + 32] = (bf16_t)(cvt_pk(o1 * bf2f(SG[ro + l + 32]), 0.f) & 0xffff);
}

__device__ __forceinline__ void b_attn_phase(const Params& p, unsigned char* smem_raw) {
    for (int it = blockIdx.x; it < 512; it += gridDim.x) attn_prompt_item(p, it, (bf16_t*)smem_raw);
    for (int it = blockIdx.x; it < 256; it += gridDim.x) attn_sample_item(p, it, smem_raw);
}

struct EpiAct {
    bf16_t* XR;
    int ldo, col0, act;
    const float* rs;
    __device__ __forceinline__ void operator()(f32x4 (&acc)[4][4], int m0, int n0, int wr, int wc, int lane) const {
        const int fr = lane & 15, fq = lane >> 4;
        bf16_t* O = act ? XR + (size_t)MT * 1024 - 1024 : XR;
#pragma unroll
        for (int i = 0; i < 4; ++i) {
            const int m = m0 + wr * 64 + i * 16 + fr;
            const float sc = rs[m];
#pragma unroll
            for (int g2 = 0; g2 < 2; ++g2) {
                f32x4 a = acc[i][2 * g2] * sc, b = acc[i][2 * g2 + 1] * sc;
                if (act) {
                    a.x = silu_f(a.x); a.y = silu_f(a.y); a.z = silu_f(a.z); a.w = silu_f(a.w);
                    b.x = silu_f(b.x); b.y = silu_f(b.y); b.z = silu_f(b.z); b.w = silu_f(b.w);
                }
                u32x4 w;
                w.x = cvt_pk(a.x, a.y); w.y = cvt_pk(a.z, a.w); w.z = cvt_pk(b.x, b.y); w.w = cvt_pk(b.z, b.w);
                *(u32x4*)(O + (size_t)m * ldo + col0 + wc * 64 + 32 * g2 + 8 * fq) = w;
            }
        }
    }
};
__device__ __forceinline__ void c_in_phase(const Params& p, bf16_t* smem) {
    const bf16_t* H = (const bf16_t*)(p.ws + W_XB);
    const float* RS = (const float*)(p.ws + W_RS);
    const bf16_t* Wt = (const bf16_t*)(p.ws + W_C_IN);
    bf16_t* XR = (bf16_t*)(p.ws + W_BUF1);
    bf16_t* SG = XR + (size_t)MT * 1024;
    Stage st;
    bool pre = false;
    for (int t = blockIdx.x; t < 129 * 16; t += gridDim.x) {
        const int mt = t >> 4, nt = t & 15;
        const int tn = t + gridDim.x;
        const bool hn = tn < 129 * 16;
        EpiAct e{XR, 1024, nt * 128, nt >= 8, RS};
        gemm_tile<true>(H, 1024, Wt, 1024, 1024, mt * 128, nt * 128, smem, e, st, pre, hn, H, Wt, (tn >> 4) * 128, (tn & 15) * 128);
        pre = hn;
    }
}

__device__ __forceinline__ void unpack8(const u32x4 v, float (&x)[8]) {
    x[0] = bf_lo(v.x); x[1] = bf_hi(v.x); x[2] = bf_lo(v.y); x[3] = bf_hi(v.y);
    x[4] = bf_lo(v.z); x[5] = bf_hi(v.z); x[6] = bf_lo(v.w); x[7] = bf_hi(v.w);
}

__device__ __forceinline__ void c_conv_phase(const Params& p) {
    const bf16_t* XR = (const bf16_t*)(p.ws + W_BUF1);
    bf16_t* XC = (bf16_t*)(p.ws + W_H);
    const float* cw = p.in[18];
    const float* cb = p.in[19];
    const float* st = p.in[4];
    const int gt = blockIdx.x * NTHREADS + threadIdx.x, gn = gridDim.x * NTHREADS;
    const int c0 = (gt & 127) * 8;
    float w0[8], w1[8], w2[8], w3[8], bias[8];
#pragma unroll
    for (int e = 0; e < 8; ++e) {
        w0[e] = cw[c0 + e]; w1[e] = cw[1024 + c0 + e]; w2[e] = cw[2048 + c0 + e]; w3[e] = cw[3072 + c0 + e]; bias[e] = cb[c0 + e];
    }
    for (int run = gt >> 7; run < M_P / 8; run += gn >> 7) {
        const int r0 = run * 8, t0 = r0 & (SEQ - 1), b = r0 >> 13;
        u32x4 raw[11];
#pragma unroll
        for (int q = 0; q < 11; ++q) {
            raw[q] = (u32x4){0u, 0u, 0u, 0u};
            if (q >= 3 || t0 > 0) raw[q] = *(const u32x4*)(XR + (size_t)(r0 - 3 + q) * 1024 + c0);
        }
        float x0[8], x1[8], x2[8], x3[8];
        unpack8(raw[0], x0); unpack8(raw[1], x1); unpack8(raw[2], x2);
#pragma unroll
        for (int q = 0; q < 8; ++q) {
            unpack8(raw[q + 3], x3);
            float acc[8];
#pragma unroll
            for (int e = 0; e < 8; ++e) acc[e] = bias[e] + x0[e] * w0[e] + x1[e] * w1[e] + x2[e] * w2[e] + x3[e] * w3[e];
            u32x4 o;
            o.x = cvt_pk(acc[0], acc[1]); o.y = cvt_pk(acc[2], acc[3]); o.z = cvt_pk(acc[4], acc[5]); o.w = cvt_pk(acc[6], acc[7]);
            *(u32x4*)(XC + (size_t)(r0 + q) * 1024 + c0) = o;
            const int t = t0 + q;
            if (t >= SEQ - 3) {
                float* oo = p.out + O_CCP + ((size_t)b * 3 + (t - (SEQ - 3))) * 1024 + c0;
#pragma unroll
                for (int e = 0; e < 8; ++e) oo[e] = x3[e];
            }
#pragma unroll
            for (int e = 0; e < 8; ++e) { x0[e] = x1[e]; x1[e] = x2[e]; x2[e] = x3[e]; }
        }
    }
    for (int b = gt >> 7; b < M_S; b += gn >> 7) {
        const int row = M_P + b;
        float xv[8], acc[8];
        unpack8(*(const u32x4*)(XR + (size_t)row * 1024 + c0), xv);
#pragma unroll
        for (int e = 0; e < 8; ++e) {
            const float s0 = st[((size_t)b * 3 + 0) * 1024 + c0 + e], s1 = st[((size_t)b * 3 + 1) * 1024 + c0 + e], s2 = st[((size_t)b * 3 + 2) * 1024 + c0 + e];
            acc[e] = bias[e] + s0 * w0[e] + s1 * w1[e] + s2 * w2[e] + xv[e] * w3[e];
            p.out[O_CCS + ((size_t)b * 3 + 0) * 1024 + c0 + e] = s1;
            p.out[O_CCS + ((size_t)b * 3 + 1) * 1024 + c0 + e] = s2;
            p.out[O_CCS + ((size_t)b * 3 + 2) * 1024 + c0 + e] = xv[e];
        }
        u32x4 o;
        o.x = cvt_pk(acc[0], acc[1]); o.y = cvt_pk(acc[2], acc[3]); o.z = cvt_pk(acc[4], acc[5]); o.w = cvt_pk(acc[6], acc[7]);
        *(u32x4*)(XC + (size_t)row * 1024 + c0) = o;
    }
}

struct EpiGate {
    const bf16_t* XC;
    float* Aa;
    bf16_t* Bb;
    const float *b_a, *b_x, *lam;
    int blk, nt;
    float* lds;
    float* carry;
    __device__ __forceinline__ void operator()(f32x4 (&acc)[4][4], int m0, int n0, int wr, int wc, int lane) const {
        const int fr = lane & 15, fq = lane >> 4;
        const bool prompt = (m0 < M_P);
#pragma unroll
        for (int jn = 0; jn < 2; ++jn) {
            const int cl = 32 * wc + 8 * fq + 4 * jn;
            const int d = blk * 256 + 64 * nt + cl;
            const f32x4 ba = *(const f32x4*)(b_a + d), bx = *(const f32x4*)(b_x + d), sp = *(const f32x4*)(lam + d);
#pragma unroll
            for (int i = 0; i < 4; ++i) {
                const int rl = wr * 64 + i * 16 + fr, m = m0 + rl;
                const bool first = (m < M_P) && ((m & (SEQ - 1)) == 0);
                const u32x2 xw = *(const u32x2*)(XC + (size_t)m * 1024 + d);
                const f32x4 xc = {bf_lo(xw.x), bf_hi(xw.x), bf_lo(xw.y), bf_hi(xw.y)};
                const f32x4 ra = acc[i][jn] + ba, ia = acc[i][jn + 2] + bx;
                f32x4 av, bv;
#pragma unroll
                for (int r = 0; r < 4; ++r) {
                    const float rg = sigmoid_f(ra[r]), ig = sigmoid_f(ia[r]);
                    const float la = -8.0f * rg * sp[r];
                    const float a = __expf(la);
                    av[r] = a;
                    const float mult = first ? 1.0f : __builtin_amdgcn_sqrtf(fmaxf(1.0f - a * a, 0.f));
                    bv[r] = mult * (ig * xc[r]);
                }
                u32x2 ow;
                ow.x = cvt_pk(1.0f - av.x, 1.0f - av.y);
                ow.y = cvt_pk(1.0f - av.z, 1.0f - av.w);
                *(u32x2*)((bf16_t*)Aa + (size_t)m * 1024 + d) = ow;
                av = (f32x4){1.0f - bf_lo(ow.x), 1.0f - bf_hi(ow.x), 1.0f - bf_lo(ow.y), 1.0f - bf_hi(ow.y)};
                u32x2 w;
                w.x = cvt_pk(bv.x, bv.y);
                w.y = cvt_pk(bv.z, bv.w);
                *(u32x2*)(Bb + (size_t)m * 1024 + d) = w;
                if (prompt) {
                    *(f32x4*)(lds + rl * 64 + cl) = av;
                    *(f32x4*)(lds + 8192 + rl * 64 + cl) = (f32x4){bf_lo(w.x), bf_hi(w.x), bf_lo(w.y), bf_hi(w.y)};
                }
            }
        }
        __syncthreads();
        if (prompt && threadIdx.x < 64) {
            float A = 1.f, h = 0.f;
#pragma unroll 16
            for (int r = 0; r < 128; ++r) {
                const float a = lds[r * 64 + threadIdx.x], b = lds[8192 + r * 64 + threadIdx.x];
                A *= a;
                h = a * h + b;
            }
            const int chunk = m0 >> 7, d = blk * 256 + 64 * nt + threadIdx.x;
            carry[(size_t)chunk * 2048 + d] = A;
            carry[(size_t)chunk * 2048 + 1024 + d] = h;
        }
    }
};

__device__ __forceinline__ void c_gate_phase(const Params& p, bf16_t* smem) {
    const bf16_t* XC = (const bf16_t*)(p.ws + W_H);
    const bf16_t* Wg = (const bf16_t*)(p.ws + W_C_G);
    float* Aa = (float*)(p.ws + W_BUF2);
    bf16_t* Bb = (bf16_t*)(p.ws + W_BUF1);
    Stage st;
    bool pre = false;
    for (int t = blockIdx.x; t < 129 * 16; t += gridDim.x) {
        const int mt = t >> 4, blk = (t >> 2) & 3, nt = t & 3;
        const int tn = t + gridDim.x, blkn = (tn >> 2) & 3;
        const bool hn = tn < 129 * 16;
        EpiGate e{XC, Aa, Bb, p.in[21], p.in[23], (const float*)(p.ws + W_SP), blk, nt, (float*)smem, (float*)(p.ws + W_CARRY)};
        gemm_tile<true>(XC + blk * 256, 1024, Wg + (size_t)blk * 512 * 256, 256, 256, mt * 128, nt * 128, smem, e, st, pre, hn,
                        XC + blkn * 256, Wg + (size_t)blkn * 512 * 256, (tn >> 4) * 128, (tn & 3) * 128);
        pre = hn;
    }
}

__device__ __forceinline__ void c_scan1_phase(const Params& p) {
    const float* Aa = (const float*)(p.ws + W_BUF2);
    const bf16_t* Bb = (const bf16_t*)(p.ws + W_BUF1);
    float* carry = (float*)(p.ws + W_CARRY);
    for (int it = blockIdx.x; it < 512; it += gridDim.x) {
        const int chunk = it >> 2, d = (it & 3) * 256 + threadIdx.x;
        float A = 1.f, h = 0.f;
        const size_t base = (size_t)chunk * 128 * 1024 + d;
#pragma unroll 8
        for (int r = 0; r < 128; ++r) {
            const float a = 1.0f - bf2f(((const bf16_t*)Aa)[base + (size_t)r * 1024]), b = bf2f(Bb[base + (size_t)r * 1024]);
            A *= a;
            h = a * h + b;
        }
        carry[(size_t)chunk * 2048 + d] = A;
        carry[(size_t)chunk * 2048 + 1024 + d] = h;
    }
}

__device__ __forceinline__ void c_scan2_phase(const Params& p) {
    const float* Aa = (const float*)(p.ws + W_BUF2);
    const bf16_t* Bb = (const bf16_t*)(p.ws + W_BUF1);
    const bf16_t* SG = Bb + (size_t)MT * 1024;
    const float* carry = (const float*)(p.ws + W_CARRY);
    bf16_t* Z = (bf16_t*)(p.ws + W_H);
    for (int it = blockIdx.x; it < 512 + 512; it += gridDim.x) {
        if (it < 512) {
            const int chunk = it >> 2, d = (it & 3) * 256 + threadIdx.x;
            const int b = chunk >> 6, ci = chunk & 63;
            float h = 0.f;
            {
                const float* c0 = carry + (size_t)(b * 64) * 2048 + d;
                int jc = 0;
                for (; jc + 16 <= ci; jc += 16) {
                    float ca[16], ch[16];
#pragma unroll
                    for (int q = 0; q < 16; ++q) { ca[q] = c0[(size_t)(jc + q) * 2048]; ch[q] = c0[(size_t)(jc + q) * 2048 + 1024]; }
#pragma unroll
                    for (int q = 0; q < 16; ++q) h = ca[q] * h + ch[q];
                }
                for (; jc < ci; ++jc) h = c0[(size_t)jc * 2048] * h + c0[(size_t)jc * 2048 + 1024];
            }
            const size_t base = (size_t)chunk * 128 * 1024 + d;
for (int r0 = 0; r0 < 128; r0 += 32) {
                float av[32];
                bf16_t bv[32], sv[32];
#pragma unroll
                for (int q = 0; q < 32; ++q) {
                    const size_t o = base + (size_t)(r0 + q) * 1024;
                    av[q] = 1.0f - bf2f(((const bf16_t*)Aa)[o]); bv[q] = Bb[o]; sv[q] = SG[o];
                }
#pragma unroll
                for (int q = 0; q < 32; ++q) {
                    h = av[q] * h + bf2f(bv[q]);
                    Z[base + (size_t)(r0 + q) * 1024] = (bf16_t)(cvt_pk(h * bf2f(sv[q]), 0.f) & 0xffff);
                }
            }
            if (ci == 63) p.out[O_CHP + (size_t)b * 1024 + d] = h;
        } else {
            const int s = it - 512, d = (s & 3) * 256 + threadIdx.x, b = s >> 2;
            const size_t o = (size_t)(M_P + b) * 1024 + d;
            const float h = (1.0f - bf2f(((const bf16_t*)Aa)[o])) * p.in[5][(size_t)b * 1024 + d] + bf2f(Bb[o]);
            Z[o] = (bf16_t)(cvt_pk(h * bf2f(SG[o]), 0.f) & 0xffff);
            p.out[O_CHS + (size_t)b * 1024 + d] = h;
        }
    }
}

constexpr int N_PHASES = 20;

__device__ __forceinline__ void run_phase(const Params& p, int ph, unsigned char* smem_raw) {
    bf16_t* smem = (bf16_t*)smem_raw;
    float* Y = (float*)(p.ws + W_BUF2);
    float* YP = (float*)(p.ws + W_YPART);
    float* X = p.out + O_X;
    bf16_t* XB = (bf16_t*)(p.ws + W_XB);
    bf16_t* RSB = (bf16_t*)(p.ws + W_RS);
    bf16_t* H = (bf16_t*)(p.ws + W_H);
    switch (ph) {
        case 0: prep_phase(p, smem_raw); break;
        case 1: a_in_phase(p, 0, smem); break;
        case 2: a_mix_phase(p, 0, smem); break;
        case 3: out_gemm_phase((const bf16_t*)(p.ws + W_BUF1), 2048, (const bf16_t*)(p.ws + W_A_OUT), Y, YP, smem); break;
        case 4: norm_phase(Y, YP, 8, p.in[0], p.in[1], XB, true, nullptr, p.in[7] + 0 * 1024, p.in[6] + 1 * 1024, RSB); break;
        case 5: b_in_phase(p, smem); break;
        case 6: b_attn_phase(p, smem_raw); break;
        case 7: out_gemm_phase(H, 1024, (const bf16_t*)(p.ws + W_B_OUT), Y, YP, smem); break;
        case 8: norm_phase(Y, YP, 4, nullptr, nullptr, XB, true, nullptr, p.in[7] + 1 * 1024, p.in[6] + 2 * 1024, RSB); break;
        case 9: c_in_phase(p, smem); break;
        case 10: c_conv_phase(p); break;
        case 11: c_gate_phase(p, smem); break;
        case 12: c_scan1_phase(p); break;
        case 13: c_scan2_phase(p); break;
        case 14: out_gemm_phase(H, 1024, (const bf16_t*)(p.ws + W_C_OUT), Y, YP, smem); break;
        case 15: norm_phase(Y, YP, 4, nullptr, nullptr, XB, true, nullptr, p.in[7] + 2 * 1024, p.in[6] + 3 * 1024, RSB); break;
        case 16: a_in_phase(p, 1, smem); break;
        case 17: a_mix_phase(p, 1, smem); break;
        case 18: out_gemm_phase((const bf16_t*)(p.ws + W_BUF1), 2048, (const bf16_t*)(p.ws + W_A_OUT) + (size_t)1024 * 2048, Y, YP, smem); break;
        case 19: norm_phase(Y, YP, 8, nullptr, nullptr, XB, false, X, p.in[7] + 3 * 1024, nullptr, H); break;
        default: break;
    }
}


#define XB_TMO      128
#define XB_XCNT(j)  (256  + 64 * (j))
#define XB_XSUB(j)  (1280 + 64 * (j))
#define XB_XGEN(j)  (2304 + 64 * (j))
#define XB_TOP      3328
#define XB_TOPGEN   3392
#define XCD_BAR_WORDS 3456
#define XB_SPIN_CAP (1u << 20)
__device__ __forceinline__ unsigned xb_ld(unsigned* p) { return __hip_atomic_load(p, __ATOMIC_RELAXED, __HIP_MEMORY_SCOPE_AGENT); }
__device__ __forceinline__ unsigned xb_add(unsigned* p, unsigned v) { return __hip_atomic_fetch_add(p, v, __ATOMIC_RELAXED, __HIP_MEMORY_SCOPE_AGENT); }
__device__ __forceinline__ unsigned xb_xcc_id() { return (unsigned)__builtin_amdgcn_s_getreg((3 << 11) | 20) & 0xFu; }
#define XB_SPIN(cond, bar) do { unsigned _sp = 0; while (cond) { __builtin_amdgcn_s_sleep(1); \
    if ((++_sp & 255u) == 0u) { if (xb_ld(&(bar)[XB_TMO])) break; if (_sp > XB_SPIN_CAP) { atomicAdd(&(bar)[XB_TMO], 1u); break; } } } } while (0)
struct XcdBarrier { unsigned* bar; unsigned x, nloc, nx; };
__device__ __forceinline__ void xcd_barrier_complete(unsigned* bar, unsigned x, unsigned& nloc, unsigned& nx) {
    const unsigned G = gridDim.x;
    unsigned sum, cnt, mine, sp = 0u;
    for (;;) {
        sum = 0u; cnt = 0u; mine = 0u;
#pragma unroll
        for (unsigned j = 0; j < 16; ++j) { const unsigned c = xb_ld(&bar[XB_XCNT(j)]); sum += c; cnt += (c > 0u) ? 1u : 0u; mine = (j == x) ? c : mine; }
        if (sum == G) break;
        __builtin_amdgcn_s_sleep(1);
        if ((++sp & 255u) == 0u) { if (xb_ld(&bar[XB_TMO])) break; if (sp > XB_SPIN_CAP) { atomicAdd(&bar[XB_TMO], 1u); break; } }
    }
    nloc = mine > 0u ? mine : 1u; nx = cnt > 0u ? cnt : 1u;
}
__device__ __forceinline__ void xcd_barrier(XcdBarrier& b) {
    asm volatile("s_waitcnt vmcnt(0)" ::: "memory");
    __syncthreads();
    if (threadIdx.x == 0) {
        unsigned* bar = b.bar;
        __builtin_amdgcn_s_waitcnt(0);
        if (b.nloc == 0u) xcd_barrier_complete(bar, b.x, b.nloc, b.nx);
        const unsigned nloc = b.nloc, nx = b.nx;
        const unsigned old = xb_add(&bar[XB_XSUB(b.x)], 1u);
        const unsigned gen = old / nloc;
        if (old + 1u == (gen + 1u) * nloc) {
            __builtin_amdgcn_fence(__ATOMIC_RELEASE, "agent");
            asm volatile("s_waitcnt vmcnt(0)" ::: "memory");
            const unsigned og = xb_add(&bar[XB_TOP], 1u);
            const unsigned tg = og / nx;
            if (og + 1u == (tg + 1u) * nx) xb_add(&bar[XB_TOPGEN], 1u);
            else XB_SPIN(xb_ld(&bar[XB_TOPGEN]) == tg, bar);
            __builtin_amdgcn_fence(__ATOMIC_ACQUIRE, "agent");
            xb_add(&bar[XB_XGEN(b.x)], 1u);
            asm volatile("s_waitcnt vmcnt(0)" ::: "memory");
        } else {
            XB_SPIN(xb_ld(&bar[XB_XGEN(b.x)]) == gen, bar);
            __builtin_amdgcn_fence(__ATOMIC_ACQUIRE, "agent");
            asm volatile("s_waitcnt vmcnt(0)" ::: "memory");
        }
    }
    __syncthreads();
}

#ifndef PROBE_K
#define PROBE_K 20
#endif
__device__ __forceinline__ void dump_phase(const Params& p) {
    const unsigned* base = (const unsigned*)(p.ws);
    const size_t nwords = W_END / 4, n = (size_t)MT * D;
    const size_t gt = (size_t)blockIdx.x * NTHREADS + threadIdx.x, gn = (size_t)gridDim.x * NTHREADS;
    for (size_t i = gt; i < n; i += gn) {
        float a = 0.f;
        for (int k = 0; k < 4; ++k) {
            const size_t w = i + (size_t)k * n;
            if (w < nwords) { const unsigned u = base[w]; a += (float)((u * 2654435761u) >> 29); }
        }
        p.out[i] = a;
    }
}
constexpr size_t W_BAR = W_END;
#define PHASE(i) if (p.ph_lo <= (i) && (i) < p.ph_hi) { if ((i) > p.ph_lo) xcd_barrier(xb); run_phase(p, (i), smem_raw); }
__global__ void __launch_bounds__(NTHREADS, 2) mega_kernel(Params p) {
    __shared__ __attribute__((aligned(16))) unsigned char smem_raw[SMEM_BYTES];
    XcdBarrier xb;
    xb.bar = (unsigned*)(p.ws + W_BAR); xb.x = xb_xcc_id(); xb.nloc = 0u; xb.nx = 0u;
    if (threadIdx.x == 0) (void)xb_add(&xb.bar[XB_XCNT(xb.x)], 1u);
    if (p.ph_lo < 0) cg::this_grid().sync();
    PHASE(0) PHASE(1) PHASE(2) PHASE(3) PHASE(4) PHASE(5) PHASE(6) PHASE(7) PHASE(8) PHASE(9)
    PHASE(10) PHASE(11) PHASE(13) PHASE(14) PHASE(15) PHASE(16) PHASE(17) PHASE(18) PHASE(19)
    if (ONE_LAUNCH && p.ph_hi < N_PHASES && p.ph_lo == 0) { xcd_barrier(xb); dump_phase(p); }
    if (!ONE_LAUNCH && p.ph_lo == N_PHASES) dump_phase(p);
}

extern "C" void kernel_launch(void* const* d_in, const int* in_sizes, int n_in, void* d_out, int out_size, void* d_ws, size_t ws_size,
                              hipStream_t stream) {
    static int grid = 0;
    if (grid == 0) {
        if (n_in != 26 || (size_t)out_size != O_END || ws_size < W_END + XCD_BAR_WORDS * 4) {
            fprintf(stderr, "kernel_launch: unexpected shapes n_in=%d out=%d ws=%zu (need %zu)\n", n_in, out_size, ws_size, (size_t)W_END);
            grid = -1;
            return;
        }
        int dev = 0, cus = 0, per_cu = 0;
        (void)hipGetDevice(&dev);
        (void)hipDeviceGetAttribute(&cus, hipDeviceAttributeMultiprocessorCount, dev);
        (void)hipOccupancyMaxActiveBlocksPerMultiprocessor(&per_cu, (const void*)mega_kernel, NTHREADS, 0);
        if (per_cu < 1) per_cu = 1;
        if (per_cu > 2) per_cu = 2;
        grid = cus * per_cu;
    }
    if (grid < 0) return;
    Params p{};
    for (int i = 0; i < 26; ++i) p.in[i] = (const float*)d_in[i];
    p.out = (float*)d_out;
    p.ws = (unsigned char*)d_ws;
#if ONE_LAUNCH
    (void)hipMemsetAsync((unsigned char*)d_ws + W_BAR, 0, XCD_BAR_WORDS * 4, stream);
    p.ph_lo = 0;
    p.ph_hi = PROBE_K;
    void* args[] = {&p};
    hipError_t e = hipLaunchCooperativeKernel((const void*)mega_kernel, dim3(grid), dim3(NTHREADS), args, 0, stream);
    if (e != hipSuccess) fprintf(stderr, "cooperative launch failed: %s (grid %d)\n", hipGetErrorString(e), grid);
#else
    for (int ph = 0; ph < N_PHASES; ++ph) {
        p.ph_lo = ph;
        p.ph_hi = ph + 1;
        hipLaunchKernelGGL(mega_kernel, dim3(grid), dim3(NTHREADS), 0, stream, p);
    }
#endif
}
```
